# Optimizing an MI355X kernel written in HIP

```python
import math
import numpy as np
import jax
import jax.numpy as jnp
from jax import lax

D_MODEL = 2048
BATCH = 2
SEQ = 8192
DEPTH = 1

HEAD_DIM = 128
ROT_DIM = HEAD_DIM // 4
ROPE_THETA = 500000.0
NORM_EPS = 1e-6
NEG_INF = -1e30

NSA_HEADS = 8
NSA_KV_HEADS = 2
NSA_GROUP = NSA_HEADS // NSA_KV_HEADS
N_BRANCH = 3
CMP_LEN = 32
CMP_STRIDE = 16
CMP_HIDDEN = 2 * HEAD_DIM
SEL_BLOCK = 64
N_SELECTED = 16
WINDOW = 512
FORCED_SCORE = 1e9
NSA_Q_BLOCK = 64

DIFF_HEADS = 4
DIFF_V_DIM = 2 * HEAD_DIM
DIFF_Q_BLOCK = 128

MIX_WIDTH = NSA_HEADS * HEAD_DIM + DIFF_HEADS * DIFF_V_DIM

NSA_Q_COLS = NSA_HEADS * HEAD_DIM
NSA_KV_COLS = NSA_KV_HEADS * HEAD_DIM
NSA_GATE_COLS = NSA_HEADS * N_BRANCH
DIFF_QK_COLS = DIFF_HEADS * 2 * HEAD_DIM
DIFF_V_COLS = DIFF_HEADS * DIFF_V_DIM
IN_SPLITS = (NSA_Q_COLS,
             NSA_KV_COLS, NSA_KV_COLS,
             NSA_KV_COLS, NSA_KV_COLS,
             NSA_KV_COLS, NSA_KV_COLS,
             NSA_GATE_COLS,
             DIFF_QK_COLS, DIFF_QK_COLS, DIFF_V_COLS)
IN_COLS = sum(IN_SPLITS)
IN_SPLIT_IDX = [int(v) for v in np.cumsum(IN_SPLITS)[:-1]]

N_EXPERTS = 32
TOP_K = 4
D_FF = D_MODEL
SWIGLU_ALPHA = 1.702
SWIGLU_LIMIT = 7.0
MOE_BLOCK = 256

kernel_name = "hybrid_nsa_diffattn_moe_block"


def rms_norm(x, g):
    xf = x.astype(jnp.float32)
    y = xf * lax.rsqrt(jnp.mean(xf * xf, axis=-1, keepdims=True) + NORM_EPS)
    return (y * g.astype(jnp.float32)).astype(x.dtype)


def partial_rope(x, pos):
    inv = jnp.power(ROPE_THETA, -jnp.arange(0, ROT_DIM, 2, dtype=jnp.float32) / ROT_DIM)
    ang = pos.astype(jnp.float32)[:, None] * inv[None, :]
    cos, sin = jnp.cos(ang), jnp.sin(ang)
    xr = x[..., :ROT_DIM].astype(jnp.float32)
    x1, x2 = xr[..., : ROT_DIM // 2], xr[..., ROT_DIM // 2:]
    rot = jnp.concatenate([x1 * cos - x2 * sin, x2 * cos + x1 * sin], axis=-1).astype(x.dtype)
    return jnp.concatenate([rot, x[..., ROT_DIM:]], axis=-1)


def masked_softmax(s, mask):
    s = jnp.where(mask, s, NEG_INF)
    m = jnp.max(s, axis=-1, keepdims=True)
    p = jnp.exp(s - m) * mask
    return p / jnp.maximum(jnp.sum(p, axis=-1, keepdims=True), 1e-30)


def nsa_mixer(q, kc, vc, ks, vs, kw, vw, g, q_norm_g, k_norm_g, pos_k, pos_v,
              k_w1, k_w2, v_w1, v_w2, pos):
    B, S, _ = q.shape
    dt = q.dtype
    scale = HEAD_DIM ** -0.5

    def heads(t, n):
        return t.reshape(B, S, n, HEAD_DIM).transpose(0, 2, 1, 3)

    qn = partial_rope(rms_norm(heads(q, NSA_HEADS), q_norm_g), pos)
    qn = qn.reshape(B, NSA_KV_HEADS, NSA_GROUP, S, HEAD_DIM)
    k_slc = partial_rope(rms_norm(heads(ks, NSA_KV_HEADS), k_norm_g[1]), pos)
    v_slc = heads(vs, NSA_KV_HEADS)
    k_win = partial_rope(rms_norm(heads(kw, NSA_KV_HEADS), k_norm_g[2]), pos)
    v_win = heads(vw, NSA_KV_HEADS)

    n_cmp = (S - CMP_LEN) // CMP_STRIDE + 1
    idx = np.arange(n_cmp)[:, None] * CMP_STRIDE + np.arange(CMP_LEN)[None, :]
    cmp_end = jnp.asarray(idx[:, -1], jnp.int32)

    def compress(t, pe, w1, w2):
        blocks = heads(t, NSA_KV_HEADS)[:, :, idx] + pe
        flat = blocks.reshape(B, NSA_KV_HEADS, n_cmp, CMP_LEN * HEAD_DIM)
        return jax.nn.gelu(flat @ w1) @ w2

    k_cmp = partial_rope(rms_norm(compress(kc, pos_k, k_w1, k_w2), k_norm_g[0]),
                         cmp_end.astype(jnp.float32))
    v_cmp = compress(vc, pos_v, v_w1, v_w2)

    n_sel = S // SEL_BLOCK
    n_top = min(N_SELECTED, n_sel)
    c_start = idx[:, 0]
    s_start = np.arange(n_sel) * SEL_BLOCK
    overlap = (c_start[:, None] < s_start[None, :] + SEL_BLOCK) & (c_start[:, None] + CMP_LEN > s_start[None, :])
    sel_map = jnp.asarray(overlap, jnp.float32)

    k_slc_blocks = k_slc.reshape(B, NSA_KV_HEADS, n_sel, SEL_BLOCK, HEAD_DIM)
    v_slc_blocks = v_slc.reshape(B, NSA_KV_HEADS, n_sel, SEL_BLOCK, HEAD_DIM)
    pad = ((0, 0), (0, 0), (WINDOW, 0), (0, 0))
    k_win_p = jnp.pad(k_win, pad)
    v_win_p = jnp.pad(v_win, pad)
    b_ix = jnp.arange(B)[:, None, None, None]
    h_ix = jnp.arange(NSA_KV_HEADS)[None, :, None, None]
    j_ids = jnp.arange(n_sel)
    f32 = jnp.float32

    def block(qi):
        q0 = qi * NSA_Q_BLOCK
        t = q0 + jnp.arange(NSA_Q_BLOCK)
        qb = lax.dynamic_slice_in_dim(qn, q0, NSA_Q_BLOCK, axis=3)
        s_c = jnp.einsum('bhgqd,bhnd->bhgqn', qb, k_cmp, preferred_element_type=f32) * scale
        p_c = masked_softmax(s_c, cmp_end[None, :] <= t[:, None])
        o_c = jnp.einsum('bhgqn,bhnd->bhgqd', p_c.astype(dt), v_cmp)
        imp = jnp.einsum('bhgqn,nj->bhqj', p_c, sel_map)
        cur = t // SEL_BLOCK
        forced = (j_ids[None, :] == 0) | (j_ids[None, :] == cur[:, None]) | (j_ids[None, :] == cur[:, None] - 1)
        imp = jnp.where(forced, FORCED_SCORE, imp)
        imp = jnp.where(j_ids[None, :] <= cur[:, None], imp, NEG_INF)
        top_s, sel = lax.top_k(imp, n_top)
        valid = top_s > -1.0
        ks_g = k_slc_blocks[b_ix, h_ix, sel]
        vs_g = v_slc_blocks[b_ix, h_ix, sel]
        s_s = jnp.einsum('bhgqd,bhqnkd->bhgqnk', qb, ks_g, preferred_element_type=f32) * scale
        key_pos = sel[..., None] * SEL_BLOCK + jnp.arange(SEL_BLOCK)
        m_s = (key_pos <= t[:, None, None]) & valid[..., None]
        p_s = masked_softmax(s_s.reshape(B, NSA_KV_HEADS, NSA_GROUP, NSA_Q_BLOCK, n_top * SEL_BLOCK),
                             m_s.reshape(B, NSA_KV_HEADS, 1, NSA_Q_BLOCK, n_top * SEL_BLOCK))
        o_s = jnp.einsum('bhgqnk,bhqnkd->bhgqd', p_s.reshape(s_s.shape).astype(dt), vs_g)
        kwb = lax.dynamic_slice_in_dim(k_win_p, q0, NSA_Q_BLOCK + WINDOW, axis=2)
        vwb = lax.dynamic_slice_in_dim(v_win_p, q0, NSA_Q_BLOCK + WINDOW, axis=2)
        kpos = q0 - WINDOW + jnp.arange(NSA_Q_BLOCK + WINDOW)
        m_w = (kpos[None, :] >= 0) & (kpos[None, :] <= t[:, None]) & (t[:, None] - kpos[None, :] < WINDOW)
        s_w = jnp.einsum('bhgqd,bhkd->bhgqk', qb, kwb, preferred_element_type=f32) * scale
        p_w = masked_softmax(s_w, m_w)
        o_w = jnp.einsum('bhgqk,bhkd->bhgqd', p_w.astype(dt), vwb)
        return jnp.stack([o_c, o_s, o_w], axis=-1)

    outs = lax.map(block, jnp.arange(S // NSA_Q_BLOCK))
    outs = outs.transpose(1, 0, 4, 2, 3, 5, 6).reshape(B, S, NSA_KV_HEADS, NSA_GROUP, HEAD_DIM, N_BRANCH)
    gates = jax.nn.sigmoid(g.astype(jnp.float32)).reshape(B, S, NSA_KV_HEADS, NSA_GROUP, 1, N_BRANCH)
    o = jnp.sum(outs.astype(jnp.float32) * gates, axis=-1)
    return o.reshape(B, S, NSA_HEADS * HEAD_DIM).astype(dt)


def diff_mixer(q, k, v, q_norm_g, k_norm_g, lq1, lk1, lq2, lk2, subln_g, lambda_init, pos):
    B, S, _ = q.shape
    scale = HEAD_DIM ** -0.5
    qd = q.reshape(B, S, DIFF_HEADS, 2, HEAD_DIM).transpose(0, 2, 3, 1, 4)
    kd = k.reshape(B, S, DIFF_HEADS, 2, HEAD_DIM).transpose(0, 2, 3, 1, 4)
    qd = partial_rope(rms_norm(qd, q_norm_g), pos)
    kd = partial_rope(rms_norm(kd, k_norm_g), pos)
    vd = v.reshape(B, S, DIFF_HEADS, DIFF_V_DIM).transpose(0, 2, 1, 3)
    lam = (jnp.exp(jnp.sum(lq1.astype(jnp.float32) * lk1.astype(jnp.float32)))
           - jnp.exp(jnp.sum(lq2.astype(jnp.float32) * lk2.astype(jnp.float32))) + lambda_init)
    kpos = jnp.arange(S)

    def block(qi):
        q0 = qi * DIFF_Q_BLOCK
        t = q0 + jnp.arange(DIFF_Q_BLOCK)
        qb = lax.dynamic_slice_in_dim(qd, q0, DIFF_Q_BLOCK, axis=3)
        s = jnp.einsum('bhcqd,bhckd->bhcqk', qb, kd, preferred_element_type=jnp.float32) * scale
        p = masked_softmax(s, kpos[None, :] <= t[:, None])
        a = p[:, :, 0] - lam * p[:, :, 1]
        return jnp.einsum('bhqk,bhkd->bhqd', a.astype(vd.dtype), vd)

    o = lax.map(block, jnp.arange(S // DIFF_Q_BLOCK))
    o = o.transpose(1, 0, 3, 2, 4).reshape(B, S, DIFF_HEADS, DIFF_V_DIM)
    o = rms_norm(o, subln_g) * (1.0 - lambda_init)
    return o.reshape(B, S, DIFF_HEADS * DIFF_V_DIM)


def moe_ffn(h, w_router, b_router, w_gate_up, b_gate_up, w_down, b_down):
    B, S, D = h.shape
    T = B * S
    TK = T * TOP_K
    xt = h.reshape(T, D)
    logits = (xt @ w_router + b_router).astype(jnp.float32)
    top_v, top_e = lax.top_k(logits, TOP_K)
    gate = jax.nn.softmax(top_v, axis=-1)
    flat_e = top_e.reshape(TK)
    flat_tok = (jnp.arange(TK) // TOP_K).astype(jnp.int32)
    flat_g = gate.reshape(TK)
    order = jnp.argsort(flat_e)
    se, st, sg = flat_e[order], flat_tok[order], flat_g[order]
    counts = jnp.bincount(flat_e, length=N_EXPERTS)
    padded = (counts + MOE_BLOCK - 1) // MOE_BLOCK * MOE_BLOCK
    pad_end = jnp.cumsum(padded)
    pad_start = pad_end - padded
    cnt_start = jnp.cumsum(counts) - counts
    dest = pad_start[se] + (jnp.arange(TK) - cnt_start[se])
    n_blocks = -(-TK // MOE_BLOCK) + N_EXPERTS
    n_rows = n_blocks * MOE_BLOCK
    row_tok = jnp.full((n_rows,), T, jnp.int32).at[dest].set(st)
    row_g = jnp.zeros((n_rows,), jnp.float32).at[dest].set(sg)
    blk_e = jnp.minimum(jnp.searchsorted(pad_end, jnp.arange(n_blocks) * MOE_BLOCK, side='right'),
                        N_EXPERTS - 1)
    x_pad = jnp.concatenate([xt, jnp.zeros((1, D), xt.dtype)], axis=0)

    def expert_block(args):
        tok, e = args
        xb = x_pad[tok]
        gu = xb @ w_gate_up[e] + b_gate_up[e]
        gl, up = gu[:, :D_FF], gu[:, D_FF:]
        gl = jnp.minimum(gl, SWIGLU_LIMIT)
        up = jnp.clip(up, -SWIGLU_LIMIT, SWIGLU_LIMIT)
        hb = (up + 1.0) * (gl * jax.nn.sigmoid(SWIGLU_ALPHA * gl))
        return hb @ w_down[e] + b_down[e]

    y = lax.map(expert_block, (row_tok.reshape(n_blocks, MOE_BLOCK), blk_e))
    y = y.reshape(n_rows, D).astype(jnp.float32) * row_g[:, None]
    out = jax.ops.segment_sum(y, row_tok, num_segments=T + 1)[:T]
    return out.reshape(B, S, D).astype(h.dtype)


def setup_inputs(seed: int = 0) -> dict:
    key = jax.random.key(seed)
    ks = jax.random.split(key, 32)
    L = DEPTH

    def nrm(k, shape, fan_in):
        return jax.random.normal(k, shape, jnp.float32) * fan_in ** -0.5

    def gain(k, shape):
        return 1.0 + 0.05 * jax.random.normal(k, shape, jnp.float32)

    def small(k, shape, s):
        return s * jax.random.normal(k, shape, jnp.float32)

    return {
        "x": jax.random.normal(ks[0], (BATCH, SEQ, D_MODEL), jnp.float32),
        "attn_norm_g": gain(ks[1], (L, D_MODEL)),
        "w_in": nrm(ks[2], (L, D_MODEL, IN_COLS), D_MODEL),
        "nsa_q_norm_g": gain(ks[3], (L, HEAD_DIM)),
        "nsa_k_norm_g": gain(ks[4], (L, N_BRANCH, HEAD_DIM)),
        "nsa_cmp_pos_k": small(ks[5], (L, CMP_LEN, HEAD_DIM), 0.1),
        "nsa_cmp_pos_v": small(ks[6], (L, CMP_LEN, HEAD_DIM), 0.1),
        "nsa_cmp_k_w1": nrm(ks[7], (L, CMP_LEN * HEAD_DIM, CMP_HIDDEN), CMP_LEN * HEAD_DIM),
        "nsa_cmp_k_w2": nrm(ks[8], (L, CMP_HIDDEN, HEAD_DIM), CMP_HIDDEN),
        "nsa_cmp_v_w1": nrm(ks[9], (L, CMP_LEN * HEAD_DIM, CMP_HIDDEN), CMP_LEN * HEAD_DIM),
        "nsa_cmp_v_w2": nrm(ks[10], (L, CMP_HIDDEN, HEAD_DIM), CMP_HIDDEN),
        "diff_q_norm_g": gain(ks[11], (L, HEAD_DIM)),
        "diff_k_norm_g": gain(ks[12], (L, HEAD_DIM)),
        "diff_lambda_q1": small(ks[13], (L, HEAD_DIM), 0.1),
        "diff_lambda_k1": small(ks[14], (L, HEAD_DIM), 0.1),
        "diff_lambda_q2": small(ks[15], (L, HEAD_DIM), 0.1),
        "diff_lambda_k2": small(ks[16], (L, HEAD_DIM), 0.1),
        "diff_subln_g": gain(ks[17], (L, DIFF_V_DIM)),
        "w_out": nrm(ks[18], (L, MIX_WIDTH, D_MODEL), MIX_WIDTH),
        "ffn_norm_g": gain(ks[19], (L, D_MODEL)),
        "w_router": nrm(ks[20], (L, D_MODEL, N_EXPERTS), D_MODEL),
        "b_router": small(ks[21], (L, N_EXPERTS), 0.01),
        "w_gate_up": nrm(ks[22], (L, N_EXPERTS, D_MODEL, 2 * D_FF), D_MODEL),
        "b_gate_up": small(ks[23], (L, N_EXPERTS, 2 * D_FF), 0.01),
        "w_down": nrm(ks[24], (L, N_EXPERTS, D_FF, D_MODEL), D_FF),
        "b_down": small(ks[25], (L, N_EXPERTS, D_MODEL), 0.01),
    }


def reference(x, attn_norm_g, w_in, nsa_q_norm_g, nsa_k_norm_g, nsa_cmp_pos_k, nsa_cmp_pos_v,
              nsa_cmp_k_w1, nsa_cmp_k_w2, nsa_cmp_v_w1, nsa_cmp_v_w2,
              diff_q_norm_g, diff_k_norm_g, diff_lambda_q1, diff_lambda_k1,
              diff_lambda_q2, diff_lambda_k2, diff_subln_g, w_out, ffn_norm_g,
              w_router, b_router, w_gate_up, b_gate_up, w_down, b_down):
    S = x.shape[1]
    pos = jnp.arange(S, dtype=jnp.float32)
    h = x
    for l in range(DEPTH):
        lambda_init = 0.8 - 0.6 * math.exp(-0.3 * l)
        xn = rms_norm(h, attn_norm_g[l])
        proj = xn @ w_in[l]
        q_nsa, kc, vc, ks_, vs_, kw, vw, g_nsa, q_d, k_d, v_d = jnp.split(proj, IN_SPLIT_IDX, axis=-1)
        o_nsa = nsa_mixer(q_nsa, kc, vc, ks_, vs_, kw, vw, g_nsa, nsa_q_norm_g[l], nsa_k_norm_g[l],
                          nsa_cmp_pos_k[l], nsa_cmp_pos_v[l], nsa_cmp_k_w1[l], nsa_cmp_k_w2[l],
                          nsa_cmp_v_w1[l], nsa_cmp_v_w2[l], pos)
        o_diff = diff_mixer(q_d, k_d, v_d, diff_q_norm_g[l], diff_k_norm_g[l], diff_lambda_q1[l],
                            diff_lambda_k1[l], diff_lambda_q2[l], diff_lambda_k2[l], diff_subln_g[l],
                            lambda_init, pos)
        mix = jnp.concatenate([o_nsa.astype(h.dtype), o_diff.astype(h.dtype)], axis=-1)
        h = h + (mix @ w_out[l]).astype(h.dtype)
        h = h + moe_ffn(rms_norm(h, ffn_norm_g[l]), w_router[l], b_router[l], w_gate_up[l],
                        b_gate_up[l], w_down[l], b_down[l])
    return h
```

```cpp
#include <hip/hip_runtime.h>
#include <cstdio>
#include <cstdint>

#ifndef MK_SPLIT
#define MK_SPLIT 0
#endif
#ifndef MK_CHECK
#define MK_CHECK 0
#endif

#define GAS __attribute__((address_space(1)))
#define LAS __attribute__((address_space(3)))
typedef unsigned short bf16;
typedef unsigned v4u __attribute__((ext_vector_type(4)));
typedef unsigned v2u __attribute__((ext_vector_type(2)));
typedef float f32x2 __attribute__((ext_vector_type(2)));
typedef float f32x4 __attribute__((ext_vector_type(4)));
typedef float f32x16 __attribute__((ext_vector_type(16)));
typedef short bf16x8 __attribute__((ext_vector_type(8)));
typedef short s16x4 __attribute__((ext_vector_type(4)));
typedef GAS unsigned gu32;
#define RLX_AGENT __ATOMIC_RELAXED, __HIP_MEMORY_SCOPE_AGENT
#define LDS_WAIT() asm volatile("s_waitcnt lgkmcnt(0)" ::: "memory")
#define VM_WAIT() asm volatile("s_waitcnt vmcnt(0)" ::: "memory")
#define SBAR() __builtin_amdgcn_sched_barrier(0)

constexpr int NB = 2, SEQ = 8192, TOK = NB * SEQ, DM = 2048, HD = 128;
constexpr int NPROJ = 5888;
constexpr int NEXP = 32, DFF = 2048, NCMPP = 512;
constexpr float NORM_EPS = 1e-6f;
constexpr float ATT_SCALE = 0.08838834764831845f;
constexpr float LOG2E = 1.4426950408889634f;
constexpr int NWAVES = 8;

__device__ __forceinline__ unsigned f2bf(float f) { unsigned u = __builtin_bit_cast(unsigned, f); return (u + 0x7fffu + ((u >> 16) & 1u)) >> 16; }
__device__ __forceinline__ unsigned pk2(float lo, float hi) { return f2bf(lo) | (f2bf(hi) << 16); }
__device__ __forceinline__ float bf2f(unsigned short b) { return __builtin_bit_cast(float, (unsigned)b << 16); }
__device__ __forceinline__ float bflo(unsigned w) { return __builtin_bit_cast(float, w << 16); }
__device__ __forceinline__ float bfhi(unsigned w) { return __builtin_bit_cast(float, w & 0xffff0000u); }
__device__ __forceinline__ unsigned cvtpk(float lo, float hi) { unsigned r; asm volatile("v_cvt_pk_bf16_f32 %0, %1, %2" : "=v"(r) : "v"(lo), "v"(hi)); return r; }
__device__ __forceinline__ float wave_sum(float v) {
#pragma unroll
    for (int o = 1; o < 64; o <<= 1) v += __shfl_xor(v, o);
    return v;
}

#define XB_TMO      128
#define XB_XCNT(j)  (256  + 64 * (j))
#define XB_XSUB(j)  (1280 + 64 * (j))
#define XB_XGEN(j)  (2304 + 64 * (j))
#define XB_TOP      3328
#define XB_TOPGEN   3392
#define XCD_BAR_WORDS 3456
#define XB_SPIN_CAP (1u << 22)

__device__ __forceinline__ unsigned xb_ld(unsigned* p)              { return __hip_atomic_load(p, __ATOMIC_RELAXED, __HIP_MEMORY_SCOPE_AGENT); }
__device__ __forceinline__ unsigned xb_add(unsigned* p, unsigned v) { return __hip_atomic_fetch_add(p, v, __ATOMIC_RELAXED, __HIP_MEMORY_SCOPE_AGENT); }
__device__ __forceinline__ unsigned xb_xcc_id() { return (unsigned)__builtin_amdgcn_s_getreg((3 << 11) | 20) & 0xFu; }
#define XB_SPIN(cond, bar) do { unsigned _sp = 0; while (cond) { __builtin_amdgcn_s_sleep(1); \
    if ((++_sp & 255u) == 0u) { if (xb_ld(&(bar)[XB_TMO])) break; if (_sp > XB_SPIN_CAP) { atomicAdd(&(bar)[XB_TMO], 1u); break; } } } } while (0)

struct XcdBarrier { unsigned* bar; unsigned x; volatile LAS unsigned* st; };

__device__ __forceinline__ XcdBarrier xcd_barrier_post(unsigned* bar, volatile LAS unsigned* st) {
    XcdBarrier b; b.bar = bar; b.x = xb_xcc_id(); b.st = st;
    if (threadIdx.x == 0) (void)xb_add(&bar[XB_XCNT(b.x)], 1u);
    return b;
}
__device__ __forceinline__ void xcd_barrier_complete(unsigned* bar, unsigned x, unsigned& nloc, unsigned& nx) {
    const unsigned G = gridDim.x * gridDim.y * gridDim.z;
    unsigned sum, cnt, mine, sp = 0u;
    for (;;) {
        sum = 0u; cnt = 0u; mine = 0u;
#pragma unroll
        for (unsigned j = 0; j < 16; ++j) { const unsigned c = xb_ld(&bar[XB_XCNT(j)]); sum += c; cnt += (c > 0u) ? 1u : 0u; mine = (j == x) ? c : mine; }
        if (sum == G) break;
        __builtin_amdgcn_s_sleep(1);
        if ((++sp & 255u) == 0u) { if (xb_ld(&bar[XB_TMO])) break; if (sp > XB_SPIN_CAP) { atomicAdd(&bar[XB_TMO], 1u); break; } }
    }
    nloc = mine > 0u ? mine : 1u; nx = cnt > 0u ? cnt : 1u;
}
__device__ __forceinline__ void xcd_barrier(const XcdBarrier& b) {
    asm volatile("s_waitcnt vmcnt(0)" ::: "memory");
    __syncthreads();
    if (threadIdx.x == 0) {
        unsigned* bar = b.bar;
        __builtin_amdgcn_s_waitcnt(0);
        unsigned nloc = b.st[0], nx = b.st[1];
        if (nloc == 0u) { xcd_barrier_complete(bar, b.x, nloc, nx); b.st[0] = nloc; b.st[1] = nx; }
        const unsigned old = xb_add(&bar[XB_XSUB(b.x)], 1u);
        const unsigned gen = old / nloc;
        if (old + 1u == (gen + 1u) * nloc) {
            __builtin_amdgcn_fence(__ATOMIC_RELEASE, "agent");
            asm volatile("s_waitcnt vmcnt(0)" ::: "memory");
            const unsigned og = xb_add(&bar[XB_TOP], 1u);
            const unsigned tg = og / nx;
            if (og + 1u == (tg + 1u) * nx) xb_add(&bar[XB_TOPGEN], 1u);
            else XB_SPIN(xb_ld(&bar[XB_TOPGEN]) == tg, bar);
            __builtin_amdgcn_fence(__ATOMIC_ACQUIRE, "agent");
            xb_add(&bar[XB_XGEN(b.x)], 1u);
            asm volatile("s_waitcnt vmcnt(0)" ::: "memory");
        } else {
            XB_SPIN(xb_ld(&bar[XB_XGEN(b.x)]) == gen, bar);
            __builtin_amdgcn_fence(__ATOMIC_ACQUIRE, "agent");
            asm volatile("s_waitcnt vmcnt(0)" ::: "memory");
        }
    }
    __syncthreads();
}

namespace pg8 {
#define PG8_LAS __attribute__((address_space(3)))
constexpr int BM = 256, BK = 64, HALF = 128, HTB = HALF * BK * 2, STAGE_BYTES = 8 * HTB;
__host__ __device__ __forceinline__ int lds_byte(int r, int c) { const int st = (r >> 4) * 2 + (c >> 5), rr = r & 15, cc = c & 31, ob = rr * 64 + cc * 2; return st * 1024 + (ob ^ (((ob >> 9) & 1) << 5)); }
__host__ __device__ __forceinline__ void stage_rc(int b, int& R, int& C) { const int st = b / 1024, sb = b % 1024, swz = sb ^ (((sb >> 9) & 1) << 5); R = (st >> 1) * 16 + swz / 64; C = (st & 1) * 32 + (swz % 64) / 2; }
__host__ __device__ __forceinline__ int perm32(int rho) { const int n = rho >> 4, i = rho & 15; return 8 * (i >> 2) + 4 * n + (i & 3); }

struct Unit { int pm, pn, e, rows; };

typedef int i32x8 __attribute__((ext_vector_type(8)));
typedef int i32x4 __attribute__((ext_vector_type(4)));
template <class Epi, class Sched, bool ALIGN_EPI, bool F8 = false, int SCALE_B = 127>
__device__ __forceinline__ void gemm_phase(PG8_LAS unsigned char* lds, const int KB  , const Sched& S, const Epi& E) {
    const int tid = threadIdx.x, wid = __builtin_amdgcn_readfirstlane(tid >> 6), lane = tid & 63, wr = wid >> 2, wc = wid & 3, fr = lane & 15, fq = lane >> 4;
    const int nt = KB / 128;
    int Rr[2], Cc[2]; unsigned voffB[2];
#pragma unroll
    for (int i = 0; i < 2; ++i) { int R, C; stage_rc(tid * 16 + i * 8192, R, C); Rr[i] = R; Cc[i] = C; const int Rb = (R & ~31) + perm32(R & 31); voffB[i] = (unsigned)(Rb * KB + C * 2); }
    const unsigned kstep = 128u;
    const unsigned hstep = (unsigned)(HALF * KB);
    const unsigned ldsw = (unsigned)wid * 1024u;
    const int aoff = lds_byte(wr * 64 + fr, fq * 8), boff = lds_byte(wc * 32 + fr, fq * 8);
    const char* const Ab = S.abase();
#define PG8_SA(b, h) (((b) * 2 + (h)) * HTB)
#define PG8_SB(b, h) ((4 + (b) * 2 + (h)) * HTB)
#define PG8_DMA(base_, off_, ldsp_) do { unsigned o_ = (off_); asm volatile("" : "+v"(o_)); __builtin_amdgcn_global_load_lds((const unsigned*)((const char*)(base_) + o_), (PG8_LAS unsigned*)(ldsp_), 16, 0, 0); } while (0)
#define PG8_STAGE(bufoff, bbase, kb) do { PG8_DMA(bbase, voffB[0] + (unsigned)(kb), lds + (bufoff) + ldsw); PG8_DMA(bbase, voffB[1] + (unsigned)(kb), lds + (bufoff) + ldsw + 8192); } while (0)
#define PG8_STAGE_A(bufoff, kb, v0_, v1_) do { PG8_DMA(Ab, (v0_) + (unsigned)(kb), lds + (bufoff) + ldsw); PG8_DMA(Ab, (v1_) + (unsigned)(kb), lds + (bufoff) + ldsw + 8192); } while (0)
#define PG8_LD8(p_) __builtin_shufflevector(*(const PG8_LAS i32x4*)(p_), *(const PG8_LAS i32x4*)((p_) + 1024), 0, 1, 2, 3, 4, 5, 6, 7)
#define PG8_LDA(dst, b, h) do { _Pragma("unroll") for (int m = 0; m < 4; ++m) dst[m] = PG8_LD8(lds + PG8_SA(b, h) + aoff + m * 2048); } while (0)
#define PG8_LDB(dst, b, h) do { _Pragma("unroll") for (int n = 0; n < 2; ++n) dst[n] = PG8_LD8(lds + PG8_SB(b, h) + boff + n * 2048); } while (0)
#define PG8_H0(x) __builtin_bit_cast(bf16x8, __builtin_shufflevector(x, x, 0, 1, 2, 3))
#define PG8_H1(x) __builtin_bit_cast(bf16x8, __builtin_shufflevector(x, x, 4, 5, 6, 7))
#define PG8_MMA(ai, bj, At, Bt) do { __builtin_amdgcn_s_setprio(1); _Pragma("unroll") for (int m = 0; m < 4; ++m) _Pragma("unroll") for (int n = 0; n < 2; ++n) { \
        if constexpr (F8) asm volatile("v_mfma_scale_f32_16x16x128_f8f6f4 %0, %1, %2, %0, %3, %4 op_sel_hi:[0,0,0]" : "+v"(acc[ai][bj][m][n]) : "v"(Bt[n]), "v"(At[m]), "v"(sclB), "v"(sclA)); \
        else { acc[ai][bj][m][n] = __builtin_amdgcn_mfma_f32_16x16x32_bf16(PG8_H0(Bt[n]), PG8_H0(At[m]), acc[ai][bj][m][n], 0, 0, 0); \
               acc[ai][bj][m][n] = __builtin_amdgcn_mfma_f32_16x16x32_bf16(PG8_H1(Bt[n]), PG8_H1(At[m]), acc[ai][bj][m][n], 0, 0, 0); } } \
        __builtin_amdgcn_s_setprio(0); } while (0)
#define PG8_WAIT_V(n) asm volatile("s_waitcnt vmcnt(" #n ")" ::: "memory")
#define PG8_WAIT_L(n) asm volatile("s_waitcnt lgkmcnt(" #n ")" ::: "memory")
#define PG8_BAR __builtin_amdgcn_s_barrier()
#define PG8_SCHED __builtin_amdgcn_sched_barrier(0)
    Unit cur, nxt; int ui = 0;
    if (!S.next(0, cur)) return;
    f32x4 acc[2][2][4][2];
#pragma unroll
    for (int a = 0; a < 2; ++a)
#pragma unroll
        for (int b = 0; b < 2; ++b)
#pragma unroll
            for (int m = 0; m < 4; ++m)
#pragma unroll
                for (int n = 0; n < 2; ++n) acc[a][b][m][n] = (f32x4){0.f, 0.f, 0.f, 0.f};
    const int sclB = SCALE_B, sclA = 127;
    i32x8 At[4], B0[2], B1[2];
    unsigned c00, c01, c10, c11, n00, n01, n10, n11;
    S.avoff(cur, Rr, Cc, KB, c00, c01, c10, c11);
    const char* cB = S.btile(cur, KB);
    typename Epi::Pre pre = E.prefetch(cur, wr, wc, fr, fq);
    PG8_STAGE(PG8_SB(0, 0), cB, 0u); PG8_STAGE(PG8_SB(0, 1), cB, hstep); PG8_STAGE_A(PG8_SA(0, 0), 0u, c00, c01); PG8_STAGE_A(PG8_SA(0, 1), 0u, c10, c11);
    if (wr == 1) PG8_BAR;
    PG8_WAIT_V(2); PG8_BAR;
    PG8_STAGE(PG8_SB(1, 0), cB, kstep); PG8_STAGE_A(PG8_SA(1, 0), kstep, c00, c01); PG8_STAGE(PG8_SB(1, 1), cB, hstep + kstep);
    PG8_WAIT_V(6); PG8_BAR;
    for (;;) {
        const bool has_next = S.next(ui + 1, nxt);
        if (!has_next) nxt = cur;
        const char* nB = has_next ? S.btile(nxt, KB) : cB;
        if (has_next) S.avoff(nxt, Rr, Cc, KB, n00, n01, n10, n11); else { n00 = c00; n01 = c01; n10 = c10; n11 = c11; }
        for (int t = 0; t < nt; t += 2) {
            const bool last = (t == nt - 2);
            const unsigned k1 = (unsigned)(t + 1) * kstep;
            const unsigned k2 = last ? 0u : (unsigned)(t + 2) * kstep, k3 = k2 + kstep;
            const unsigned x00 = last ? n00 : c00, x01 = last ? n01 : c01, x10 = last ? n10 : c10, x11 = last ? n11 : c11;
            const char* b2 = last ? nB : cB;
            PG8_LDB(B0, 0, 0); PG8_LDB(B1, 0, 1); PG8_SCHED; PG8_LDA(At, 0, 0); PG8_STAGE_A(PG8_SA(1, 1), k1, c10, c11);
            PG8_WAIT_V(8); PG8_WAIT_L(0); PG8_BAR; PG8_MMA(0, 0, At, B0); PG8_MMA(0, 1, At, B1); PG8_BAR; PG8_SCHED;
            PG8_LDA(At, 0, 1); PG8_STAGE(PG8_SB(0, 0), b2, k2); PG8_STAGE(PG8_SB(0, 1), b2, k2 + hstep); PG8_STAGE_A(PG8_SA(0, 0), k2, x00, x01);
            PG8_WAIT_V(8); PG8_WAIT_L(0); PG8_BAR; PG8_MMA(1, 0, At, B0); PG8_MMA(1, 1, At, B1); PG8_BAR; PG8_SCHED;
            PG8_LDB(B0, 1, 0); PG8_LDB(B1, 1, 1); PG8_SCHED; PG8_LDA(At, 1, 0); PG8_STAGE_A(PG8_SA(0, 1), k2, x10, x11);
            PG8_WAIT_V(8); PG8_WAIT_L(0); PG8_BAR; PG8_MMA(0, 0, At, B0); PG8_MMA(0, 1, At, B1); PG8_BAR; PG8_SCHED;
            PG8_LDA(At, 1, 1); PG8_STAGE(PG8_SB(1, 0), b2, k3); PG8_STAGE(PG8_SB(1, 1), b2, k3 + hstep); PG8_STAGE_A(PG8_SA(1, 0), k3, x00, x01);
            PG8_WAIT_V(8); PG8_WAIT_L(0); PG8_BAR; PG8_MMA(1, 0, At, B0); PG8_MMA(1, 1, At, B1); PG8_BAR; PG8_SCHED;
        }
        if constexpr (ALIGN_EPI) { if (wr == 0) PG8_BAR; }
        if constexpr (F8) asm volatile("s_nop 15\n\ts_nop 15" ::: "memory");
        { int fr2 = fr, fq2 = fq; asm volatile("" : "+v"(fr2), "+v"(fq2)); E(acc, cur, wr, wc, fr2, fq2, pre); }
        if (!has_next) break;
#pragma unroll
        for (int a = 0; a < 2; ++a)
#pragma unroll
            for (int b = 0; b < 2; ++b)
#pragma unroll
                for (int m = 0; m < 4; ++m)
#pragma unroll
                    for (int n = 0; n < 2; ++n) acc[a][b][m][n] = (f32x4){0.f, 0.f, 0.f, 0.f};
        cur = nxt; cB = nB; c00 = n00; c01 = n01; c10 = n10; c11 = n11; ++ui;
        pre = E.prefetch(cur, wr, wc, fr, fq);
        if constexpr (ALIGN_EPI) { if (wr == 1) PG8_BAR; }
    }
    PG8_WAIT_V(0);
    if constexpr (!ALIGN_EPI) { if (wr == 0) PG8_BAR; }
    PG8_BAR;
#undef PG8_SA
#undef PG8_SB
#undef PG8_STAGE
#undef PG8_DMA
#undef PG8_STAGE_A
#undef PG8_LDA
#undef PG8_LD8
#undef PG8_H0
#undef PG8_H1
#undef PG8_LDB
#undef PG8_MMA
#undef PG8_WAIT_V
#undef PG8_WAIT_L
#undef PG8_BAR
#undef PG8_SCHED
}
}
namespace fa16 {
constexpr int D = 128, NW = 8, QBLK = 32, KVBLK = 64, QB = NW * QBLK;
constexpr int SHM_V = KVBLK * D * 2, SHM_K = KVBLK * D * 2;
constexpr int NVB = 3;
constexpr int WS_OFF = NVB * SHM_V + 2 * SHM_K;
constexpr int SELM_OFF = WS_OFF + NW * 64 * 4;
constexpr int LDS_BYTES = SELM_OFF + 1024;
constexpr float SCALE = 0.08838834764831845f;
constexpr float THR = 8.f;

#define KSWZ(row, colB) ((row) * 256 + ((colB) ^ (((row) & 7) << 4)))
__device__ __forceinline__ int v_st(int k, int c) { const int kk = (k & ~0xC) | ((k & 4) << 1) | ((k & 8) >> 1); return ((kk >> 3) * 4 + (c >> 5)) * 512 + ((kk & 7) * 32 + (c & 31)) * 2; }
__device__ __forceinline__ int v_rd_base(int lane) { return ((lane & 3) << 3) | (((lane >> 2) & 3) << 6) | (((lane >> 4) & 1) << 5) | (((lane >> 5) & 1) << 8); }
constexpr int v_rd_off(int d0, int ks, int half) { return d0 * 512 + ks * 4096 + half * 2048; }
__device__ __forceinline__ int crow(int r, int hi) { return (r & 3) + 8 * (r >> 2) + 4 * hi; }
__device__ __forceinline__ bf16x8 load8(const bf16* p) { return *reinterpret_cast<const bf16x8*>(p); }

template <int KS>
__device__ __forceinline__ void mask_tile(f32x16& p0, f32x16& p1, int dq, unsigned Wk) {
    const float NEG = -__builtin_inff();
#pragma unroll
    for (int r = 0; r < 16; ++r) {
        const int c = KS * ((r & 3) + 8 * (r >> 2));
        if ((unsigned)(dq - c) >= Wk) p0[r] = NEG;
        if ((unsigned)(dq - c - KS * 32) >= Wk) p1[r] = NEG;
    }
}
__device__ __forceinline__ void kill_tile(f32x16& p0, f32x16& p1, bool keep) {
    const float NEG = -__builtin_inff();
#pragma unroll
    for (int r = 0; r < 16; ++r) { p0[r] = keep ? p0[r] : NEG; p1[r] = keep ? p1[r] : NEG; }
}
__device__ __forceinline__ void partialSM(f32x16& p0, f32x16& p1, float& m_reg, float& mn, float& alpha) {
    float pmax = p0[0]; for (int r = 1; r < 16; ++r) pmax = fmaxf(pmax, p0[r]); for (int r = 0; r < 16; ++r) pmax = fmaxf(pmax, p1[r]);
    { auto rr = __builtin_amdgcn_permlane32_swap(__float_as_uint(pmax), __float_as_uint(pmax), false, false);
      pmax = fmaxf(__uint_as_float(rr[0]), __uint_as_float(rr[1])); }
    constexpr float C2 = 1.4426950408889634f * SCALE;
    if (__builtin_expect(__all((pmax - m_reg) * SCALE <= THR), 1)) { mn = m_reg; alpha = 1.f; }
    else { mn = fmaxf(m_reg, pmax); alpha = __builtin_amdgcn_exp2f((m_reg - mn) * C2); m_reg = mn; }
    const float mnL = -mn * C2;
    for (int r = 0; r < 16; ++r) p0[r] = fmaf(p0[r], C2, mnL); for (int r = 0; r < 16; ++r) p1[r] = fmaf(p1[r], C2, mnL);
    for (int r = 0; r < 16; ++r) p0[r] = __builtin_amdgcn_exp2f(p0[r]);
}
#define FA_PK4(P, B_, OUT) do { unsigned a0 = cvtpk(P[B_+0], P[B_+1]), a1 = cvtpk(P[B_+2], P[B_+3]);                          \
        unsigned b0 = cvtpk(P[B_+4], P[B_+5]), b1 = cvtpk(P[B_+6], P[B_+7]);                                             \
        auto r0 = __builtin_amdgcn_permlane32_swap(a0, b0, false, false); auto r1 = __builtin_amdgcn_permlane32_swap(a1, b1, false, false); \
        v4u w = {r0[0], r1[0], r0[1], r1[1]}; OUT = *reinterpret_cast<bf16x8*>(&w); } while (0)
__device__ __forceinline__ void pack_p(const f32x16& p0, const f32x16& p1, bf16x8& pa0, bf16x8& pa1, bf16x8& pa2, bf16x8& pa3) {
    FA_PK4(p0, 0, pa0); FA_PK4(p0, 8, pa1); FA_PK4(p1, 0, pa2); FA_PK4(p1, 8, pa3);
}
__device__ __forceinline__ void finishSM(f32x16& p0, f32x16& p1, float alpha, float& l_reg, bf16x8& pa0, bf16x8& pa1, bf16x8& pa2, bf16x8& pa3) {
    for (int r = 0; r < 16; ++r) p1[r] = __builtin_amdgcn_exp2f(p1[r]);
    float ps = 0; for (int r = 0; r < 16; ++r) ps += p0[r]; for (int r = 0; r < 16; ++r) ps += p1[r];
    { auto rr = __builtin_amdgcn_permlane32_swap(__float_as_uint(ps), __float_as_uint(ps), false, false);
      ps = __uint_as_float(rr[0]) + __uint_as_float(rr[1]); }
    l_reg = l_reg * alpha + ps;
    pack_p(p0, p1, pa0, pa1, pa2, pa3);
}
template <int KB, bool SK>
__device__ __forceinline__ void qkt(f32x16& p0, f32x16& p1, const char* K_lds, int r32, int hi, const bf16x8* qr, bool act) {
    if (SK && !act) { const float NEG = -__builtin_inff();
#pragma unroll
        for (int r = 0; r < 16; ++r) { p0[r] = NEG; p1[r] = NEG; } return; }
    p0 = f32x16{}; p1 = f32x16{};
    const char* kb[4];
#pragma unroll
    for (int dd = 0; dd < 4; ++dd) kb[dd] = K_lds + KB * SHM_K + KSWZ(r32, (dd * 16 + hi * 8) * 2);
#pragma unroll
    for (int d0 = 0; d0 < 8; ++d0) { const char* a = kb[d0 & 3] + (d0 >> 2) * 128;
        bf16x8 b0 = *reinterpret_cast<const bf16x8*>(a);
        bf16x8 b1 = *reinterpret_cast<const bf16x8*>(a + 32 * 256);
        p0 = __builtin_amdgcn_mfma_f32_32x32x16_bf16(b0, qr[d0], p0, 0, 0, 0);
        p1 = __builtin_amdgcn_mfma_f32_32x32x16_bf16(b1, qr[d0], p1, 0, 0, 0); }
}
template <int VB, bool SK>
__device__ __forceinline__ void pv_tile(f32x16* o, int vb0, bf16x8 pa0, bf16x8 pa1, bf16x8 pa2, bf16x8 pa3, bool act) {
    if (SK && !act) return;
#define TRRD(dst, off) asm volatile("ds_read_b64_tr_b16 %0, %1 offset:%2" : "=&v"(dst) : "v"(vb0), "i"(off) : "memory")
#define PV_D0(d0) do { s16x4 l0, l1, l2, l3, h0, h1, h2, h3; constexpr int b_ = VB * SHM_V + v_rd_off(d0, 0, 0); \
        TRRD(l0, b_); TRRD(h0, b_ + 2048); TRRD(l1, b_ + 4096); TRRD(h1, b_ + 6144); TRRD(l2, b_ + 8192); TRRD(h2, b_ + 10240); TRRD(l3, b_ + 12288); TRRD(h3, b_ + 14336); \
        asm volatile("s_waitcnt lgkmcnt(0)" ::: "memory"); SBAR();   \
        o[d0] = __builtin_amdgcn_mfma_f32_32x32x16_bf16(pa0, (bf16x8){l0[0], l0[1], l0[2], l0[3], h0[0], h0[1], h0[2], h0[3]}, o[d0], 0, 0, 0);   \
        o[d0] = __builtin_amdgcn_mfma_f32_32x32x16_bf16(pa1, (bf16x8){l1[0], l1[1], l1[2], l1[3], h1[0], h1[1], h1[2], h1[3]}, o[d0], 0, 0, 0);   \
        o[d0] = __builtin_amdgcn_mfma_f32_32x32x16_bf16(pa2, (bf16x8){l2[0], l2[1], l2[2], l2[3], h2[0], h2[1], h2[2], h2[3]}, o[d0], 0, 0, 0);   \
        o[d0] = __builtin_amdgcn_mfma_f32_32x32x16_bf16(pa3, (bf16x8){l3[0], l3[1], l3[2], l3[3], h3[0], h3[1], h3[2], h3[3]}, o[d0], 0, 0, 0); } while (0)
    PV_D0(0); PV_D0(1); PV_D0(2); PV_D0(3);
#undef PV_D0
#undef TRRD
}

}
namespace fa {
constexpr int D = 128, NW = 8, QBLK = 32, KVBLK = 64, QB = NW * QBLK, SEQ_V = 8192;
constexpr int KPITCH = 144, VPITCH = 80;
constexpr int SHM_V = D * VPITCH, SHM_K = KVBLK * KPITCH;
typedef int fi8 __attribute__((ext_vector_type(8)));
constexpr int SC_IN = 123;
constexpr float PSH = 7.f;
constexpr int NVB = 3;
constexpr int WS_OFF = NVB * SHM_V + 2 * SHM_K;
constexpr int SELM_OFF = WS_OFF + NW * 64 * 4;
constexpr int LDS_BYTES = SELM_OFF + 1024;
constexpr float SCALE = 0.08838834764831845f;
constexpr float THR = 1.f;

__device__ __forceinline__ unsigned pk4f8(float a, float b, float c, float d) { int w = __builtin_amdgcn_cvt_pk_fp8_f32(a, b, 0, false); w = __builtin_amdgcn_cvt_pk_fp8_f32(c, d, w, true); return (unsigned)w; }
__device__ __forceinline__ f32x16 mfma8(fi8 a, fi8 b, f32x16 c, int sa, int sb) { return __builtin_amdgcn_mfma_scale_f32_32x32x64_f8f6f4(a, b, c, 0, 0, 0, sa, 0, sb); }
__device__ __forceinline__ fi8 ld32(const char* p) { const v4u a = *reinterpret_cast<const v4u*>(p), b = *reinterpret_cast<const v4u*>(p + 16); return fi8{(int)a.x, (int)a.y, (int)a.z, (int)a.w, (int)b.x, (int)b.y, (int)b.z, (int)b.w}; }
__device__ __forceinline__ int crow(int r, int hi) { return (r & 3) + 8 * (r >> 2) + 4 * hi; }

template <int KS>
__device__ __forceinline__ void mask_tile(f32x16& p0, f32x16& p1, int dq, unsigned Wk) {
    const float NEG = -__builtin_inff();
#pragma unroll
    for (int r = 0; r < 16; ++r) {
        const int c = KS * ((r & 3) + 8 * (r >> 2));
        if ((unsigned)(dq - c) >= Wk) p0[r] = NEG;
        if ((unsigned)(dq - c - KS * 32) >= Wk) p1[r] = NEG;
    }
}
__device__ __forceinline__ void kill_tile(f32x16& p0, f32x16& p1, bool keep) {
    const float NEG = -__builtin_inff();
#pragma unroll
    for (int r = 0; r < 16; ++r) { p0[r] = keep ? p0[r] : NEG; p1[r] = keep ? p1[r] : NEG; }
}
__device__ __forceinline__ void partialSM(f32x16& p0, f32x16& p1, float& m_reg, float& mn, float& alpha) {
    float pmax = p0[0]; for (int r = 1; r < 16; ++r) pmax = fmaxf(pmax, p0[r]); for (int r = 0; r < 16; ++r) pmax = fmaxf(pmax, p1[r]);
    { auto rr = __builtin_amdgcn_permlane32_swap(__float_as_uint(pmax), __float_as_uint(pmax), false, false);
      pmax = fmaxf(__uint_as_float(rr[0]), __uint_as_float(rr[1])); }
    constexpr float C2 = 1.4426950408889634f * SCALE;
    if (__builtin_expect(__all((pmax - m_reg) * SCALE <= THR), 1)) { mn = m_reg; alpha = 1.f; }
    else { mn = fmaxf(m_reg, pmax); alpha = __builtin_amdgcn_exp2f((m_reg - mn) * C2); m_reg = mn; }
    const float mnL = PSH - mn * C2;
    for (int r = 0; r < 16; ++r) p0[r] = fmaf(p0[r], C2, mnL); for (int r = 0; r < 16; ++r) p1[r] = fmaf(p1[r], C2, mnL);
    for (int r = 0; r < 16; ++r) p0[r] = __builtin_amdgcn_exp2f(p0[r]);
}
__device__ __forceinline__ void pack_p(const f32x16& p0, const f32x16& p1, fi8& pa) {
#pragma unroll
    for (int i = 0; i < 4; ++i) { pa[i] = (int)pk4f8(p0[4 * i], p0[4 * i + 1], p0[4 * i + 2], p0[4 * i + 3]); pa[4 + i] = (int)pk4f8(p1[4 * i], p1[4 * i + 1], p1[4 * i + 2], p1[4 * i + 3]); }
}
__device__ __forceinline__ void finishSM(f32x16& p0, f32x16& p1, float alpha, float& l_reg, fi8& pa) {
    for (int r = 0; r < 16; ++r) p1[r] = __builtin_amdgcn_exp2f(p1[r]);
    float ps = 0; for (int r = 0; r < 16; ++r) ps += p0[r]; for (int r = 0; r < 16; ++r) ps += p1[r];
    { auto rr = __builtin_amdgcn_permlane32_swap(__float_as_uint(ps), __float_as_uint(ps), false, false);
      ps = __uint_as_float(rr[0]) + __uint_as_float(rr[1]); }
    l_reg = l_reg * alpha + ps;
    pack_p(p0, p1, pa);
}
template <int KB, bool SK>
__device__ __forceinline__ void qkt(f32x16& p0, f32x16& p1, const char* kb, const fi8* qr, bool act) {
    if (SK && !act) { const float NEG = -__builtin_inff();
#pragma unroll
        for (int r = 0; r < 16; ++r) { p0[r] = NEG; p1[r] = NEG; } return; }
    p0 = f32x16{}; p1 = f32x16{};
    const fi8 a00 = ld32(kb + KB * SHM_K), a10 = ld32(kb + KB * SHM_K + 32 * KPITCH), a01 = ld32(kb + KB * SHM_K + 64), a11 = ld32(kb + KB * SHM_K + 32 * KPITCH + 64);
    __builtin_amdgcn_s_setprio(1);
    p0 = mfma8(a00, qr[0], p0, SC_IN, SC_IN); p1 = mfma8(a10, qr[0], p1, SC_IN, SC_IN);
    p0 = mfma8(a01, qr[1], p0, SC_IN, SC_IN); p1 = mfma8(a11, qr[1], p1, SC_IN, SC_IN);
    __builtin_amdgcn_s_setprio(0);
}
template <int VB, bool SK>
__device__ __forceinline__ void pv_tile(f32x16* o, const char* vb, fi8 pa, bool act) {
    if (SK && !act) return;
    const fi8 b0 = ld32(vb + VB * SHM_V), b1 = ld32(vb + VB * SHM_V + 32 * VPITCH), b2 = ld32(vb + VB * SHM_V + 64 * VPITCH), b3 = ld32(vb + VB * SHM_V + 96 * VPITCH);
    __builtin_amdgcn_s_setprio(1);
    o[0] = mfma8(pa, b0, o[0], 127, SC_IN); o[1] = mfma8(pa, b1, o[1], 127, SC_IN); o[2] = mfma8(pa, b2, o[2], 127, SC_IN); o[3] = mfma8(pa, b3, o[3], 127, SC_IN);
    __builtin_amdgcn_s_setprio(0);
}

struct BlockRef { const unsigned char* Q; const unsigned char* K; const unsigned char* V; bf16* O; const unsigned* selsrc; int P0, ksh, W, sel; };
struct Seam { fi8 qr[2]; v4u st_v, st_k; };
__device__ __forceinline__ int blk_jlo(const BlockRef& b) { const int lowk = (b.P0 >> b.ksh) - b.W + 1; return lowk > 0 ? lowk / KVBLK : 0; }
#define FA_VMW() asm volatile("s_waitcnt vmcnt(0)" ::: "memory")
#define FA_VMWN(n) asm volatile("s_waitcnt vmcnt(%0)" :: "i"(n) : "memory")
#define FA_SLOAD_H(Kp, Vp, k0) do { S.st_v = *(const v4u*)((Vp) + (size_t)(tid >> 2) * SEQ_V + (k0) + (tid & 3) * 16);              \
                         S.st_k = *(const v4u*)((Kp) + (size_t)((k0) + (tid >> 3)) * D + (tid & 7) * 16); } while (0)
#define FA_SWRITE_HK(bf) do { *(v4u*)(K_lds + (bf) * SHM_K + kws) = S.st_k; } while (0)
#define FA_SWRITE_HV(bf) do { *(v4u*)(V_lds + (bf) * SHM_V + vws) = S.st_v; } while (0)
#define FA_SWRITE_H(bf) do { FA_SWRITE_HV(bf); FA_SWRITE_HK(bf); } while (0)
#define FA_QLOAD(Qp) do { const unsigned char* q_ = (Qp) + (size_t)(wid * QBLK + r32) * D + hi * 32; const v4u a_ = *(const v4u*)q_, b_ = *(const v4u*)(q_ + 16), c_ = *(const v4u*)(q_ + 64), d_ = *(const v4u*)(q_ + 80); \
        S.qr[0] = fi8{(int)a_.x, (int)a_.y, (int)a_.z, (int)a_.w, (int)b_.x, (int)b_.y, (int)b_.z, (int)b_.w}; S.qr[1] = fi8{(int)c_.x, (int)c_.y, (int)c_.z, (int)c_.w, (int)d_.x, (int)d_.y, (int)d_.z, (int)d_.w}; } while (0)

__device__ __forceinline__ int selrow() { int t = threadIdx.x; asm volatile("" : "+v"(t)); return (((t >> 6) * QBLK + (t & 31)) >> 2) * 4; }
__device__ __forceinline__ void fa_prime(const BlockRef& cur, char* lds, Seam& S) {
    const int tid = threadIdx.x, wid = __builtin_amdgcn_readfirstlane(tid >> 6), lane = tid & 63, r32 = lane & 31, hi = lane >> 5;
    const int kws = (tid >> 3) * KPITCH + (tid & 7) * 16; char* K_lds = lds + NVB * SHM_V;
    const int kb0 = blk_jlo(cur) * KVBLK;
    FA_QLOAD(cur.Q);
    FA_SLOAD_H(cur.K, cur.V, kb0); FA_VMW(); FA_SWRITE_HK(0);
    __syncthreads();
}
template <class BG>
__device__ __forceinline__ void fa_block(const BlockRef& cur, const BlockRef& nxt, int skv, char* lds, Seam& S, unsigned* qhead, LAS int* qslot, BG& bg) {
    constexpr bool SK = true;
    const int tid = threadIdx.x, wid = __builtin_amdgcn_readfirstlane(tid >> 6), lane = tid & 63, r32 = lane & 31, hi = lane >> 5;
    const int ksh = cur.ksh, W = cur.W; const bool selm = cur.sel != 0;
    const int j_lo = blk_jlo(cur);
    int j_hi = ((cur.P0 + QB - 1) >> ksh) / KVBLK + 1; if (j_hi > skv / KVBLK) j_hi = skv / KVBLK;
    const int NT = j_hi - j_lo;
    const int kbn = blk_jlo(nxt) * KVBLK;
    const int qlo = cur.P0 + wid * QBLK;
    const int tlo = qlo >> ksh, thi = (qlo + QBLK - 1) >> ksh;
#define DQB() ({ int l2_ = threadIdx.x; asm volatile("" : "+v"(l2_)); qlo + (l2_ & 31) - ((4 * ((l2_ >> 5) & 1)) << ksh); })
    const unsigned Wk = (unsigned)W << ksh;
    char* V_lds = lds; char* K_lds = lds + NVB * SHM_V;
    float* ws = (float*)(lds + WS_OFF) + wid * 64; float* li_l = ws, * al_l = ws + 32;
    unsigned* selmask = (unsigned*)(lds + SELM_OFF);
    int tid2 = threadIdx.x; asm volatile("" : "+v"(tid2));
    const unsigned selw = cur.selsrc[tid2 & 255];
    int tkt = 0; if (tid2 == 0) tkt = (int)__hip_atomic_fetch_add(qhead, 1u, RLX_AGENT);
    float m_reg = -1e30f, l_reg = 0; f32x16 o[4] = {};
    const int kws = (tid >> 3) * KPITCH + (tid & 7) * 16, vws = (tid >> 2) * VPITCH + (tid & 3) * 16;
    const char* vb0 = V_lds + r32 * VPITCH + hi * 32; const char* kb0r = K_lds + r32 * KPITCH + hi * 32;
    const unsigned char* Kh = cur.K; const unsigned char* Vh = cur.V;
#define RESC(a) do { if (__any((a) < 1.f)) { if (hi == 0) al_l[r32] = (a); asm volatile("s_waitcnt lgkmcnt(0)" ::: "memory");              \
                     for (int d_ = 0; d_ < 4; ++d_) for (int r = 0; r < 16; ++r) o[d_][r] *= al_l[crow(r, hi)]; } } while (0)
#define KBASE(t) ((j_lo + (t)) * KVBLK)
#define GEO(t) (KBASE(t) <= thi && KBASE(t) + KVBLK - 1 >= tlo - W + 1)
#define SELBIT(t) ((!selm || (j_lo + (t)) == 0) ? true : (((selmask[selrow() + ((j_lo + (t)) >> 5)] >> ((j_lo + (t)) & 31)) & 1u) != 0u))
#define MASKT(P0_, P1_, t, act_, bit_) do { const int kb_ = KBASE(t); if (act_) { if (kb_ + KVBLK - 1 > tlo || kb_ <= thi - W) { \
        if (ksh) mask_tile<4>(P0_, P1_, DQB() - (kb_ << 2), Wk); else mask_tile<1>(P0_, P1_, DQB() - kb_, Wk); } \
        if (selm) kill_tile(P0_, P1_, bit_); } } while (0)
    constexpr int NQL = 4;
#define SEAM_K0() do { FA_VMWN(NQL); FA_SWRITE_HK(0); SBAR(); } while (0)
    f32x16 pA0, pA1, pB0, pB1; float mnA, mnB, alA, alB; fi8 pa;
    bool bitA, bitB, actA, actB;
    FA_SWRITE_HV(0); SBAR();
    if (NT > 1) { FA_SLOAD_H(Kh, Vh, KBASE(1)); }
    bitA = true; actA = GEO(0);
    if (selm && j_lo != 0) { bitA = SELBIT(0); actA = actA && __any(bitA); }
    SBAR(); qkt<0, SK>(pA0, pA1, kb0r, S.qr, actA);
    MASKT(pA0, pA1, 0, actA, bitA); partialSM(pA0, pA1, m_reg, mnA, alA);
    if (NT > 1) { FA_VMW(); FA_SWRITE_H(1); }
    if (selm && tid2 < 256) selmask[tid2] = selw;
    if (tid2 == 0) *qslot = tkt;
    __syncthreads();
#define VADV(x) ((x) == NVB - 1 ? 0 : (x) + 1)
#define HALF_STEP(PX0, PX1, mnX, alX, actX, bitX, PY0, PY1, alY, actY, t, KB, HOOK) do {                                     \
        bitX = SELBIT(t); actX = GEO(t) && (!selm || __any(bitX));                                                            \
        SBAR(); qkt<KB, SK>(PX0, PX1, kb0r, S.qr, actX);                                                            \
        finishSM(PY0, PY1, alY, l_reg, pa); SBAR();                                                           \
        int dj_ = 0;                                                                                                          \
        if ((t) + 1 < NT) { FA_SLOAD_H(Kh, Vh, KBASE((t) + 1)); SBAR(); if (HOOK) { dj_ = bg.slot_mid(); SBAR(); } }          \
        pv_tile<0, SK>(o, vb0 + vp * SHM_V, pa, actY); MASKT(PX0, PX1, (t), actX, bitX); partialSM(PX0, PX1, m_reg, mnX, alX); \
        if ((t) + 1 < NT) { if (dj_) FA_VMWN(8); else FA_VMW(); FA_SWRITE_HV(vn); FA_SWRITE_HK((KB) ^ 1); }                   \
        vp = VADV(vp); vn = VADV(vn);                                                                                         \
        RESC(alX); __syncthreads(); } while (0)
    int vp = 0, vn = 2;
    for (int t = 1; t + 1 < NT; t += 2) {
        HALF_STEP(pB0, pB1, mnB, alB, actB, bitB, pA0, pA1, alA, actA, t, 1, false);
        HALF_STEP(pA0, pA1, mnA, alA, actA, bitA, pB0, pB1, alB, actB, t + 1, 0, true);
    }
    const bool even = (NT & 1) == 0;
    if (even) { bitB = SELBIT(NT - 1); actB = GEO(NT - 1) && (!selm || __any(bitB)); SBAR(); qkt<1, SK>(pB0, pB1, kb0r, S.qr, actB); SBAR(); }
    FA_SLOAD_H(nxt.K, nxt.V, kbn); SBAR();
    FA_QLOAD(nxt.Q);
    SBAR();
    finishSM(pA0, pA1, alA, l_reg, pa); SBAR();
    pv_tile<0, SK>(o, vb0 + vp * SHM_V, pa, actA);
    if (even) { MASKT(pB0, pB1, NT - 1, actB, bitB); partialSM(pB0, pB1, m_reg, mnB, alB); __syncthreads(); RESC(alB);
        finishSM(pB0, pB1, alB, l_reg, pa); SBAR(); pv_tile<0, SK>(o, vb0 + VADV(vp) * SHM_V, pa, actB); }
    SBAR(); SEAM_K0();
    if (hi == 0) li_l[r32] = l_reg; asm volatile("s_waitcnt lgkmcnt(0)" ::: "memory");
    float rli[16];
#pragma unroll
    for (int r = 0; r < 16; ++r) { const float lv = li_l[crow(r, hi)]; rli[r] = lv > 0.f ? __builtin_amdgcn_rcpf(lv) : 0.f; }
    int t3 = threadIdx.x; asm volatile("" : "+v"(t3));
    bf16* Ow = cur.O + (unsigned)(((t3 >> 6) * QBLK + 4 * ((t3 >> 5) & 1)) * D + (t3 & 31));
#pragma unroll
    for (int r = 0; r < 16; ++r) { const int orow = (r & 3) + 8 * (r >> 2);
#pragma unroll
        for (int d0 = 0; d0 < 4; ++d0) { const float v = o[d0][r] * rli[r];
            const float vn = __shfl_xor(v, 1);
            if ((t3 & 1) == 0) *(unsigned*)(Ow + orow * D + d0 * 32) = cvtpk(v, vn); } }
    __syncthreads();
#undef DQB
#undef RESC
#undef KBASE
#undef GEO
#undef SELBIT
#undef MASKT
#undef SEAM_K0
#undef HALF_STEP
#undef VADV
}
}
constexpr size_t MiB = 1u << 20;
constexpr size_t WS_CTL = 0, CTL_ZERO_BYTES = 1 * MiB;
constexpr size_t WS_ITEMS = 1 * MiB;
constexpr size_t WS_SCAL = 1 * MiB + 65536;
constexpr size_t WS_ROPE = 2 * MiB;
constexpr size_t WS_WIN_T = 4 * MiB, WS_WOUT_T = 28 * MiB, WS_WCAT = 36 * MiB;
constexpr size_t WS_XN = 40 * MiB;
constexpr size_t WS_QNSA = 104 * MiB;
constexpr size_t WS_KV6 = 136 * MiB, KV6_STRIDE = 10 * MiB;
constexpr size_t WS_KCA = WS_KV6, WS_VCA = WS_KV6 + KV6_STRIDE, WS_KSLC = WS_KV6 + 2 * KV6_STRIDE, WS_VSLC = WS_KV6 + 3 * KV6_STRIDE, WS_KWIN = WS_KV6 + 4 * KV6_STRIDE, WS_VWIN = WS_KV6 + 5 * KV6_STRIDE;
constexpr size_t WS_QD = 196 * MiB, WS_KD = 228 * MiB, WS_VD = 260 * MiB;
constexpr size_t WS_GATES = 292 * MiB;
constexpr size_t WS_G = 294 * MiB, G_STRIDE = 5 * MiB;
constexpr size_t WS_KCMP = 304 * MiB, WS_VCMP = 305 * MiB;
constexpr size_t WS_SELM = 306 * MiB;
constexpr size_t WS_OCMP = 308 * MiB, WS_OSLC = 340 * MiB, WS_OWIN = 372 * MiB;
constexpr size_t WS_ODIFF = 404 * MiB;
constexpr size_t WS_MIX = 468 * MiB;
constexpr size_t WS_HN = 532 * MiB;
constexpr size_t WS_LIST = 596 * MiB, WS_GATEW = 598 * MiB;
constexpr size_t WS_HB = 600 * MiB;
constexpr size_t WS_Q8NSA = 744 * MiB, WS_K8SLC = 760 * MiB, WS_K8WIN = 764 * MiB, WS_Q8D = 768 * MiB, WS_K8D = 784 * MiB;
constexpr size_t WS_VT = 800 * MiB;
constexpr size_t WS_HBF = 824 * MiB;
constexpr size_t WS_YS = 888 * MiB;
constexpr size_t WS_WGU_T = 1184 * MiB, WS_WD_T = 1656 * MiB;
constexpr size_t WS_INV = 1448 * MiB;
constexpr size_t WS_END = 1912 * MiB;
constexpr int CW_TMO = 0, CW_CODE = 1;
constexpr int CW_BAR = 4096;
constexpr int CW_QHEAD = 8192;
constexpr int CW_ECNT = 12288;
constexpr int CW_CHK = 16384;
constexpr int RING_BYTES = 131072;
constexpr int LDSX_OFF = RING_BYTES;
constexpr int LDSCTL_OFF = RING_BYTES + 8192, MISC_OFF = LDSCTL_OFF + 320;
constexpr int LDS_BYTES = 147456;
constexpr int NITEMS_ATT = 2048;

struct KArgs { const float* in[26]; float* out; unsigned char* ws; int ph_lo, ph_hi, rep, pad; };

struct DenseSched {
    const char* A; const char* Bt; int nM, nN, nwg, G, c;
    __device__ __forceinline__ void init(const void* A_, const void* Bt_, int M, int N, int G_, int c_) { A = (const char*)A_; Bt = (const char*)Bt_; nM = M / 256; nN = N / 256; nwg = nM * nN; G = G_; c = c_; }
    __device__ __forceinline__ const char* abase() const { return A; }
    __device__ __forceinline__ bool next(int i, pg8::Unit& u) const {
        const long L = (long)i * G + c; if (L >= nwg) return false;
        int wgid = (int)L; { const int q = nwg / 8, r = nwg % 8, xcd = wgid % 8, off = wgid / 8; wgid = (xcd < r ? xcd * (q + 1) : r * (q + 1) + (xcd - r) * q) + off; }
        const int nig = 8 * nN, gid = wgid / nig, fm = gid * 8, gsz = (nM - fm) < 8 ? (nM - fm) : 8;
        u.pm = fm + ((wgid % nig) % gsz); u.pn = (wgid % nig) / gsz; u.e = 0; u.rows = 256;
        if (nN == 8) u.pn = ((u.pn & 3) << 1) | (u.pn >> 2);
        return true;
    }
    __device__ __forceinline__ void avoff(const pg8::Unit& u, const int (&R)[2], const int (&C)[2], int KB, unsigned& v00, unsigned& v01, unsigned& v10, unsigned& v11) const {
        const unsigned base = (unsigned)(u.pm * 256) * (unsigned)KB;
        v00 = base + (unsigned)(R[0] * KB + C[0] * 2); v01 = base + (unsigned)(R[1] * KB + C[1] * 2);
        v10 = v00 + (unsigned)(128 * KB); v11 = v01 + (unsigned)(128 * KB);
    }
    __device__ __forceinline__ const char* btile(const pg8::Unit& u, int KB) const { return Bt + (size_t)u.pn * 256 * KB; }
};
struct CmpSched {
    const char* A; const char* Bt; int c;
    __device__ __forceinline__ const char* abase() const { return A; }
    __device__ __forceinline__ bool next(int i, pg8::Unit& u) const { if (i > 0 || c >= 36) return false; u.e = c / 18; const int r = c % 18; u.pm = r >> 1; u.pn = r & 1; u.rows = 256; return true; }
    __device__ __forceinline__ void avoff(const pg8::Unit& u, const int (&R)[2], const int (&C)[2], int KB, unsigned& v00, unsigned& v01, unsigned& v10, unsigned& v11) const {
        const unsigned base = (unsigned)u.e * (unsigned)KV6_STRIDE + (unsigned)(u.pm * 256) * (unsigned)KB;
        v00 = base + (unsigned)(R[0] * KB + C[0] * 2); v01 = base + (unsigned)(R[1] * KB + C[1] * 2);
        v10 = v00 + (unsigned)(128 * KB); v11 = v01 + (unsigned)(128 * KB);
    }
    __device__ __forceinline__ const char* btile(const pg8::Unit& u, int KB) const { return Bt + ((size_t)u.e * 512 + (size_t)u.pn * 256) * KB; }
};
template <bool GATHER, int NT_>
struct MoeSched {
    const char* A; const char* Bt; size_t bstride; const int* list; const LAS int* tb; const LAS int* cnt; int G, c, ntot;
    __device__ __forceinline__ const char* abase() const { return A; }
    __device__ __forceinline__ bool next(int i, pg8::Unit& u) const {
        int mt;
        if (G == 256) {
            const int x = c & 7, j = c >> 3;
            if (NT_ == 16) { u.pn = (x & 3) * 4 + (j & 3); mt = i * 16 + (x >> 2) * 8 + (j >> 2); }
            else           { u.pn = (x & 1) * 4 + (j & 3); mt = i * 32 + (x >> 1) * 8 + (j >> 2); }
            if (mt >= ntot) return false;
        } else { const long L = (long)i * G + c; if (L >= (long)ntot * NT_) return false; mt = (int)(L / NT_); u.pn = (int)(L % NT_); }
        u.pm = mt;
        int e = 0;
#pragma unroll
        for (int st = 16; st > 0; st >>= 1) e = (__builtin_amdgcn_readfirstlane(tb[e + st]) <= mt) ? e + st : e;
        u.e = e; const int left = __builtin_amdgcn_readfirstlane(cnt[e]) - (mt - __builtin_amdgcn_readfirstlane(tb[e])) * 256; u.rows = left < 256 ? left : 256; return true;
    }
    __device__ __forceinline__ void avoff(const pg8::Unit& u, const int (&R)[2], const int (&C)[2], int KB, unsigned& v00, unsigned& v01, unsigned& v10, unsigned& v11) const {
        if constexpr (GATHER) {
            const int* le = list + (size_t)u.e * TOK + (size_t)(u.pm - __builtin_amdgcn_readfirstlane(tb[u.e])) * 256;
            const int lim = u.rows - 1;
            const int r00 = R[0] < lim ? R[0] : lim, r01 = R[1] < lim ? R[1] : lim, r10 = R[0] + 128 < lim ? R[0] + 128 : lim, r11 = R[1] + 128 < lim ? R[1] + 128 : lim;
            v00 = (unsigned)(le[r00] >> 2) * (unsigned)KB + (unsigned)C[0] * 2u; v01 = (unsigned)(le[r01] >> 2) * (unsigned)KB + (unsigned)C[1] * 2u;
            v10 = (unsigned)(le[r10] >> 2) * (unsigned)KB + (unsigned)C[0] * 2u; v11 = (unsigned)(le[r11] >> 2) * (unsigned)KB + (unsigned)C[1] * 2u;
        } else {
            const unsigned base = (unsigned)(u.pm * 256) * (unsigned)KB;
            v00 = base + (unsigned)(R[0] * KB + C[0] * 2); v01 = base + (unsigned)(R[1] * KB + C[1] * 2);
            v10 = v00 + (unsigned)(128 * KB); v11 = v01 + (unsigned)(128 * KB);
        }
    }
    __device__ __forceinline__ const char* btile(const pg8::Unit& u, int KB) const { return Bt + (size_t)u.e * bstride + (size_t)u.pn * 256 * KB; }
};

#ifndef EPI_NT
#define EPI_NT 0
#endif
#if EPI_NT
#define EPI_ST(ptr_, val_) __builtin_nontemporal_store((val_), (ptr_))
#else
#define EPI_ST(ptr_, val_) (*(ptr_) = (val_))
#endif
__device__ __forceinline__ unsigned f8pk4(float a, float b, float c, float d) { int w = __builtin_amdgcn_cvt_pk_fp8_f32(a, b, 0, false); w = __builtin_amdgcn_cvt_pk_fp8_f32(c, d, w, true); return (unsigned)w; }
__device__ __forceinline__ v4u pack8bf(const f32x4 a, const f32x4 b) { v4u w; w.x = cvtpk(a[0], a[1]); w.y = cvtpk(a[2], a[3]); w.z = cvtpk(b[0], b[1]); w.w = cvtpk(b[2], b[3]); return w; }
struct NoPre {};
struct EpiInProj {
    unsigned char* ws; typedef NoPre Pre;
    __device__ __forceinline__ Pre prefetch(const pg8::Unit&, int, int, int, int) const { return Pre{}; }
    __device__ __forceinline__ void operator()(const f32x4 (&acc)[2][2][4][2], const pg8::Unit& u, int wr, int wc, int fr, int fq, const Pre&) const {
        const int pn = u.pn, cw = wc * 32 + 8 * fq;
        if (pn == 22) {
            if (wc == 0 && fq < 3) { float* gates = (float*)(ws + WS_GATES);
#pragma unroll
                for (int ai = 0; ai < 2; ++ai)
#pragma unroll
                    for (int m = 0; m < 4; ++m) { const int row = u.pm * 256 + ai * 128 + wr * 64 + m * 16 + fr; f32x4 a = acc[ai][0][m][0], b = acc[ai][0][m][1];
#pragma unroll
                        for (int k = 0; k < 4; ++k) { a[k] = 1.f / (1.f + __expf(-a[k])); b[k] = 1.f / (1.f + __expf(-b[k])); }
                        *(f32x4*)(gates + (size_t)row * 24 + cw) = a; *(f32x4*)(gates + (size_t)row * 24 + cw + 4) = b; } }
            return;
        }
#pragma unroll
        for (int bj = 0; bj < 2; ++bj) {
            size_t base, sb, st;
            if (pn < 4) { const int kvh = pn >> 1, g = 2 * (pn & 1) + bj; base = WS_QNSA / 2 + ((size_t)kvh * SEQ * 4 + g) * 128; sb = (size_t)2 * SEQ * 512; st = 512; }
            else if (pn < 10) { base = (WS_KV6 + (size_t)(pn - 4) * KV6_STRIDE) / 2 + (size_t)bj * SEQ * 128; sb = (size_t)2 * SEQ * 128; st = 128; }
            else { const int idx = pn - 10, h = idx & 3; const size_t rb = idx < 4 ? WS_QD : (idx < 8 ? WS_KD : WS_VD); base = rb / 2 + (size_t)(h * 2 + bj) * SEQ * 128; sb = (size_t)8 * SEQ * 128; st = 128; }
            bf16* dst0 = (bf16*)ws + base + cw;
#pragma unroll
            for (int ai = 0; ai < 2; ++ai)
#pragma unroll
                for (int m = 0; m < 4; ++m) { const int row = u.pm * 256 + ai * 128 + wr * 64 + m * 16 + fr, b = row >> 13, t = row & (SEQ - 1);
                    EPI_ST((v4u*)(dst0 + (size_t)b * sb + (size_t)t * st), pack8bf(acc[ai][bj][m][0], acc[ai][bj][m][1])); }
        }
    }
};
struct EpiG {
    unsigned char* ws; typedef NoPre Pre;
    __device__ __forceinline__ Pre prefetch(const pg8::Unit&, int, int, int, int) const { return Pre{}; }
    __device__ __forceinline__ void operator()(const f32x4 (&acc)[2][2][4][2], const pg8::Unit& u, int wr, int wc, int fr, int fq, const Pre&) const {
        float* G = (float*)(ws + WS_G + (size_t)u.e * G_STRIDE);
#pragma unroll
        for (int ai = 0; ai < 2; ++ai)
#pragma unroll
            for (int m = 0; m < 4; ++m) { const int row = u.pm * 256 + ai * 128 + wr * 64 + m * 16 + fr;
#pragma unroll
                for (int bj = 0; bj < 2; ++bj) { float* p = G + (size_t)row * 512 + u.pn * 256 + bj * 128 + wc * 32 + 8 * fq; *(f32x4*)p = acc[ai][bj][m][0]; *(f32x4*)(p + 4) = acc[ai][bj][m][1]; } }
    }
};
#ifndef PROBE_EPI
#define PROBE_EPI 0
#endif
struct EpiOutProj {
    const float* x; bf16* h; int probe; typedef NoPre Pre;
    __device__ __forceinline__ Pre prefetch(const pg8::Unit&, int, int, int, int) const { return Pre{}; }
    __device__ __forceinline__ void operator()(const f32x4 (&acc)[2][2][4][2], const pg8::Unit& u, int wr, int wc, int fr, int fq, const Pre&) const {
        if (PROBE_EPI == 2 && probe) return;
#pragma unroll
        for (int ai = 0; ai < 2; ++ai) {
            f32x4 xv[4][2][2];
#pragma unroll
            for (int m = 0; m < 4; ++m) { const int row = u.pm * 256 + ai * 128 + wr * 64 + m * 16 + fr;
#pragma unroll
                for (int bj = 0; bj < 2; ++bj) { const size_t o = (size_t)row * DM + u.pn * 256 + bj * 128 + wc * 32 + 8 * fq; if (PROBE_EPI == 1 && probe) { xv[m][bj][0] = acc[ai][bj][m][1]; xv[m][bj][1] = acc[ai][bj][m][0]; } else { xv[m][bj][0] = *(const GAS f32x4*)(x + o); xv[m][bj][1] = *(const GAS f32x4*)(x + o + 4); } } }
#pragma unroll
            for (int m = 0; m < 4; ++m) { const int row = u.pm * 256 + ai * 128 + wr * 64 + m * 16 + fr;
#pragma unroll
                for (int bj = 0; bj < 2; ++bj) { const size_t o = (size_t)row * DM + u.pn * 256 + bj * 128 + wc * 32 + 8 * fq;
                    const f32x4 s0 = xv[m][bj][0] + acc[ai][bj][m][0], s1 = xv[m][bj][1] + acc[ai][bj][m][1];
                    v4u pk; pk.x = pk2(s0.x, s0.y); pk.y = pk2(s0.z, s0.w); pk.z = pk2(s1.x, s1.y); pk.w = pk2(s1.z, s1.w);
                    EPI_ST((v4u*)(h + o), pk); } }
        }
    }
};
struct EpiGateUp {
    const float* bgu; unsigned char* HB; int probe;
    struct Pre { f32x4 g0, g1, u0, u1; };
    __device__ __forceinline__ Pre prefetch(const pg8::Unit& u, int wr, int wc, int fr, int fq) const {
        const float* bg = bgu + (size_t)u.e * 4096 + u.pn * 128 + wc * 32 + 8 * fq; Pre p; p.g0 = *(const f32x4*)bg; p.g1 = *(const f32x4*)(bg + 4); p.u0 = *(const f32x4*)(bg + 2048); p.u1 = *(const f32x4*)(bg + 2052); return p; }
    __device__ __forceinline__ void operator()(const f32x4 (&acc)[2][2][4][2], const pg8::Unit& u, int wr, int wc, int fr, int fq, const Pre& pre) const {
        if (PROBE_EPI == 2 && probe) return;
        const int col = u.pn * 128 + wc * 32 + 8 * fq;
        const f32x4 g0 = pre.g0, g1 = pre.g1, u0 = pre.u0, u1 = pre.u1;
#pragma unroll
        for (int ai = 0; ai < 2; ++ai)
#pragma unroll
            for (int m = 0; m < 4; ++m) { const int r = ai * 128 + wr * 64 + m * 16 + fr;
                f32x4 ga = acc[ai][0][m][0] + g0, gb = acc[ai][0][m][1] + g1, ua = acc[ai][1][m][0] + u0, ub = acc[ai][1][m][1] + u1, ha, hb;
#pragma unroll
                for (int k = 0; k < 4; ++k) {
                    float gl = fminf(ga[k], 7.f), up = __builtin_amdgcn_fmed3f(ua[k], -7.f, 7.f), q = gl * __builtin_amdgcn_rcpf(1.f + __builtin_amdgcn_exp2f(gl * (-1.702f * LOG2E))); ha[k] = fmaf(up, q, q);
                    gl = fminf(gb[k], 7.f); up = __builtin_amdgcn_fmed3f(ub[k], -7.f, 7.f); q = gl * __builtin_amdgcn_rcpf(1.f + __builtin_amdgcn_exp2f(gl * (-1.702f * LOG2E))); hb[k] = fmaf(up, q, q); }
                if (r < u.rows) { v2u o; o.x = f8pk4(ha[0], ha[1], ha[2], ha[3]); o.y = f8pk4(hb[0], hb[1], hb[2], hb[3]); EPI_ST((v2u*)(HB + (size_t)(u.pm * 256 + r) * DFF + col), o); } }
    }
};
#define MOE_ATOMIC 0
struct EpiDown {
    const float* bd; bf16* YS; const int* list; const float* gatew; const LAS int* tb; float* out; int probe;
    struct Pre { float gw[2][4]; f32x4 bv[2][2]; };
    __device__ __forceinline__ Pre prefetch(const pg8::Unit& u, int wr, int wc, int fr, int fq) const {
        const size_t lbase = (size_t)u.e * TOK + (size_t)(u.pm - __builtin_amdgcn_readfirstlane(tb[u.e])) * 256; Pre p;
#pragma unroll
        for (int ai = 0; ai < 2; ++ai)
#pragma unroll
            for (int m = 0; m < 4; ++m) { const int r = ai * 128 + wr * 64 + m * 16 + fr, rc = r < u.rows ? r : u.rows - 1; p.gw[ai][m] = gatew[lbase + rc]; }
#pragma unroll
        for (int bj = 0; bj < 2; ++bj) { const float* b = bd + (size_t)u.e * DM + u.pn * 256 + bj * 128 + wc * 32 + 8 * fq; p.bv[bj][0] = *(const f32x4*)b; p.bv[bj][1] = *(const f32x4*)(b + 4); }
        return p; }
    __device__ __forceinline__ void operator()(const f32x4 (&acc)[2][2][4][2], const pg8::Unit& u, int wr, int wc, int fr, int fq, const Pre& pre) const {
        if (PROBE_EPI == 2 && probe) return;
#pragma unroll
        for (int ai = 0; ai < 2; ++ai)
#pragma unroll
            for (int m = 0; m < 4; ++m) { const int r = ai * 128 + wr * 64 + m * 16 + fr;
                if (r < u.rows) {
#pragma unroll
                    for (int bj = 0; bj < 2; ++bj) { const int col = u.pn * 256 + bj * 128 + wc * 32 + 8 * fq;
                        const f32x4 a = (acc[ai][bj][m][0] + pre.bv[bj][0]) * pre.gw[ai][m], c = (acc[ai][bj][m][1] + pre.bv[bj][1]) * pre.gw[ai][m];
                        EPI_ST((v4u*)(YS + (size_t)(u.pm * 256 + r) * DM + col), pack8bf(a, c)); } } }
    }
};

template <bool F8>
__device__ __forceinline__ void p0_transpose_item(const float* W, int ldw, void* WT, int ldt, int k0, int n0s, int n0d, int nvalid, float wscale, LAS float* scr, int lane) {
    f32x4 v[16]; const int kk0 = lane >> 3, n4 = (lane & 7) * 4;
#pragma unroll
    for (int i = 0; i < 16; ++i) v[i] = n4 < nvalid ? *(const GAS f32x4*)(W + (size_t)(k0 + 8 * i + kk0) * ldw + n0s + n4) : (f32x4){0.f, 0.f, 0.f, 0.f};
#pragma unroll
    for (int i = 0; i < 16; ++i) { LAS float* s = scr + (8 * i + kk0) * 33 + n4; s[0] = v[i].x; s[1] = v[i].y; s[2] = v[i].z; s[3] = v[i].w; }
    LDS_WAIT(); asm volatile("" ::: "memory");
    if constexpr (F8) {
        const int c = lane & 7;
#pragma unroll
        for (int j = 0; j < 4; ++j) { const int n = (lane >> 3) + 8 * j; const LAS float* s = scr + (16 * c) * 33 + n; v4u o;
            o.x = f8pk4(s[0 * 33] * wscale, s[1 * 33] * wscale, s[2 * 33] * wscale, s[3 * 33] * wscale); o.y = f8pk4(s[4 * 33] * wscale, s[5 * 33] * wscale, s[6 * 33] * wscale, s[7 * 33] * wscale);
            o.z = f8pk4(s[8 * 33] * wscale, s[9 * 33] * wscale, s[10 * 33] * wscale, s[11 * 33] * wscale); o.w = f8pk4(s[12 * 33] * wscale, s[13 * 33] * wscale, s[14 * 33] * wscale, s[15 * 33] * wscale);
            *(GAS v4u*)((unsigned char*)WT + (size_t)(n0d + n) * ldt + k0 + 16 * c) = o; }
    } else {
        const int c = lane & 15;
#pragma unroll
        for (int j = 0; j < 8; ++j) { const int n = (lane >> 4) + 4 * j; const LAS float* s = scr + (8 * c) * 33 + n;
            v4u o; o.x = pk2(s[0 * 33], s[1 * 33]); o.y = pk2(s[2 * 33], s[3 * 33]); o.z = pk2(s[4 * 33], s[5 * 33]); o.w = pk2(s[6 * 33], s[7 * 33]);
            *(GAS v4u*)((bf16*)WT + (size_t)(n0d + n) * ldt + k0 + 8 * c) = o; }
    }
    LDS_WAIT(); asm volatile("" ::: "memory");
}
#ifndef BG_IN_FLASH
#define BG_IN_FLASH 1
#endif
constexpr int BG_ITEMS = 32 * 16 * 128 + 32 * 16 * 64, BG_TILE_BYTES = 64 * 33 * 4, BG_LDS_OFF = 69632;
struct BgItem { const float* W; unsigned char* WT; int ldw, k0, n0s, n0d; };
__device__ __forceinline__ BgItem bg_decode(const KArgs& a, int I) {
    BgItem b;
    if (I < 65536) { const int e = I >> 11, q = I & 2047, kb = q >> 7, nb = q & 127, n0 = nb * 32, bj = n0 >> 11, rem = n0 & 2047, pn = rem >> 7, i0 = rem & 127;
        b.W = a.in[22] + (size_t)e * 2048 * 4096; b.ldw = 4096; b.WT = a.ws + WS_WGU_T + (size_t)e * 4096 * 2048; b.k0 = kb * 128; b.n0s = n0; b.n0d = pn * 256 + bj * 128 + i0; }
    else { const int J = I - 65536, e = J >> 10, q = J & 1023, kb = q >> 6, nb = q & 63;
        b.W = a.in[24] + (size_t)e * 2048 * 2048; b.ldw = 2048; b.WT = a.ws + WS_WD_T + (size_t)e * 2048 * 2048; b.k0 = kb * 128; b.n0s = nb * 32; b.n0d = nb * 32; }
    return b;
}
__device__ __forceinline__ void bg_load(const BgItem& b, f32x4 (&v)[16], int lane) {
    const unsigned voff = (unsigned)(((lane >> 3) * b.ldw + (lane & 7) * 4) * 4);
#pragma unroll
    for (int i = 0; i < 16; ++i) v[i] = *(const GAS f32x4*)((const char*)(b.W + (size_t)(b.k0 + 8 * i) * b.ldw + b.n0s) + voff);
}
__device__ __forceinline__ void bg_store(const BgItem& b, const f32x4 (&v)[16], LAS float* scr, int lane) {
    const int kk0 = lane >> 3, n4 = (lane & 7) * 4;
#pragma unroll
    for (int hf = 0; hf < 2; ++hf) {
#pragma unroll
        for (int i = 0; i < 8; ++i) { LAS float* s = scr + (8 * i + kk0) * 33 + n4; const f32x4 x = v[hf * 8 + i]; s[0] = x.x; s[1] = x.y; s[2] = x.z; s[3] = x.w; }
        LDS_WAIT(); asm volatile("" ::: "memory");
        const int c = lane & 3;
#pragma unroll
        for (int j = 0; j < 2; ++j) { const int n = (lane >> 2) + 16 * j; const LAS float* s = scr + (16 * c) * 33 + n; v4u o;
            o.x = f8pk4(s[0 * 33] * 32.f, s[1 * 33] * 32.f, s[2 * 33] * 32.f, s[3 * 33] * 32.f); o.y = f8pk4(s[4 * 33] * 32.f, s[5 * 33] * 32.f, s[6 * 33] * 32.f, s[7 * 33] * 32.f);
            o.z = f8pk4(s[8 * 33] * 32.f, s[9 * 33] * 32.f, s[10 * 33] * 32.f, s[11 * 33] * 32.f); o.w = f8pk4(s[12 * 33] * 32.f, s[13 * 33] * 32.f, s[14 * 33] * 32.f, s[15 * 33] * 32.f);
            *(GAS v4u*)(b.WT + (size_t)(b.n0d + n) * 2048 + b.k0 + 64 * hf + 16 * c) = o; }
        LDS_WAIT(); asm volatile("" ::: "memory");
    }
}
__device__ __forceinline__ void bg_conv_item(const KArgs& a, LAS float* scr, int I, int lane) { f32x4 v[16]; const BgItem b = bg_decode(a, I); bg_load(b, v, lane); bg_store(b, v, scr, lane); }
__device__ __forceinline__ void bg_conv_pair(const KArgs& a, LAS float* scr, int I0, int I1, int lane) {
    f32x4 va[16], vb[16]; const BgItem b0 = bg_decode(a, I0), b1 = bg_decode(a, I1);
    bg_load(b0, va, lane); bg_load(b1, vb, lane); bg_store(b0, va, scr, lane); bg_store(b1, vb, scr, lane);
}
struct BgAsync {
    const KArgs& a; LAS float* tile; int I, st, q, pend, pq, on, tick; BgItem pb;
    __device__ __forceinline__ void convert() {
        int l_ = threadIdx.x; asm volatile("" : "+v"(l_)); const int n = l_ & 31, c = (l_ >> 5) & 1;
#pragma unroll
        for (int g = 0; g < 2; ++g) { const LAS float* s = tile + (16 * (c + 2 * g)) * 32 + n; float x[16];
#pragma unroll
            for (int j = 0; j < 16; ++j) x[j] = s[j * 32];
            v4u o; o.x = f8pk4(x[0] * 32.f, x[1] * 32.f, x[2] * 32.f, x[3] * 32.f); o.y = f8pk4(x[4] * 32.f, x[5] * 32.f, x[6] * 32.f, x[7] * 32.f);
            o.z = f8pk4(x[8] * 32.f, x[9] * 32.f, x[10] * 32.f, x[11] * 32.f); o.w = f8pk4(x[12] * 32.f, x[13] * 32.f, x[14] * 32.f, x[15] * 32.f);
            *(GAS v4u*)(pb.WT + (size_t)(pb.n0d + n) * 2048 + pb.k0 + 64 * pq + 16 * (c + 2 * g)) = o; }
        LDS_WAIT(); asm volatile("" ::: "memory");
    }
    __device__ __forceinline__ void issue() {
        pb = bg_decode(a, I); int l_ = threadIdx.x; asm volatile("" : "+v"(l_));
        const unsigned voff = (unsigned)((((l_ >> 3) & 7) * pb.ldw + (l_ & 7) * 4) * 4);
#pragma unroll
        for (int i = 0; i < 8; ++i) { unsigned o_ = voff; asm volatile("" : "+v"(o_)); __builtin_amdgcn_global_load_lds((const unsigned*)((const char*)(pb.W + (size_t)(pb.k0 + 64 * q + 8 * i) * pb.ldw + pb.n0s) + o_), (LAS unsigned*)((LAS unsigned char*)tile + i * 1024), 16, 0, 0); }
        pq = q; pend = 1; if (++q == 2) { q = 0; I += st; }
    }
    __device__ __forceinline__ int slot_mid() {
        if (!on) return 0;
        if ((tick ^= 1) != 0) return 0;
        if (pend) { asm volatile("s_waitcnt vmcnt(2)" ::: "memory"); convert(); pend = 0; }
        if (I < BG_ITEMS) { issue(); return 1; }
        return 0;
    }
    __device__ __forceinline__ void drain(LAS float* scr, int lane) {
        if (!on) return;
        if (pend) { VM_WAIT(); convert(); pend = 0; }
        if (q != 0 && I < BG_ITEMS) { issue(); VM_WAIT(); convert(); pend = 0; }
        _Pragma("unroll 1") while (I < BG_ITEMS) { if (I + st < BG_ITEMS) { bg_conv_pair(a, scr, I, I + st, lane); I += 2 * st; } else { bg_conv_item(a, scr, I, lane); I += st; } }
    }
};
__device__ __forceinline__ void p0_prologue(const KArgs& a, LAS unsigned char* lds, int gw, int NGW, int wave, int lane) {
    unsigned char* ws = a.ws;
    LAS float* scr = (LAS float*)(lds + wave * 16896);
    const int gtid = blockIdx.x * 512 + threadIdx.x, GT = gridDim.x * 512;
    for (int idx = gtid; idx < SEQ * 16; idx += GT) { const int pos = idx >> 4, i = idx & 15; const float inv = powf(500000.f, -(float)(2 * i) / 32.f); const float ang = (float)pos * inv;
        ((float*)(ws + WS_ROPE))[idx] = cosf(ang); ((float*)(ws + WS_ROPE))[SEQ * 16 + idx] = sinf(ang); }
    for (int idx = gtid; idx < 2 * 256 * 2048; idx += GT) { const int e = idx / (256 * 2048), r = (idx / 2048) % 256, cidx = idx % 2048;
        const float v = r < 2 ? a.in[5 + e][r * 2048 + cidx] : 0.f; ((bf16*)(ws + WS_KCA + (size_t)e * KV6_STRIDE))[(size_t)(2048 + r) * 2048 + cidx] = (bf16)f2bf(v); }
    if (blockIdx.x == 1 && wave == 0) { float s1 = a.in[13][lane] * a.in[14][lane] + a.in[13][lane + 64] * a.in[14][lane + 64], s2 = a.in[15][lane] * a.in[16][lane] + a.in[15][lane + 64] * a.in[16][lane + 64];
        s1 = wave_sum(s1); s2 = wave_sum(s2); if (lane == 0) ((float*)(ws + WS_SCAL))[0] = expf(s1) - expf(s2) + 0.2f; }
    if (blockIdx.x == 0 && threadIdx.x == 0) { int* it = (int*)(ws + WS_ITEMS); int n = 0;
        for (int c = 128; c >= 1; --c) {
            if ((c & 3) == 0) { const int qb = c / 4 - 1; for (int id = 0; id < 32; ++id) it[n++] = (0 << 16) | (id << 8) | qb; }
            { const int u = c - 1; for (int id = 0; id < 4; ++id) it[n++] = (1 << 16) | (id << 8) | u; }
            if (c < 9) { const int u = c - 1; for (int id = 0; id < 4; ++id) it[n++] = (2 << 16) | (id << 8) | u; }
            else if (c == 9) { for (int u = 8; u < 128; ++u) for (int id = 0; id < 4; ++id) it[n++] = (2 << 16) | (id << 8) | u; }
        } }
    constexpr int I_IN = 16 * 184, I_OUT = 16 * 64, I_CAT = 2 * 2 * 16 * 8;
    constexpr int NIT = I_IN + I_OUT + I_CAT;
    for (int it = gw; it < NIT; it += NGW) {
        int r = it;
        if (r < I_IN) { const int kb = r / 184, nb = r % 184, n0 = nb * 32; int ns, nv;
            if (n0 < 2560) { ns = n0; nv = 32; } else if (n0 < 5632) { ns = n0 + 24; nv = 32; } else if (n0 == 5632) { ns = 2560; nv = 24; } else { ns = 0; nv = 0; }
            p0_transpose_item<false>(a.in[2], 5656, ws + WS_WIN_T, 2048, kb * 128, ns, n0, nv, 1.f, scr, lane); continue; } r -= I_IN;
        if (r < I_OUT) { const int kb = r / 64, nb = r % 64; p0_transpose_item<false>(a.in[18], 2048, ws + WS_WOUT_T, 2048, kb * 128, nb * 32, nb * 32, 32, 1.f, scr, lane); continue; } r -= I_OUT;
        { const int e = r / 256, q = r % 256, part = q / 128, kb = (q % 128) / 8, nb = q % 8;
            p0_transpose_item<false>(a.in[e ? 9 : 7] + (size_t)part * 2048 * 256, 256, ws + WS_WCAT + (size_t)e * 2 * MiB, 2048, kb * 128, nb * 32, part * 256 + nb * 32, 32, 1.f, scr, lane); }
    }
    if (!BG_IN_FLASH) { for (int I = gw; I < BG_ITEMS; I += NGW) bg_conv_item(a, scr, I, lane); }
    for (int m = gw; m < TOK; m += 2 * NGW) {
        const int m2 = m + NGW < TOK ? m + NGW : m;
        const GAS f32x4* xr = (const GAS f32x4*)(a.in[0] + (size_t)m * DM) + lane; const GAS f32x4* xr2 = (const GAS f32x4*)(a.in[0] + (size_t)m2 * DM) + lane; const GAS f32x4* gr = (const GAS f32x4*)a.in[1] + lane;
        f32x4 v[8], w[8]; float s = 0.f, s2 = 0.f;
#pragma unroll
        for (int j = 0; j < 8; ++j) { v[j] = xr[64 * j]; w[j] = xr2[64 * j]; }
#pragma unroll
        for (int j = 0; j < 8; ++j) { s += (v[j].x * v[j].x + v[j].y * v[j].y) + (v[j].z * v[j].z + v[j].w * v[j].w); s2 += (w[j].x * w[j].x + w[j].y * w[j].y) + (w[j].z * w[j].z + w[j].w * w[j].w); }
        const float rstd = 1.f / sqrtf(wave_sum(s) * (1.f / DM) + NORM_EPS), rstd2 = 1.f / sqrtf(wave_sum(s2) * (1.f / DM) + NORM_EPS);
        GAS unsigned long long* o8 = (GAS unsigned long long*)(ws + WS_XN + (size_t)m * DM * 2) + lane; GAS unsigned long long* o82 = (GAS unsigned long long*)(ws + WS_XN + (size_t)m2 * DM * 2) + lane;
#pragma unroll
        for (int j = 0; j < 8; ++j) { const f32x4 g = gr[64 * j];
            o8[64 * j] = (unsigned long long)pk2(v[j].x * rstd * g.x, v[j].y * rstd * g.y) | ((unsigned long long)pk2(v[j].z * rstd * g.z, v[j].w * rstd * g.w) << 32);
            o82[64 * j] = (unsigned long long)pk2(w[j].x * rstd2 * g.x, w[j].y * rstd2 * g.y) | ((unsigned long long)pk2(w[j].z * rstd2 * g.z, w[j].w * rstd2 * g.w) << 32); }
    }
}

__device__ __forceinline__ void p1b_norm(const KArgs& a, int gw, int NGW, int lane) {
    unsigned char* ws = a.ws; const float* ropec = (const float*)(ws + WS_ROPE); const float* ropes = ropec + SEQ * 16;
    constexpr int R0 = TOK * 8, R1 = TOK * 2;
    const int sub = lane & 15, rq = lane >> 4;
#define NLOAD(S, u, r4_) { const int rr_ = (r4_) + (u) * NGW; ok##S##u = rr_ < n4;                                                                  \
        if (ok##S##u) { const int row = rr_ * 4 + rq; w##S##u = *(const v4u*)(base + (size_t)row * 128 + sub * 8);                                   \
            if (sub < 4) { const int pos = (row >> psh) & (SEQ - 1); const float* cp = ropec + pos * 16 + (sub & 1) * 8; const float* sp = ropes + pos * 16 + (sub & 1) * 8; \
                c0##S##u = *(const f32x4*)cp; c1##S##u = *(const f32x4*)(cp + 4); s0##S##u = *(const f32x4*)sp; s1##S##u = *(const f32x4*)(sp + 4); } } }
#define NDO(S, u, r4_) if (ok##S##u) { const int row = ((r4_) + (u) * NGW) * 4 + rq; const v4u w = w##S##u;                                         \
        float x[8] = {bflo(w.x), bfhi(w.x), bflo(w.y), bfhi(w.y), bflo(w.z), bfhi(w.z), bflo(w.w), bfhi(w.w)};                                        \
        float ss = 0.f;                                                                                                                              \
        _Pragma("unroll") for (int k = 0; k < 8; ++k) ss += x[k] * x[k];                                                                             \
        ss += __shfl_xor(ss, 1); ss += __shfl_xor(ss, 2); ss += __shfl_xor(ss, 4); ss += __shfl_xor(ss, 8);                                           \
        const float rstd = 1.f / sqrtf(ss * (1.f / 128.f) + NORM_EPS);                                                                               \
        x[0] *= rstd * gv0.x; x[1] *= rstd * gv0.y; x[2] *= rstd * gv0.z; x[3] *= rstd * gv0.w; x[4] *= rstd * gv1.x; x[5] *= rstd * gv1.y; x[6] *= rstd * gv1.z; x[7] *= rstd * gv1.w; \
        const float cc[8] = {c0##S##u.x, c0##S##u.y, c0##S##u.z, c0##S##u.w, c1##S##u.x, c1##S##u.y, c1##S##u.z, c1##S##u.w};                         \
        const float sn[8] = {s0##S##u.x, s0##S##u.y, s0##S##u.z, s0##S##u.w, s1##S##u.x, s1##S##u.y, s1##S##u.z, s1##S##u.w};                         \
        float y[8];                                                                                                                                  \
        _Pragma("unroll") for (int k = 0; k < 8; ++k) { const float other = __shfl_xor(x[k], 2);                                                     \
            y[k] = sub < 2 ? x[k] * cc[k] - other * sn[k] : (sub < 4 ? x[k] * cc[k] + other * sn[k] : x[k]); }                                         \
        v4u o; o.x = pk2(y[0], y[1]); o.y = pk2(y[2], y[3]); o.z = pk2(y[4], y[5]); o.w = pk2(y[6], y[7]); if (wb) *(v4u*)(base + (size_t)row * 128 + sub * 8) = o; \
        v2u o8; o8.x = f8pk4(16.f * y[0], 16.f * y[1], 16.f * y[2], 16.f * y[3]); o8.y = f8pk4(16.f * y[4], 16.f * y[5], 16.f * y[6], 16.f * y[7]);     \
        *(v2u*)(b8 + (size_t)row * 128 + sub * 8) = o8; }
#define NDECL(S, u) bool ok##S##u = false; v4u w##S##u = {0u, 0u, 0u, 0u}; f32x4 c0##S##u = {1.f, 1.f, 1.f, 1.f}, c1##S##u = c0##S##u, s0##S##u = {0.f, 0.f, 0.f, 0.f}, s1##S##u = s0##S##u;
#define NLOAD4(S, r4_) NLOAD(S, 0, r4_) NLOAD(S, 1, r4_) NLOAD(S, 2, r4_) NLOAD(S, 3, r4_)
#define NDO4(S, r4_) NDO(S, 0, r4_) NDO(S, 1, r4_) NDO(S, 2, r4_) NDO(S, 3, r4_)
    _Pragma("unroll 1") for (int t = 0; t < 5; ++t) {
        bf16* base; unsigned char* b8; const float* g; int n4, psh = 0;
        if (t == 0) { base = (bf16*)(ws + WS_QNSA); b8 = ws + WS_Q8NSA; g = a.in[3]; n4 = R0 / 4; psh = 2; }
        else if (t == 1) { base = (bf16*)(ws + WS_KSLC); b8 = ws + WS_K8SLC; g = a.in[4] + 128; n4 = R1 / 4; }
        else if (t == 2) { base = (bf16*)(ws + WS_KWIN); b8 = ws + WS_K8WIN; g = a.in[4] + 256; n4 = R1 / 4; }
        else if (t == 3) { base = (bf16*)(ws + WS_QD); b8 = ws + WS_Q8D; g = a.in[11]; n4 = R0 / 4; }
        else { base = (bf16*)(ws + WS_KD); b8 = ws + WS_K8D; g = a.in[12]; n4 = R0 / 4; }
        const f32x4 gv0 = *(const f32x4*)(g + sub * 8), gv1 = *(const f32x4*)(g + sub * 8 + 4);
        const bool wb = t == 0 || MK_CHECK;
        NDECL(A, 0) NDECL(A, 1) NDECL(A, 2) NDECL(A, 3) NDECL(B, 0) NDECL(B, 1) NDECL(B, 2) NDECL(B, 3)
        int r = gw;
        NLOAD4(A, r)
        _Pragma("unroll 1") while (r < n4) {
            NLOAD4(B, r + 4 * NGW)
            NDO4(A, r)
            r += 4 * NGW; if (r >= n4) break;
            NLOAD4(A, r + 4 * NGW)
            NDO4(B, r)
            r += 4 * NGW;
        }
    }
#undef NLOAD
#undef NDO
#undef NDECL
#undef NLOAD4
#undef NDO4
}
__device__ __forceinline__ void p1c_vt(const KArgs& a, int gw, int NGW, int lane) {
    unsigned char* ws = a.ws;
    for (int it = gw; it < 24 * (SEQ / 64); it += NGW) {
        const int pl = it >> 7, tile = it & 127;
        const bf16* src = (const bf16*)(ws + (pl < 4 ? WS_VSLC : (pl < 8 ? WS_VWIN : WS_VD))) + ((size_t)(pl < 4 ? pl : (pl < 8 ? pl - 4 : pl - 8)) * SEQ + tile * 64) * 128;
        unsigned char* dst = ws + WS_VT + ((size_t)pl * 128 + 2 * lane) * SEQ + tile * 64;
#pragma unroll
        for (int c = 0; c < 4; ++c) {
            unsigned w[16];
#pragma unroll
            for (int i = 0; i < 16; ++i) { const int key = 32 * (c & 1) + (i & 3) + 8 * (i >> 2) + 4 * (c >> 1); w[i] = ((const unsigned*)(src + (size_t)key * 128))[lane]; }
            v4u lo, hi;
            lo.x = f8pk4(16.f * bflo(w[0]), 16.f * bflo(w[1]), 16.f * bflo(w[2]), 16.f * bflo(w[3]));     hi.x = f8pk4(16.f * bfhi(w[0]), 16.f * bfhi(w[1]), 16.f * bfhi(w[2]), 16.f * bfhi(w[3]));
            lo.y = f8pk4(16.f * bflo(w[4]), 16.f * bflo(w[5]), 16.f * bflo(w[6]), 16.f * bflo(w[7]));     hi.y = f8pk4(16.f * bfhi(w[4]), 16.f * bfhi(w[5]), 16.f * bfhi(w[6]), 16.f * bfhi(w[7]));
            lo.z = f8pk4(16.f * bflo(w[8]), 16.f * bflo(w[9]), 16.f * bflo(w[10]), 16.f * bflo(w[11]));   hi.z = f8pk4(16.f * bfhi(w[8]), 16.f * bfhi(w[9]), 16.f * bfhi(w[10]), 16.f * bfhi(w[11]));
            lo.w = f8pk4(16.f * bflo(w[12]), 16.f * bflo(w[13]), 16.f * bflo(w[14]), 16.f * bflo(w[15])); hi.w = f8pk4(16.f * bfhi(w[12]), 16.f * bfhi(w[13]), 16.f * bfhi(w[14]), 16.f * bfhi(w[15]));
            *(v4u*)(dst + c * 16) = lo; *(v4u*)(dst + SEQ + c * 16) = hi;
        }
    }
}

__device__ __forceinline__ float gelu_tanh(float x) { const float u = 0.7978845608028654f * (x + 0.044715f * x * x * x); return 0.5f * x * (1.f + tanhf(u)); }
__device__ __forceinline__ void p2b_compress2(const KArgs& a, LAS unsigned char* lds) {
    unsigned char* ws = a.ws; const int tid = threadIdx.x, wave = tid >> 6, lane = tid & 63;
    LAS float* h1 = (LAS float*)lds;
    LAS float* cb = (LAS float*)(lds + 16384);
    const float* ropec = (const float*)(ws + WS_ROPE); const float* ropes = ropec + SEQ * 16;
    for (int item = blockIdx.x; item < 256; item += gridDim.x) {
        const int e = item >> 7, r0 = (item & 127) * 16;
        const float* G = (const float*)(ws + WS_G + (size_t)e * G_STRIDE); const float* w2 = a.in[e ? 10 : 8];
        __syncthreads();
        for (int idx = tid; idx < 16 * 256; idx += 512) { const int r = idx >> 8, n = idx & 255, row = r0 + r;
            const float v = G[(size_t)row * 512 + n] + G[(size_t)(row + 1) * 512 + 256 + n] + G[(size_t)2048 * 512 + n] + G[(size_t)2049 * 512 + 256 + n];
            h1[idx] = gelu_tanh(v); }
        __syncthreads();
        const int d = tid & 127, rg = tid >> 7; float acc0 = 0.f, acc1 = 0.f, acc2 = 0.f, acc3 = 0.f;
#pragma unroll 4
        for (int n = 0; n < 256; ++n) { const float w = w2[n * 128 + d]; acc0 += h1[(rg * 4 + 0) * 256 + n] * w; acc1 += h1[(rg * 4 + 1) * 256 + n] * w; acc2 += h1[(rg * 4 + 2) * 256 + n] * w; acc3 += h1[(rg * 4 + 3) * 256 + n] * w; }
        cb[(rg * 4 + 0) * 128 + d] = acc0; cb[(rg * 4 + 1) * 128 + d] = acc1; cb[(rg * 4 + 2) * 128 + d] = acc2; cb[(rg * 4 + 3) * 128 + d] = acc3;
        __syncthreads();
#pragma unroll
        for (int rr = 0; rr < 2; ++rr) { const int r = wave * 2 + rr, row = r0 + r, i = row & 511;
            float x0 = cb[r * 128 + lane], x1 = cb[r * 128 + lane + 64];
            bf16* dst = (bf16*)(ws + (e ? WS_VCMP : WS_KCMP)) + (size_t)row * 128;
            if (e == 0) {
                const float ss = wave_sum(x0 * x0 + x1 * x1); const float rstd = 1.f / sqrtf(ss * (1.f / 128.f) + NORM_EPS);
                x0 *= rstd * a.in[4][lane]; x1 *= rstd * a.in[4][lane + 64];
                const int pos = 16 * i + 31; const float other = __shfl_xor(x0, 16);
                if (lane < 32 && pos < SEQ) { const int ai = lane & 15; const float c = ropec[pos * 16 + ai], s = ropes[pos * 16 + ai]; x0 = lane < 16 ? x0 * c - other * s : x0 * c + other * s; }
            }
            if (i == 511) { x0 = 0.f; x1 = 0.f; }
            dst[lane] = (bf16)f2bf(x0); dst[lane + 64] = (bf16)f2bf(x1);
        }
    }
    __syncthreads();
}
__device__ __forceinline__ void p4_cmp_unit(const KArgs& a, char* lds, int unit) {
    using namespace fa16;
    unsigned char* ws = a.ws;
    const int tid = threadIdx.x, wid = __builtin_amdgcn_readfirstlane(tid >> 6), lane = tid & 63, r32 = lane & 31, hi = lane >> 5;
    const int bk = unit >> 7, u = unit & 127;
    char* V_lds = lds; char* K_lds = lds + 2 * SHM_V;
    float* imp = (float*)(lds + 69632);
    const bf16* Q = (const bf16*)(ws + WS_QNSA) + ((size_t)bk * SEQ + 64 * u) * 512;
    const bf16* Kc = (const bf16*)(ws + WS_KCMP) + (size_t)bk * NCMPP * 128;
    const bf16* Vc = (const bf16*)(ws + WS_VCMP) + (size_t)bk * NCMPP * 128;
    bf16* Oc = (bf16*)(ws + WS_OCMP) + ((size_t)bk * SEQ + 64 * u) * 512;
    bf16x8 qr[8];
#pragma unroll
    for (int d0 = 0; d0 < 8; ++d0) qr[d0] = load8(Q + (size_t)(wid * 32 + r32) * 128 + d0 * 16 + hi * 8);
    const int trow = 64 * u + ((wid * 32 + r32) >> 2);
    const int imax = (trow - 31) >> 4;
    const int ntile = ((4 * u + 2) >> 6) + 1;
    constexpr float C2 = LOG2E * SCALE; const float NEG = -__builtin_inff();
    const int sr = tid >> 4, sc = (tid & 15) * 8, vst0 = v_st(sr, sc), vst1 = v_st(32 + sr, sc), kws = KSWZ(sr, sc * 2);
    const int vb0 = (int)(uintptr_t)V_lds + v_rd_base(lane);
    float m = -1e30f, l = 0.f;
    bf16x8 sk0 = load8(Kc + (size_t)sr * 128 + sc), sk1 = load8(Kc + (size_t)(32 + sr) * 128 + sc), sv0, sv1;
    for (int kt = 0; kt < ntile; ++kt) {
        __syncthreads();
        *(bf16x8*)(K_lds + kws) = sk0; *(bf16x8*)(K_lds + kws + 32 * 256) = sk1;
        __syncthreads();
        { const int nk = kt + 1 < ntile ? kt + 1 : 0;
          sk0 = load8(Kc + (size_t)(64 * nk + sr) * 128 + sc); sk1 = load8(Kc + (size_t)(64 * nk + 32 + sr) * 128 + sc); }
        f32x16 p0, p1; qkt<0, false>(p0, p1, K_lds, r32, hi, qr, true);
        float pmax = NEG;
#pragma unroll
        for (int r = 0; r < 16; ++r) { const int i0 = 64 * kt + crow(r, hi); if (i0 > imax) p0[r] = NEG; if (i0 + 32 > imax) p1[r] = NEG; pmax = fmaxf(pmax, fmaxf(p0[r], p1[r])); }
        { auto rr = __builtin_amdgcn_permlane32_swap(__float_as_uint(pmax), __float_as_uint(pmax), false, false); pmax = fmaxf(__uint_as_float(rr[0]), __uint_as_float(rr[1])); }
        const float mn = fmaxf(m, pmax); float ps = 0.f;
#pragma unroll
        for (int r = 0; r < 16; ++r) ps += __builtin_amdgcn_exp2f((p0[r] - mn) * C2) + __builtin_amdgcn_exp2f((p1[r] - mn) * C2);
        { auto rr = __builtin_amdgcn_permlane32_swap(__float_as_uint(ps), __float_as_uint(ps), false, false); ps = __uint_as_float(rr[0]) + __uint_as_float(rr[1]); }
        l = l * __builtin_amdgcn_exp2f((m - mn) * C2) + ps; m = mn;
    }
    const float rl = l > 0.f ? 1.f / l : 0.f;
    f32x16 o[4] = {}; float carry = 0.f;
    sv0 = load8(Vc + (size_t)sr * 128 + sc); sv1 = load8(Vc + (size_t)(32 + sr) * 128 + sc);
    for (int kt = 0; kt < ntile; ++kt) {
        __syncthreads();
        *(bf16x8*)(K_lds + kws) = sk0; *(bf16x8*)(K_lds + kws + 32 * 256) = sk1;
        *(bf16x8*)(V_lds + vst0) = sv0; *(bf16x8*)(V_lds + vst1) = sv1;
        __syncthreads();
        if (kt + 1 < ntile) { sk0 = load8(Kc + (size_t)(64 * (kt + 1) + sr) * 128 + sc); sk1 = load8(Kc + (size_t)(64 * (kt + 1) + 32 + sr) * 128 + sc);
                              sv0 = load8(Vc + (size_t)(64 * (kt + 1) + sr) * 128 + sc); sv1 = load8(Vc + (size_t)(64 * (kt + 1) + 32 + sr) * 128 + sc); }
        f32x16 p0, p1; qkt<0, false>(p0, p1, K_lds, r32, hi, qr, true);
#pragma unroll
        for (int r = 0; r < 16; ++r) { const int i0 = 64 * kt + crow(r, hi);
            p0[r] = i0 > imax ? 0.f : __builtin_amdgcn_exp2f((p0[r] - m) * C2) * rl; p1[r] = i0 + 32 > imax ? 0.f : __builtin_amdgcn_exp2f((p1[r] - m) * C2) * rl; }
        float Lq[8], Qs[8];
#pragma unroll
        for (int s = 0; s < 4; ++s) { Qs[s] = (p0[4 * s] + p0[4 * s + 1]) + (p0[4 * s + 2] + p0[4 * s + 3]); Lq[s] = p0[4 * s + 3];
                                      Qs[4 + s] = (p1[4 * s] + p1[4 * s + 1]) + (p1[4 * s + 2] + p1[4 * s + 3]); Lq[4 + s] = p1[4 * s + 3]; }
#pragma unroll
        for (int s = 0; s < 8; ++s) { const float av = s == 0 ? carry : Lq[s - 1], bv = Lq[s];
            auto rr = __builtin_amdgcn_permlane32_swap(__float_as_uint(av), __float_as_uint(bv), false, false);
            const float recv = hi ? __uint_as_float(rr[0]) : __uint_as_float(rr[1]);
            float v = Qs[s] + recv; v += __shfl_xor(v, 1); v += __shfl_xor(v, 2);
            if ((r32 & 3) == 0) imp[(wid * 8 + (r32 >> 2)) * 128 + 16 * kt + 2 * s + hi] = v; }
        carry = Lq[7];
        bf16x8 pa0, pa1, pa2, pa3; pack_p(p0, p1, pa0, pa1, pa2, pa3);
        pv_tile<0, false>(o, vb0, pa0, pa1, pa2, pa3, true);
    }
    { bf16* Ow = Oc + (size_t)(wid * 32) * 128;
#pragma unroll
      for (int r = 0; r < 16; ++r) { const int orow = crow(r, hi);
#pragma unroll
        for (int d0 = 0; d0 < 4; ++d0) { const float v = o[d0][r]; const float vn = __shfl_xor(v, 1);
            if ((r32 & 1) == 0) *(unsigned*)(Ow + (size_t)orow * 128 + d0 * 32 + r32) = cvtpk(v, vn); } } }
    __syncthreads();
    { const int tl = lane >> 3, c = lane & 7; float v[16];
#pragma unroll
      for (int k = 0; k < 16; ++k) { const int j = 16 * c + k; const float x = imp[(wid * 8 + tl) * 128 + j];
          v[k] = j > u ? NEG : ((j == 0 || j == u || j == u - 1) ? 1e9f : x); }
      unsigned word = 0u;
#pragma unroll 1
      for (int round = 0; round < 16; ++round) {
          float best = v[0]; int bi = 16 * c;
#pragma unroll
          for (int k = 1; k < 16; ++k) if (v[k] > best) { best = v[k]; bi = 16 * c + k; }
#pragma unroll
          for (int x = 1; x < 8; x <<= 1) { const float ob = __shfl_xor(best, x); const int oi = __shfl_xor(bi, x); if (ob > best || (ob == best && oi < bi)) { best = ob; bi = oi; } }
          if (best > -1.0f) { if ((bi >> 5) == c) word |= 1u << (bi & 31);
#pragma unroll
              for (int k = 0; k < 16; ++k) if (16 * c + k == bi) v[k] = NEG; }
      }
      if (c < 4) ((unsigned*)(ws + WS_SELM))[((size_t)bk * SEQ + 64 * u + wid * 8 + tl) * 4 + c] = word; }
    __syncthreads();
}

__device__ __forceinline__ fa::BlockRef p5_ref(unsigned char* ws, int item) {
    const int kind = item >> 16, id = (item >> 8) & 255, x = item & 255; fa::BlockRef r;
    r.selsrc = (const unsigned*)(ws + WS_SELM);
    if (kind == 0) { const int bhc = id >> 1, half = id & 1, bh = id >> 2;
        r.Q = ws + WS_Q8D + ((size_t)bhc * SEQ + 256 * x) * 128; r.K = ws + WS_K8D + (size_t)bhc * SEQ * 128;
        r.V = ws + WS_VT + (size_t)(8 + bh * 2 + half) * SEQ * 128; r.O = (bf16*)(ws + WS_ODIFF) + ((size_t)id * SEQ + 256 * x) * 128;
        r.P0 = 256 * x; r.ksh = 0; r.W = 1 << 20; r.sel = 0; }
    else { const size_t ro = ((size_t)id * SEQ + 64 * x) * 512;
        r.Q = ws + WS_Q8NSA + ro; r.K = ws + (kind == 1 ? WS_K8SLC : WS_K8WIN) + (size_t)id * SEQ * 128; r.V = ws + WS_VT + (size_t)((kind == 1 ? 0 : 4) + id) * SEQ * 128;
        r.O = (bf16*)(ws + (kind == 1 ? WS_OSLC : WS_OWIN)) + ro; r.P0 = 256 * x; r.ksh = 2; r.W = kind == 1 ? (1 << 20) : 512; r.sel = kind == 1 ? 1 : 0;
        if (kind == 1) r.selsrc = (const unsigned*)(ws + WS_SELM) + ((size_t)id * SEQ + 64 * x) * 4; }
    return r;
}
__device__ __forceinline__ void p5_flash(const KArgs& a, char* lds, LAS int* qslot, int rep, int vcu) {
    unsigned char* ws = a.ws; const int tid = threadIdx.x, wave = __builtin_amdgcn_readfirstlane(tid >> 6), lane = tid & 63;
    unsigned* head = (unsigned*)(ws + WS_CTL) + CW_QHEAD + 64 * rep; const int* items = (const int*)(ws + WS_ITEMS);
    int t0_ = threadIdx.x; asm volatile("" : "+v"(t0_)); const int w0_ = __builtin_amdgcn_readfirstlane(t0_ >> 6);
    BgAsync bg{a, (LAS float*)((LAS unsigned char*)lds + BG_LDS_OFF + w0_ * BG_TILE_BYTES), __builtin_amdgcn_readfirstlane(vcu * NWAVES + wave), (int)gridDim.x * NWAVES, 0, 0, 0, (rep == 0 && BG_IN_FLASH) ? 1 : 0, 0, BgItem{}};
#define P5_FETCH(dst) do { if (tid == 0) *qslot = (int)__hip_atomic_fetch_add(head, 1u, RLX_AGENT); __syncthreads(); dst = __builtin_amdgcn_readfirstlane(*qslot); __syncthreads(); } while (0)
    int ci, ni; P5_FETCH(ci);
    if (ci < NITEMS_ATT) {
        P5_FETCH(ni);
        fa::BlockRef cur = p5_ref(ws, items[ci]); fa::Seam S;
        fa::fa_prime(cur, lds, S);
        int par = 0;
        for (;;) {
            const bool last = ni >= NITEMS_ATT;
            const fa::BlockRef nxt = last ? cur : p5_ref(ws, items[ni]);
            fa::fa_block(cur, nxt, SEQ, lds, S, head, qslot + par, bg);
            ni = __builtin_amdgcn_readfirstlane(qslot[par]); par ^= 1;
            if (last) break;
            cur = nxt;
        }
    }
    { int t1_ = threadIdx.x; asm volatile("" : "+v"(t1_)); bg.drain(bg.tile, t1_ & 63); }
#undef P5_FETCH
}

__device__ __forceinline__ void p6_combine(const KArgs& a, int gw, int NGW, int lane) {
    unsigned char* ws = a.ws; const float lam = ((const float*)(ws + WS_SCAL))[0];
    const float* gates = (const float*)(ws + WS_GATES); const float* sg = a.in[17];
    for (int tok = gw; tok < TOK; tok += NGW) {
        const int b = tok >> 13, t = tok & (SEQ - 1); bf16* mix = (bf16*)(ws + WS_MIX) + (size_t)tok * DM;
#pragma unroll
        for (int c = 0; c < 2; ++c) { const int col = c * 512 + lane * 8, h = col >> 7, d = col & 127, kvh = h >> 2, g = h & 3;
            const size_t ro = ((((size_t)(b * 2 + kvh) * SEQ + t) * 4 + g) * 128 + d) * 2;
            const v4u oc = *(const v4u*)(ws + WS_OCMP + ro), os = *(const v4u*)(ws + WS_OSLC + ro), ow = *(const v4u*)(ws + WS_OWIN + ro);
            const float gc = gates[(size_t)tok * 24 + h * 3 + 0], gs = gates[(size_t)tok * 24 + h * 3 + 1], gwn = gates[(size_t)tok * 24 + h * 3 + 2];
            v4u o;
            o.x = pk2(gc * bflo(oc.x) + gs * bflo(os.x) + gwn * bflo(ow.x), gc * bfhi(oc.x) + gs * bfhi(os.x) + gwn * bfhi(ow.x));
            o.y = pk2(gc * bflo(oc.y) + gs * bflo(os.y) + gwn * bflo(ow.y), gc * bfhi(oc.y) + gs * bfhi(os.y) + gwn * bfhi(ow.y));
            o.z = pk2(gc * bflo(oc.z) + gs * bflo(os.z) + gwn * bflo(ow.z), gc * bfhi(oc.z) + gs * bfhi(os.z) + gwn * bfhi(ow.z));
            o.w = pk2(gc * bflo(oc.w) + gs * bflo(os.w) + gwn * bflo(ow.w), gc * bfhi(oc.w) + gs * bfhi(os.w) + gwn * bfhi(ow.w));
            *(v4u*)(mix + col) = o; }
#pragma unroll
        for (int c = 0; c < 2; ++c) { const int h = 2 * c + (lane >> 5), l32 = lane & 31, half = l32 >> 4, d = (l32 & 15) * 8;
            const size_t i0 = ((size_t)((((b * 4 + h) * 2 + 0) * 2 + half)) * SEQ + t) * 128 + d, i1 = ((size_t)((((b * 4 + h) * 2 + 1) * 2 + half)) * SEQ + t) * 128 + d;
            const v4u o0 = *(const v4u*)((const bf16*)(ws + WS_ODIFF) + i0), o1 = *(const v4u*)((const bf16*)(ws + WS_ODIFF) + i1);
            float x[8] = {bflo(o0.x) - lam * bflo(o1.x), bfhi(o0.x) - lam * bfhi(o1.x), bflo(o0.y) - lam * bflo(o1.y), bfhi(o0.y) - lam * bfhi(o1.y),
                          bflo(o0.z) - lam * bflo(o1.z), bfhi(o0.z) - lam * bfhi(o1.z), bflo(o0.w) - lam * bflo(o1.w), bfhi(o0.w) - lam * bfhi(o1.w)};
            float ss = 0.f;
#pragma unroll
            for (int k = 0; k < 8; ++k) ss += x[k] * x[k];
            ss += __shfl_xor(ss, 1); ss += __shfl_xor(ss, 2); ss += __shfl_xor(ss, 4); ss += __shfl_xor(ss, 8); ss += __shfl_xor(ss, 16);
            const float rstd = 0.8f / sqrtf(ss * (1.f / 256.f) + NORM_EPS);
            const float* gp = sg + half * 128 + d; const f32x4 g0 = *(const f32x4*)gp, g1 = *(const f32x4*)(gp + 4);
            v4u o; o.x = pk2(x[0] * rstd * g0.x, x[1] * rstd * g0.y); o.y = pk2(x[2] * rstd * g0.z, x[3] * rstd * g0.w); o.z = pk2(x[4] * rstd * g1.x, x[5] * rstd * g1.y); o.w = pk2(x[6] * rstd * g1.z, x[7] * rstd * g1.w);
            *(v4u*)(mix + 1024 + h * 256 + half * 128 + d) = o; }
    }
}

__device__ __forceinline__ void p8_router(const KArgs& a, char* lds) {
    unsigned char* ws = a.ws; const bf16* h = (const bf16*)(ws + WS_HBF); const float* gn = a.in[19]; const float* wr_ = a.in[20]; const float* br = a.in[21];
    const int tid = threadIdx.x, wave = __builtin_amdgcn_readfirstlane(tid >> 6), lane = tid & 63, n = lane & 31, kh = lane >> 5, tg = wave & 1, kq = wave >> 1;
    float* part = (float*)lds;
    float* ssp = (float*)(lds + 32768);
    float* rstd_l = (float*)(lds + 32768 + 1024);
    int* lcnt = (int*)(lds + 32768 + 2048);
    int* gbase = lcnt + 32;
    unsigned* ecnt = (unsigned*)(ws + WS_CTL) + CW_ECNT;
    for (int tile = blockIdx.x; tile < TOK / 64; tile += gridDim.x) {
        const int t0 = tile * 64;
        __syncthreads();
        if (tid < 32) lcnt[tid] = 0;
        const bf16* hrow = h + (size_t)(t0 + 32 * tg + n) * DM;
        f32x16 acc = {}; float ss = 0.f;
#pragma unroll 4
        for (int c = 0; c < 64; ++c) { const int kb = kq * 512 + 8 * c + 4 * kh;
            const v2u hw = *(const v2u*)(hrow + kb); const f32x4 hv = {bflo(hw.x), bfhi(hw.x), bflo(hw.y), bfhi(hw.y)}, gv = *(const f32x4*)(gn + kb);
            ss += (hv.x * hv.x + hv.y * hv.y) + (hv.z * hv.z + hv.w * hv.w);
#pragma unroll
            for (int e4 = 0; e4 < 4; ++e4) acc = __builtin_amdgcn_mfma_f32_32x32x2f32(wr_[(size_t)(kb + e4) * 32 + n], hv[e4] * gv[e4], acc, 0, 0, 0); }
        { auto rr = __builtin_amdgcn_permlane32_swap(__float_as_uint(ss), __float_as_uint(ss), false, false); ss = __uint_as_float(rr[0]) + __uint_as_float(rr[1]); }
#pragma unroll
        for (int r = 0; r < 16; ++r) part[((tg * 4 + kq) * 16 + r) * 64 + lane] = acc[r];
        if (kh == 0) ssp[(tg * 4 + kq) * 32 + n] = ss;
        __syncthreads();
        int te[4] = {0, 0, 0, 0}; float tgv[4] = {0.f, 0.f, 0.f, 0.f}; int rk[4] = {0, 0, 0, 0};
        if (kq == 0) {
            float lg[16]; const float sst = (ssp[(tg * 4 + 0) * 32 + n] + ssp[(tg * 4 + 1) * 32 + n]) + (ssp[(tg * 4 + 2) * 32 + n] + ssp[(tg * 4 + 3) * 32 + n]);
            const float rstd = 1.f / sqrtf(sst * (1.f / DM) + NORM_EPS);
            if (kh == 0) rstd_l[32 * tg + n] = rstd;
#pragma unroll
            for (int r = 0; r < 16; ++r) { const float s = (part[((tg * 4 + 0) * 16 + r) * 64 + lane] + part[((tg * 4 + 1) * 16 + r) * 64 + lane]) + (part[((tg * 4 + 2) * 16 + r) * 64 + lane] + part[((tg * 4 + 3) * 16 + r) * 64 + lane]);
                lg[r] = s * rstd + br[fa::crow(r, kh)]; }
            float tv[4];
#pragma unroll
            for (int k = 0; k < 4; ++k) { float best = lg[0]; int be = fa::crow(0, kh);
#pragma unroll
                for (int r = 1; r < 16; ++r) if (lg[r] > best) { best = lg[r]; be = fa::crow(r, kh); }
                auto rv = __builtin_amdgcn_permlane32_swap(__float_as_uint(best), __float_as_uint(best), false, false); auto re = __builtin_amdgcn_permlane32_swap((unsigned)be, (unsigned)be, false, false);
                const float ob = kh ? __uint_as_float(rv[0]) : __uint_as_float(rv[1]); const int oe = kh ? (int)re[0] : (int)re[1];
                if (ob > best || (ob == best && oe < be)) { best = ob; be = oe; }
                tv[k] = best; te[k] = be;
#pragma unroll
                for (int r = 0; r < 16; ++r) if (fa::crow(r, kh) == be) lg[r] = -__builtin_inff(); }
            const float e1 = __expf(tv[1] - tv[0]), e2 = __expf(tv[2] - tv[0]), e3 = __expf(tv[3] - tv[0]), inv = 1.f / (1.f + e1 + e2 + e3);
            tgv[0] = inv; tgv[1] = e1 * inv; tgv[2] = e2 * inv; tgv[3] = e3 * inv;
            if (kh == 0) {
#pragma unroll
                for (int k = 0; k < 4; ++k) rk[k] = atomicAdd(&lcnt[te[k]], 1); }
        }
        __syncthreads();
        if (tid < 32) gbase[tid] = (int)__hip_atomic_fetch_add(ecnt + 64 * tid, (unsigned)lcnt[tid], RLX_AGENT);
        __syncthreads();
        if (kq == 0 && kh == 0) { const int tok = t0 + 32 * tg + n;
#pragma unroll
            for (int k = 0; k < 4; ++k) { const size_t p = (size_t)te[k] * TOK + gbase[te[k]] + rk[k]; ((int*)(ws + WS_LIST))[p] = tok * 4 + k; ((float*)(ws + WS_GATEW))[p] = tgv[k]; ((int*)(ws + WS_INV))[tok * 4 + k] = (te[k] << 16) | (gbase[te[k]] + rk[k]); } }
#pragma unroll 1
        for (int q = 0; q < 8; ++q) { const int tl = wave * 8 + q; const float rs = rstd_l[tl];
            const GAS v2u* xr = (const GAS v2u*)(h + (size_t)(t0 + tl) * DM) + lane; const GAS f32x4* gr = (const GAS f32x4*)gn + lane;
            GAS unsigned* o4 = (GAS unsigned*)(ws + WS_HN + (size_t)(t0 + tl) * DM) + lane;
#pragma unroll
            for (int j = 0; j < 8; ++j) { const v2u vw = xr[64 * j]; const f32x4 g = gr[64 * j]; o4[64 * j] = f8pk4(bflo(vw.x) * rs * g.x, bfhi(vw.x) * rs * g.y, bflo(vw.y) * rs * g.z, bfhi(vw.y) * rs * g.w); } }
    }
    __syncthreads();
}

__device__ __forceinline__ void p11_final(const KArgs& a, int gw, int NGW, int lane, const LAS int* tb) {
    const bf16* YS = (const bf16*)(a.ws + WS_YS); const int* INV = (const int*)(a.ws + WS_INV);
    for (int tok = gw; tok < TOK; tok += NGW) {
        GAS f32x4* o = (GAS f32x4*)(a.out + (size_t)tok * DM) + lane; const GAS v2u* hb = (const GAS v2u*)((const bf16*)(a.ws + WS_HBF) + (size_t)tok * DM) + lane;
        size_t rowo[4];
#pragma unroll
        for (int k = 0; k < 4; ++k) { const int iv = __builtin_amdgcn_readfirstlane(INV[tok * 4 + k]); rowo[k] = ((size_t)__builtin_amdgcn_readfirstlane(tb[iv >> 16]) * 256 + (iv & 0xffff)) * DM; }
        f32x4 v[8]; v2u y[8][4];
#pragma unroll
        for (int j = 0; j < 8; ++j) { { const v2u hw = hb[64 * j]; v[j] = f32x4{bflo(hw.x), bfhi(hw.x), bflo(hw.y), bfhi(hw.y)}; }
#pragma unroll
            for (int k = 0; k < 4; ++k) y[j][k] = *(const GAS v2u*)(YS + rowo[k] + 256 * j + 4 * lane); }
#pragma unroll
        for (int j = 0; j < 8; ++j) {
#pragma unroll
            for (int k = 0; k < 4; ++k) { v[j].x += bflo(y[j][k].x); v[j].y += bfhi(y[j][k].x); v[j].z += bflo(y[j][k].y); v[j].w += bfhi(y[j][k].y); }
            o[64 * j] = v[j]; }
    }
}

constexpr int NPHASE = 12;
__global__ void __launch_bounds__(NWAVES * 64, 2) mk_fwd(KArgs args) {
    extern __shared__ __attribute__((aligned(16))) unsigned char lds[];
    LAS unsigned char* L = (LAS unsigned char*)lds;
    const int tid = threadIdx.x, lane = tid & 63, wave = __builtin_amdgcn_readfirstlane(tid >> 6);
    const int G = gridDim.x; const int bx = blockIdx.x; const int vcu = (G % 8 == 0) ? (bx % 8) * (G / 8) + bx / 8 : bx;
    const int gw = vcu * NWAVES + wave, NGW = G * NWAVES;
    unsigned char* ws = args.ws; gu32* ctl = (gu32*)(ws + WS_CTL);
    for (int u = tid; u < (LDS_BYTES - LDSCTL_OFF) / 4; u += NWAVES * 64) ((LAS unsigned*)(L + LDSCTL_OFF))[u] = 0u;
    __syncthreads();
    volatile LAS unsigned* MISC = (volatile LAS unsigned*)(L + MISC_OFF);
    XcdBarrier bar; bar.bar = (unsigned*)ctl + CW_BAR; bar.x = 0; bar.st = nullptr;
    if (!MK_SPLIT) bar = xcd_barrier_post((unsigned*)ctl + CW_BAR, MISC + 8);
    const int lo = args.ph_lo, hi = args.ph_hi;
#ifndef PH_MASK
#define PH_MASK 0xFFF
#endif
#define IN(k) (((PH_MASK >> (k)) & 1) && lo <= (k) && (k) < hi)
#define SEAM(k) do { if (IN(k) && IN((k) + 1)) xcd_barrier(bar); } while (0)
#ifndef ALIGN_MULTI
#define ALIGN_MULTI true
#endif
#ifndef REP_MASK
#define REP_MASK 0
#endif
#define REPS(k) (1 + ((REP_MASK >> (k)) & 1))

    if (IN(0)) { _Pragma("unroll") for (int rep = 0; rep < REPS(0); ++rep) { if (rep) xcd_barrier(bar); p0_prologue(args, L, gw, NGW, wave, lane); } } SEAM(0);
    if (IN(1)) { _Pragma("unroll") for (int rep = 0; rep < REPS(1); ++rep) { if (rep) xcd_barrier(bar); DenseSched S; S.init(ws + WS_XN, ws + WS_WIN_T, TOK, NPROJ, G, bx); EpiInProj E{ws};
        pg8::gemm_phase<EpiInProj, DenseSched, ALIGN_MULTI>(L, DM * 2, S, E); } } SEAM(1);
    if (IN(2)) {
        if (G >= 72) { if (bx < 36) { CmpSched S{(const char*)(ws + WS_KCA), (const char*)(ws + WS_WCAT), bx}; EpiG E{ws}; pg8::gemm_phase<EpiG, CmpSched, false>(L, 2048 * 2, S, E); }
                       else { p1b_norm(args, (bx - 36) * NWAVES + wave, (G - 36) * NWAVES, lane); p1c_vt(args, (bx - 36) * NWAVES + wave, (G - 36) * NWAVES, lane); } }
        else { for (int c = bx; c < 36; c += G) { CmpSched S{(const char*)(ws + WS_KCA), (const char*)(ws + WS_WCAT), c}; EpiG E{ws}; pg8::gemm_phase<EpiG, CmpSched, false>(L, 2048 * 2, S, E); }
               p1b_norm(args, gw, NGW, lane); p1c_vt(args, gw, NGW, lane); }
    } SEAM(2);
    if (IN(3)) { p2b_compress2(args, L); } SEAM(3);
    if (IN(4)) { for (int x = bx; x < 256; x += G) { p4_cmp_unit(args, (char*)lds, x); p4_cmp_unit(args, (char*)lds, 511 - x); } } SEAM(4);
    if (IN(5)) { _Pragma("unroll") for (int rep = 0; rep < REPS(5); ++rep) { if (rep) xcd_barrier(bar); p5_flash(args, (char*)lds, (LAS int*)(L + LDSCTL_OFF + 64), rep + args.rep, vcu); } } SEAM(5);
    if (IN(6)) { int l6_ = threadIdx.x; asm volatile("" : "+v"(l6_)); p6_combine(args, gw, NGW, l6_ & 63); } SEAM(6);
    if (IN(7)) { _Pragma("unroll") for (int rep = 0; rep < REPS(7); ++rep) { if (rep) xcd_barrier(bar); DenseSched S; S.init(ws + WS_MIX, ws + WS_WOUT_T, TOK, DM, G, bx); EpiOutProj E{args.in[0], (bf16*)(ws + (args.rep ? WS_YS : WS_HBF)), args.rep};
        pg8::gemm_phase<EpiOutProj, DenseSched, ALIGN_MULTI>(L, DM * 2, S, E); } } SEAM(7);
    if (IN(8)) { p8_router(args, (char*)lds); } SEAM(8);
    LAS int* tb = (LAS int*)(L + LDSX_OFF); LAS int* cn = tb + 64;
    if (IN(9) || IN(10) || IN(11)) {
        __syncthreads();
        if (tid == 0) { int s = 0; for (int e = 0; e < NEXP; ++e) { const int c = (int)__hip_atomic_load((unsigned*)ctl + CW_ECNT + 64 * e, RLX_AGENT); cn[e] = c; tb[e] = s; s += (c + 255) >> 8; } tb[NEXP] = s; }
        __syncthreads();
    }
    if (IN(9)) { _Pragma("unroll") for (int rep = 0; rep < REPS(9); ++rep) { if (rep) xcd_barrier(bar); MoeSched<true, 16> S{(const char*)(ws + WS_HN), (const char*)(ws + WS_WGU_T), (size_t)4096 * 2048, (const int*)(ws + WS_LIST), tb, cn, G, bx, __builtin_amdgcn_readfirstlane(tb[NEXP])};
        EpiGateUp E{args.in[23], ws + WS_HB, args.rep};
        pg8::gemm_phase<EpiGateUp, MoeSched<true, 16>, ALIGN_MULTI, true, 122>(L, DM, S, E); } } SEAM(9);
    if (IN(10)) { _Pragma("unroll") for (int rep = 0; rep < REPS(10); ++rep) { if (rep) xcd_barrier(bar); MoeSched<false, 8> S{(const char*)(ws + WS_HB), (const char*)(ws + WS_WD_T), (size_t)2048 * 2048, (const int*)(ws + WS_LIST), tb, cn, G, bx, __builtin_amdgcn_readfirstlane(tb[NEXP])};
        EpiDown E{args.in[25], (bf16*)(ws + WS_YS), (const int*)(ws + WS_LIST), (const float*)(ws + WS_GATEW), tb, args.out, args.rep};
        pg8::gemm_phase<EpiDown, MoeSched<false, 8>, ALIGN_MULTI, true, 122>(L, DFF, S, E); } } SEAM(10);
    if (IN(11)) { int l11_ = threadIdx.x; asm volatile("" : "+v"(l11_)); p11_final(args, gw, NGW, l11_ & 63, tb); }
#undef IN
#undef SEAM
}
#if MK_CHECK
constexpr int NSTAGE = 16;
__device__ __forceinline__ unsigned hsh(unsigned x) { x ^= x >> 16; x *= 0x7feb352du; x ^= x >> 15; x *= 0x846ca68bu; x ^= x >> 16; return x; }
__device__ void chk_commit(unsigned char* ws, int stage, float err) {
    __shared__ float red[256];
    if (!(err == err)) err = 1e30f;
    red[threadIdx.x] = err; __syncthreads();
    for (int s = 128; s > 0; s >>= 1) { if (threadIdx.x < s) red[threadIdx.x] = fmaxf(red[threadIdx.x], red[threadIdx.x + s]); __syncthreads(); }
    if (threadIdx.x == 0) atomicMax((unsigned*)(ws + WS_CTL) + CW_CHK + 64 * stage, __float_as_uint(red[0]));
    __syncthreads();
}
__device__ float blk_sum(float v) { __shared__ float r2[256]; r2[threadIdx.x] = v; __syncthreads();
    for (int s = 128; s > 0; s >>= 1) { if (threadIdx.x < s) r2[threadIdx.x] += r2[threadIdx.x + s]; __syncthreads(); } const float o = r2[0]; __syncthreads(); return o; }
__device__ float blk_max(float v) { __shared__ float r3[256]; r3[threadIdx.x] = v; __syncthreads();
    for (int s = 128; s > 0; s >>= 1) { if (threadIdx.x < s) r3[threadIdx.x] = fmaxf(r3[threadIdx.x], r3[threadIdx.x + s]); __syncthreads(); } const float o = r3[0]; __syncthreads(); return o; }
__device__ __forceinline__ float relerr(float a, float ref, float floor_) { return fabsf(a - ref) / (fabsf(ref) + floor_); }
__device__ __forceinline__ int orig_col(int c) { return c < 2560 ? c : (c < 5632 ? c + 24 : (c < 5656 ? c - 5632 + 2560 : -1)); }
__device__ __forceinline__ float f8dec(unsigned v) { const unsigned e = (v >> 3) & 15u, m = v & 7u; const float a = e == 0u ? (float)m * 0.001953125f : (float)(8u + m) * exp2f((float)e - 10.f); return (v & 128u) ? -a : a; }
__device__ __forceinline__ unsigned f8enc(float x) { return f8pk4(x, 0.f, 0.f, 0.f) & 255u; }
__device__ __forceinline__ float qw(float w) { return f8dec(f8enc(w * 32.f)) * 0.03125f; }
__device__ __forceinline__ float rope_inv(int i) { return powf(500000.f, -(float)(2 * i) / 32.f); }

__global__ void chk0(KArgs a) {
    unsigned char* ws = a.ws; const int tid = threadIdx.x; float err = 0.f;
    const int row = hsh(blockIdx.x * 7919u + 1u) % TOK; const float* x = a.in[0] + (size_t)row * DM;
    float ss = 0.f; for (int c = tid; c < DM; c += 256) ss += x[c] * x[c];
    ss = blk_sum(ss); const float rstd = 1.f / sqrtf(ss / DM + NORM_EPS);
    for (int c = tid; c < DM; c += 256) err = fmaxf(err, relerr(bf2f(((const bf16*)(ws + WS_XN))[(size_t)row * DM + c]), x[c] * rstd * a.in[1][c], 0.05f));
    const unsigned r = hsh(blockIdx.x * 256u + tid + 12345u);
    { const int c = r % NPROJ, k = (r >> 13) % 2048, oc = orig_col(c); const float ref = oc < 0 ? 0.f : a.in[2][(size_t)k * 5656 + oc]; err = fmaxf(err, relerr(bf2f(((const bf16*)(ws + WS_WIN_T))[(size_t)c * 2048 + k]), ref, 0.01f)); }
    { const int c = r % 2048, k = (r >> 11) % 2048; err = fmaxf(err, relerr(bf2f(((const bf16*)(ws + WS_WOUT_T))[(size_t)c * 2048 + k]), a.in[18][(size_t)k * 2048 + c], 0.01f)); }
    { const int e = r & 1, n = (r >> 1) % 512, k = (r >> 10) % 2048; const float ref = a.in[e ? 9 : 7][(size_t)((n >> 8) * 2048 + k) * 256 + (n & 255)];
      err = fmaxf(err, relerr(bf2f(((const bf16*)(ws + WS_WCAT + (size_t)e * 2 * MiB))[(size_t)n * 2048 + k]), ref, 0.005f)); }
    { const int pos = r % SEQ, i = (r >> 13) & 15; const float ang = (float)pos * rope_inv(i); err = fmaxf(err, fabsf(((const float*)(ws + WS_ROPE))[pos * 16 + i] - cosf(ang)) + fabsf(((const float*)(ws + WS_ROPE))[SEQ * 16 + pos * 16 + i] - sinf(ang))); }
    { const int e = r & 1, rr = (r >> 1) % 4, c = (r >> 3) % 2048; const float ref = rr < 2 ? a.in[5 + e][rr * 2048 + c] : 0.f; err = fmaxf(err, relerr(bf2f(((const bf16*)(ws + WS_KCA + (size_t)e * KV6_STRIDE))[(size_t)(2048 + rr) * 2048 + c]), ref, 0.002f)); }
    chk_commit(ws, 0, err);
}
__global__ void chk0b(KArgs a) {
    unsigned char* ws = a.ws; const int tid = threadIdx.x; float err = 0.f; const unsigned r = hsh(blockIdx.x * 256u + tid + 54321u);
    { const int e = r % 32, rho = (r >> 5) % 4096, k = (r >> 17) % 2048, pn = rho >> 8, bj = (rho >> 7) & 1, i = rho & 127, col = bj * 2048 + pn * 128 + i;
      err = fmaxf(err, (float)((unsigned)(ws + WS_WGU_T)[((size_t)e * 4096 + rho) * 2048 + k] != f8enc(a.in[22][((size_t)e * 2048 + k) * 4096 + col] * 32.f))); }
    { const int e = r % 32, c = (r >> 5) % 2048, k = (r >> 16) % 2048; err = fmaxf(err, (float)((unsigned)(ws + WS_WD_T)[((size_t)e * 2048 + c) * 2048 + k] != f8enc(a.in[24][((size_t)e * 2048 + k) * 2048 + c] * 32.f))); }
    chk_commit(ws, 0, err);
}
__device__ __forceinline__ float inproj_fetch(unsigned char* ws, int row, int c) {
    const int b = row >> 13, t = row & (SEQ - 1);
    if (c >= 5632) return ((const float*)(ws + WS_GATES))[(size_t)row * 24 + (c - 5632)];
    if (c < 1024) { const int h = c >> 7, d = c & 127, kvh = h >> 2, g = h & 3; return bf2f(((const bf16*)(ws + WS_QNSA))[((((size_t)(b * 2 + kvh)) * SEQ + t) * 4 + g) * 128 + d]); }
    if (c < 2560) { const int q = (c - 1024) >> 8, kvh = ((c - 1024) >> 7) & 1, d = c & 127; return bf2f(((const bf16*)(ws + WS_KV6 + (size_t)q * KV6_STRIDE))[((size_t)(b * 2 + kvh) * SEQ + t) * 128 + d]); }
    const int cc = c - 2560, which = cc >> 10, h = (cc >> 8) & 3, sub = (cc >> 7) & 1, d = cc & 127;
    const size_t base = which == 0 ? WS_QD : (which == 1 ? WS_KD : WS_VD);
    return bf2f(((const bf16*)(ws + base))[((size_t)((b * 4 + h) * 2 + sub) * SEQ + t) * 128 + d]);
}
__global__ void chk1(KArgs a) {
    unsigned char* ws = a.ws; const unsigned r = hsh(blockIdx.x * 256u + threadIdx.x + 777u);
    const int row = r % TOK, c = (r >> 14) % 5656, oc = orig_col(c);
    float s = 0.f; for (int k = 0; k < DM; ++k) s += bf2f(((const bf16*)(ws + WS_XN))[(size_t)row * DM + k]) * a.in[2][(size_t)k * 5656 + oc];
    const float ref = c >= 5632 ? 1.f / (1.f + expf(-s)) : s;
    chk_commit(ws, 1, relerr(inproj_fetch(ws, row, c), ref, 0.3f));
}
__device__ float raw_proj(const KArgs& a, int row, int oc) { float s = 0.f; for (int k = 0; k < DM; ++k) s += bf2f(((const bf16*)(a.ws + WS_XN))[(size_t)row * DM + k]) * a.in[2][(size_t)k * 5656 + oc]; return bf2f((bf16)f2bf(s)); }
__global__ void chk2(KArgs a) {
    unsigned char* ws = a.ws; const int tid = threadIdx.x; const unsigned r = hsh(blockIdx.x * 31u + 5u);
    const int kind = blockIdx.x % 5, row = (r >> 3) % TOK, b = row >> 13, t = row & (SEQ - 1);
    int oc0; const float* g; const bf16* dst;
    if (kind == 0) { const int h = r & 7; oc0 = h * 128; g = a.in[3]; dst = (const bf16*)(ws + WS_QNSA) + ((((size_t)(b * 2 + (h >> 2))) * SEQ + t) * 4 + (h & 3)) * 128; }
    else if (kind == 1) { const int kvh = r & 1; oc0 = 1536 + kvh * 128; g = a.in[4] + 128; dst = (const bf16*)(ws + WS_KSLC) + ((size_t)(b * 2 + kvh) * SEQ + t) * 128; }
    else if (kind == 2) { const int kvh = r & 1; oc0 = 2048 + kvh * 128; g = a.in[4] + 256; dst = (const bf16*)(ws + WS_KWIN) + ((size_t)(b * 2 + kvh) * SEQ + t) * 128; }
    else { const int hc = r & 7; oc0 = (kind == 3 ? 2584 : 3608) + hc * 128; g = a.in[kind == 3 ? 11 : 12]; dst = (const bf16*)(ws + (kind == 3 ? WS_QD : WS_KD)) + ((size_t)(b * 8 + hc) * SEQ + t) * 128; }
    __shared__ float v[128];
    float x = 0.f; if (tid < 128) x = raw_proj(a, row, oc0 + tid);
    const float ss = blk_sum(tid < 128 ? x * x : 0.f); const float rstd = 1.f / sqrtf(ss / 128.f + NORM_EPS);
    if (tid < 128) v[tid] = x * rstd * g[tid]; __syncthreads();
    float err = 0.f;
    if (tid < 128) { float y = v[tid];
        if (tid < 32) { const int i = tid & 15; const float ang = (float)t * rope_inv(i), c = cosf(ang), s = sinf(ang); y = tid < 16 ? v[tid] * c - v[tid + 16] * s : v[tid] * c + v[tid - 16] * s; }
        err = relerr(bf2f(dst[tid]), y, 0.6f); }
    chk_commit(ws, 2, err);
}
__global__ void chk3(KArgs a) {
    unsigned char* ws = a.ws; const unsigned r = hsh(blockIdx.x * 256u + threadIdx.x + 99u);
    const int e = r & 1, n = (r >> 1) % 512; int row = (r >> 10) % 2050; const int part = n >> 8;
    const bf16* A = (const bf16*)(ws + WS_KCA + (size_t)e * KV6_STRIDE) + (size_t)row * 2048; const float* w1 = a.in[e ? 9 : 7];
    float s = 0.f; for (int k = 0; k < 2048; ++k) s += bf2f(A[k]) * w1[(size_t)(part * 2048 + k) * 256 + (n & 255)];
    chk_commit(ws, 3, relerr(((const float*)(ws + WS_G + (size_t)e * G_STRIDE))[(size_t)row * 512 + n], s, 0.3f));
}
__device__ __forceinline__ float gelu_ref(float x) { return 0.5f * x * (1.f + tanhf(0.7978845608028654f * (x + 0.044715f * x * x * x))); }
__global__ void chk4(KArgs a) {
    unsigned char* ws = a.ws; const int tid = threadIdx.x; const unsigned r = hsh(blockIdx.x * 131u + 3u);
    const int e = blockIdx.x & 1, bk = (r >> 1) & 3; int i = (r >> 3) % 511; if (blockIdx.x < 4) i = blockIdx.x < 2 ? 0 : 510;
    const bf16* A = (const bf16*)(ws + WS_KCA + (size_t)e * KV6_STRIDE) + ((size_t)bk * SEQ + 16 * i) * 128; const float* pe = a.in[5 + e]; const float* w1 = a.in[e ? 9 : 7]; const float* w2 = a.in[e ? 10 : 8];
    __shared__ float hid[256]; __shared__ float ov[128];
    float s = 0.f; for (int k = 0; k < 4096; ++k) s += (bf2f(A[k]) + pe[k]) * w1[(size_t)k * 256 + tid];
    hid[tid] = gelu_ref(s); __syncthreads();
    float o = 0.f; if (tid < 128) for (int n = 0; n < 256; ++n) o += hid[n] * w2[n * 128 + tid];
    float err = 0.f;
    if (e == 0) { const float ss = blk_sum(tid < 128 ? o * o : 0.f); const float rstd = 1.f / sqrtf(ss / 128.f + NORM_EPS);
        if (tid < 128) ov[tid] = o * rstd * a.in[4][tid]; __syncthreads();
        if (tid < 128) { float y = ov[tid]; if (tid < 32) { const int q = tid & 15; const float ang = (float)(16 * i + 31) * rope_inv(q), c = cosf(ang), sn = sinf(ang); y = tid < 16 ? ov[tid] * c - ov[tid + 16] * sn : ov[tid] * c + ov[tid - 16] * sn; }
            err = relerr(bf2f(((const bf16*)(ws + WS_KCMP))[((size_t)bk * 512 + i) * 128 + tid]), y, 0.6f); } }
    else if (tid < 128) err = relerr(bf2f(((const bf16*)(ws + WS_VCMP))[((size_t)bk * 512 + i) * 128 + tid]), o, 0.3f);
    chk_commit(ws, 4, err);
}
__global__ void chk5(KArgs a) {
    unsigned char* ws = a.ws; const int tid = threadIdx.x; const unsigned r = hsh(blockIdx.x * 977u + 11u);
    const int bk = r & 3; int t = (r >> 2) % SEQ; if (blockIdx.x < 8) t = blockIdx.x * 9; if (blockIdx.x == 8) t = SEQ - 1;
    __shared__ float p[4][512]; __shared__ float imp[128]; __shared__ int sel[128];
    const bf16* Q = (const bf16*)(ws + WS_QNSA) + ((size_t)bk * SEQ + t) * 512; const bf16* Kc = (const bf16*)(ws + WS_KCMP) + (size_t)bk * 512 * 128; const bf16* Vc = (const bf16*)(ws + WS_VCMP) + (size_t)bk * 512 * 128;
    for (int idx = tid; idx < 4 * 512; idx += 256) { const int g = idx >> 9, i = idx & 511; float s = -1e30f;
        if (i < 511 && 16 * i + 31 <= t) { s = 0.f; for (int d = 0; d < 128; ++d) s += bf2f(Q[g * 128 + d]) * bf2f(Kc[(size_t)i * 128 + d]); s *= ATT_SCALE; }
        p[g][i] = s; }
    __syncthreads();
    if (tid < 4) { float m = -1e30f; for (int i = 0; i < 512; ++i) m = fmaxf(m, p[tid][i]); float l = 0.f;
        for (int i = 0; i < 512; ++i) { const float e = p[tid][i] > -1e29f ? expf(p[tid][i] - m) : 0.f; p[tid][i] = e; l += e; }
        const float rl = 1.f / fmaxf(l, 1e-30f); for (int i = 0; i < 512; ++i) p[tid][i] *= rl; }
    __syncthreads();
    float err = 0.f;
    for (int idx = tid; idx < 512; idx += 256) { const int g = idx >> 7, d = idx & 127; float o = 0.f; for (int i = 0; i < 511; ++i) o += p[g][i] * bf2f(Vc[(size_t)i * 128 + d]);
        err = fmaxf(err, relerr(bf2f(((const bf16*)(ws + WS_OCMP))[(((size_t)bk * SEQ + t) * 4 + g) * 128 + d]), o, 0.02f)); }
    chk_commit(ws, 5, err);
    const int cur = t >> 6;
    if (tid < 128) { const int j = tid; float v = 0.f; for (int i = 4 * j - 1; i <= 4 * j + 3; ++i) if (i >= 0 && i < 511) v += (p[0][i] + p[1][i]) + (p[2][i] + p[3][i]);
        if (j == 0 || j == cur || j == cur - 1) v = 1e9f; if (j > cur) v = -1e30f; imp[j] = v; }
    __syncthreads();
    if (tid < 128) { const float v = imp[tid]; int rank = 0; for (int j = 0; j < 128; ++j) rank += (imp[j] > v || (imp[j] == v && j < tid)) ? 1 : 0; sel[tid] = (rank < 16 && v > -1.f) ? 1 : 0; }
    __syncthreads();
    float e2 = 0.f;
    if (tid < 128) { const unsigned w = ((const unsigned*)(ws + WS_SELM))[((size_t)bk * SEQ + t) * 4 + (tid >> 5)]; e2 = (float)((int)((w >> (tid & 31)) & 1u) != sel[tid]); }
    e2 = blk_sum(e2) / 32.f;
    chk_commit(ws, 6, e2);
}
__global__ void chk6(KArgs a) {
    unsigned char* ws = a.ws; const int tid = threadIdx.x; const unsigned r = hsh(blockIdx.x * 613u + 17u);
    const int kind = blockIdx.x % 3; int t = (r >> 8) % SEQ; if (blockIdx.x < 12) t = (blockIdx.x / 3) * 85; if (blockIdx.x >= 12 && blockIdx.x < 15) t = SEQ - 1;
    __shared__ float sc[SEQ]; __shared__ float q[128]; __shared__ float part[2][128];
    const bf16 *Qp, *Kp, *Vp, *Op; unsigned mw[4] = {0xffffffffu, 0xffffffffu, 0xffffffffu, 0xffffffffu}; int klo = 0;
    if (kind < 2) { const int bk = r & 3, g = (r >> 2) & 3; Qp = (const bf16*)(ws + WS_QNSA) + (((size_t)bk * SEQ + t) * 4 + g) * 128; Kp = (const bf16*)(ws + (kind == 0 ? WS_KSLC : WS_KWIN)) + (size_t)bk * SEQ * 128;
        Vp = (const bf16*)(ws + (kind == 0 ? WS_VSLC : WS_VWIN)) + (size_t)bk * SEQ * 128; Op = (const bf16*)(ws + (kind == 0 ? WS_OSLC : WS_OWIN)) + (((size_t)bk * SEQ + t) * 4 + g) * 128;
        if (kind == 0) for (int w = 0; w < 4; ++w) mw[w] = ((const unsigned*)(ws + WS_SELM))[((size_t)bk * SEQ + t) * 4 + w]; else klo = t - 511 > 0 ? t - 511 : 0; }
    else { const int id = r & 31, bhc = id >> 1, half = id & 1, bh = id >> 2; Qp = (const bf16*)(ws + WS_QD) + ((size_t)bhc * SEQ + t) * 128; Kp = (const bf16*)(ws + WS_KD) + (size_t)bhc * SEQ * 128;
        Vp = (const bf16*)(ws + WS_VD) + (size_t)(bh * 2 + half) * SEQ * 128; Op = (const bf16*)(ws + WS_ODIFF) + ((size_t)id * SEQ + t) * 128; }
    if (tid < 128) q[tid] = bf2f(Qp[tid]); __syncthreads();
    float mx = -1e30f;
    for (int k = tid; k <= t; k += 256) { float s = -1e30f; const int j = k >> 6;
        if (k >= klo && ((mw[j >> 5] >> (j & 31)) & 1u)) { s = 0.f; for (int d = 0; d < 128; ++d) s += q[d] * bf2f(Kp[(size_t)k * 128 + d]); s *= ATT_SCALE; }
        sc[k] = s; mx = fmaxf(mx, s); }
    mx = blk_max(mx); float l = 0.f;
    for (int k = tid; k <= t; k += 256) { const float e = sc[k] > -1e29f ? expf(sc[k] - mx) : 0.f; sc[k] = e; l += e; }
    l = blk_sum(l);
    { const int d = tid & 127, hf = tid >> 7; float o = 0.f; for (int k = hf; k <= t; k += 2) o += sc[k] * bf2f(Vp[(size_t)k * 128 + d]); part[hf][d] = o; }
    __syncthreads();
    float ref = 0.f; if (tid < 128) ref = (part[0][tid] + part[1][tid]) / fmaxf(l, 1e-30f);
    const float rms = sqrtf(blk_sum(tid < 128 ? ref * ref : 0.f) / 128.f);
    float err = 0.f; if (tid < 128) err = fabsf(bf2f(Op[tid]) - ref) / (rms + 1e-4f);
    chk_commit(ws, 7 + kind, err);
}
__global__ void chk7(KArgs a) {
    unsigned char* ws = a.ws; const int tid = threadIdx.x; const int tok = hsh(blockIdx.x * 71u + 29u) % TOK, b = tok >> 13, t = tok & (SEQ - 1);
    float s1 = 0.f, s2 = 0.f; for (int d = 0; d < 128; ++d) { s1 += a.in[13][d] * a.in[14][d]; s2 += a.in[15][d] * a.in[16][d]; }
    const float lam = expf(s1) - expf(s2) + 0.2f; const bf16* mix = (const bf16*)(ws + WS_MIX) + (size_t)tok * DM; float err = 0.f;
    for (int c = tid; c < 1024; c += 256) { const int h = c >> 7, d = c & 127; const size_t ro = (((size_t)(b * 2 + (h >> 2)) * SEQ + t) * 4 + (h & 3)) * 128 + d; const float* gt = (const float*)(ws + WS_GATES) + (size_t)tok * 24 + h * 3;
        const float ref = gt[0] * bf2f(((const bf16*)(ws + WS_OCMP))[ro]) + gt[1] * bf2f(((const bf16*)(ws + WS_OSLC))[ro]) + gt[2] * bf2f(((const bf16*)(ws + WS_OWIN))[ro]);
        err = fmaxf(err, fabsf(bf2f(mix[c]) - ref) / (fabsf(ref) + 0.02f)); }
    __shared__ float od[1024];
    for (int c = tid; c < 1024; c += 256) { const int h = c >> 8, half = (c >> 7) & 1, d = c & 127; const bf16* O = (const bf16*)(ws + WS_ODIFF);
        od[c] = bf2f(O[((size_t)(((b * 4 + h) * 2 + 0) * 2 + half) * SEQ + t) * 128 + d]) - lam * bf2f(O[((size_t)(((b * 4 + h) * 2 + 1) * 2 + half) * SEQ + t) * 128 + d]); }
    __syncthreads();
    for (int c = tid; c < 1024; c += 256) { const int h = c >> 8; float ss = 0.f; for (int k = 0; k < 256; ++k) ss += od[h * 256 + k] * od[h * 256 + k];
        const float ref = od[c] / sqrtf(ss / 256.f + NORM_EPS) * a.in[17][c & 255] * 0.8f; err = fmaxf(err, relerr(bf2f(mix[1024 + c]), ref, 0.1f)); }
    chk_commit(ws, 10, err);
}
__global__ void chk8(KArgs a) {
    unsigned char* ws = a.ws; const unsigned r = hsh(blockIdx.x * 256u + threadIdx.x + 4242u); const int row = r % TOK, c = (r >> 14) % DM;
    float s = a.in[0][(size_t)row * DM + c]; for (int k = 0; k < DM; ++k) s += bf2f(((const bf16*)(ws + WS_MIX))[(size_t)row * DM + k]) * a.in[18][(size_t)k * DM + c];
    chk_commit(ws, 11, relerr(bf2f(((const bf16*)(ws + WS_HBF))[(size_t)row * DM + c]), s, 0.3f));
}
__global__ void chk9(KArgs a) {
    unsigned char* ws = a.ws; const int tid = threadIdx.x; const int tok = hsh(blockIdx.x * 337u + 41u) % TOK; __shared__ float h[DM]; for (int c = tid; c < DM; c += 256) h[c] = bf2f(((const bf16*)(ws + WS_HBF))[(size_t)tok * DM + c]); __syncthreads();
    float ss = 0.f; for (int c = tid; c < DM; c += 256) ss += h[c] * h[c]; ss = blk_sum(ss); const float rstd = 1.f / sqrtf(ss / DM + NORM_EPS);
    float e13 = 0.f; for (int c = tid; c < DM; c += 256) { const float ref = h[c] * rstd * a.in[19][c]; e13 = fmaxf(e13, 0.03f * fabsf(f8dec((ws + WS_HN)[(size_t)tok * DM + c]) - ref) / (0.0626f * fabsf(ref) + 0.002f)); }
    chk_commit(ws, 13, e13);
    __shared__ float lg[8][32]; __shared__ float fin[32];
    { const int e = tid & 31, ks = tid >> 5; float s = 0.f; for (int k = ks * 256; k < ks * 256 + 256; ++k) s += h[k] * rstd * a.in[19][k] * a.in[20][(size_t)k * 32 + e]; lg[ks][e] = s; }
    __syncthreads();
    if (tid < 32) { float s = a.in[21][tid]; for (int ks = 0; ks < 8; ++ks) s += lg[ks][tid]; fin[tid] = s; }
    __syncthreads();
    float err = 0.f;
    if (tid == 0) { int te[4]; float tv[4]; float gap = 1e30f;
        for (int k = 0; k < 4; ++k) { int be = -1; float bv = -1e30f; for (int e = 0; e < 32; ++e) { bool used = false; for (int q = 0; q < k; ++q) used |= te[q] == e; if (!used && fin[e] > bv) { bv = fin[e]; be = e; } } te[k] = be; tv[k] = bv; }
        { float v5 = -1e30f; for (int e = 0; e < 32; ++e) { bool used = false; for (int q = 0; q < 4; ++q) used |= te[q] == e; if (!used) v5 = fmaxf(v5, fin[e]); } gap = tv[3] - v5; }
        float den = 0.f; for (int k = 0; k < 4; ++k) den += expf(tv[k] - tv[0]);
        for (int k = 0; k < 4; ++k) { const int e = te[k]; const int cnt = (int)((const unsigned*)(ws + WS_CTL))[CW_ECNT + 64 * e]; const int* li = (const int*)(ws + WS_LIST) + (size_t)e * TOK; bool found = false;
            for (int i = 0; i < cnt && i < TOK; ++i) if (li[i] == tok * 4 + k) { found = true; err = fmaxf(err, fabsf(((const float*)(ws + WS_GATEW))[(size_t)e * TOK + i] - expf(tv[k] - tv[0]) / den) * 10.f); break; }
            if (!found && gap > 1e-3f) err = fmaxf(err, 1.f); }
        if (blockIdx.x == 0) { int tot = 0; for (int e = 0; e < 32; ++e) tot += (int)((const unsigned*)(ws + WS_CTL))[CW_ECNT + 64 * e]; if (tot != TOK * 4) err = fmaxf(err, 5.f); } }
    chk_commit(ws, 12, err);
}
__device__ __forceinline__ void moe_locate(unsigned char* ws, unsigned r, int& e, int& idx, int& prow) {
    e = r % 32; int tb = 0; for (int q = 0; q < e; ++q) tb += ((int)((const unsigned*)(ws + WS_CTL))[CW_ECNT + 64 * q] + 255) >> 8;
    const int cnt = (int)((const unsigned*)(ws + WS_CTL))[CW_ECNT + 64 * e]; idx = cnt > 0 ? (int)((r >> 5) % (unsigned)cnt) : 0; prow = tb * 256 + idx;
}
__global__ void chk10(KArgs a) {
    unsigned char* ws = a.ws; const unsigned r = hsh(blockIdx.x * 256u + threadIdx.x + 9001u); int e, idx, prow; moe_locate(ws, r, e, idx, prow); const int col = (r >> 19) % DFF;
    const int tok = ((const int*)(ws + WS_LIST))[(size_t)e * TOK + idx] >> 2; const unsigned char* hn = ws + WS_HN + (size_t)tok * DM; const float* w = a.in[22] + (size_t)e * 2048 * 4096;
    float gl = a.in[23][e * 4096 + col], up = a.in[23][e * 4096 + 2048 + col]; for (int k = 0; k < DM; ++k) { const float x = f8dec(hn[k]); gl += x * qw(w[(size_t)k * 4096 + col]); up += x * qw(w[(size_t)k * 4096 + 2048 + col]); }
    gl = fminf(gl, 7.f); up = fminf(fmaxf(up, -7.f), 7.f); const float ref = (up + 1.f) * gl / (1.f + expf(-1.702f * gl));
    chk_commit(ws, 14, 0.06f * fabsf(f8dec((ws + WS_HB)[(size_t)prow * DFF + col]) - ref) / (0.0626f * fabsf(ref) + 0.01f));
}
__global__ void chk11(KArgs a) {
    unsigned char* ws = a.ws; const unsigned r = hsh(blockIdx.x * 256u + threadIdx.x + 31337u); int e, idx, prow; moe_locate(ws, r, e, idx, prow); const int col = (r >> 19) % DM;
    const int ent = ((const int*)(ws + WS_LIST))[(size_t)e * TOK + idx]; const float gw = ((const float*)(ws + WS_GATEW))[(size_t)e * TOK + idx]; const unsigned char* hb = ws + WS_HB + (size_t)prow * DFF; const float* w = a.in[24] + (size_t)e * 2048 * 2048;
    float s = a.in[25][e * 2048 + col]; for (int k = 0; k < DFF; ++k) s += f8dec(hb[k]) * qw(w[(size_t)k * 2048 + col]);
    { const int iv = ((const int*)(ws + WS_INV))[ent]; const float e2 = (iv == ((e << 16) | idx)) ? 0.f : 1.f;
      chk_commit(ws, 15, fmaxf(e2, relerr(bf2f(((const bf16*)(ws + WS_YS))[(size_t)prow * DM + col]), s * gw, 0.1f))); }
}
__global__ void chk_report(KArgs a) {
    const float tol[NSTAGE] = {0.02f, 0.08f, 0.08f, 0.08f, 0.1f, 0.1f, 0.07f, 0.35f, 0.35f, 0.35f, 0.08f, 0.08f, 0.05f, 0.04f, 0.1f, 0.1f};
    int bad = -1, bad2 = -1; float be = 0.f;
    for (int s = 0; s < NSTAGE; ++s) { const float e = __uint_as_float(((const unsigned*)(a.ws + WS_CTL))[CW_CHK + 64 * s]); if (e > tol[s]) { if (bad < 0) { bad = s; be = e; } else if (bad2 < 0) bad2 = s; } }
    if (bad < 0) return;
    const size_t n = (size_t)TOK * DM;
    float g = log10f(fmaxf(be, 1e-30f)); g = fminf(fmaxf(g, -3.f), 3.f);
    const float A = powf(10.f, 4.f + (float)bad) * (1.f + (g + 3.f) / 3.f);
    const int q = bad2 < 0 ? 0 : (bad2 - bad < 7 ? bad2 - bad : 7);
    const float B = q ? A * sqrtf(powf(10.f, (float)q) / (float)n) : 0.f;
    for (size_t i = (size_t)blockIdx.x * blockDim.x + threadIdx.x; i < n; i += (size_t)gridDim.x * blockDim.x) a.out[i] = i == 0 ? A : B;
}
static void chk_after_phase(int p, const KArgs& a, hipStream_t stream) {
    switch (p) {
    case 0: chk0<<<64, 256, 0, stream>>>(a); break;
    case 1: chk1<<<16, 256, 0, stream>>>(a); break;
    case 2: chk2<<<160, 256, 0, stream>>>(a); chk3<<<8, 256, 0, stream>>>(a); break;
    case 3: chk4<<<64, 256, 0, stream>>>(a); break;
    case 4: chk5<<<96, 256, 0, stream>>>(a); break;
    case 5: chk6<<<192, 256, 0, stream>>>(a); chk0b<<<256, 256, 0, stream>>>(a); break;
    case 6: chk7<<<64, 256, 0, stream>>>(a); break;
    case 7: chk8<<<16, 256, 0, stream>>>(a); break;
    case 8: chk9<<<64, 256, 0, stream>>>(a); break;
    case 9: chk10<<<8, 256, 0, stream>>>(a); break;
    case 10: chk11<<<8, 256, 0, stream>>>(a); break;
    default: break;
    }
}
#endif
extern "C" void kernel_launch(void* const* d_in, const int* in_sizes, int n_in, void* d_out, int out_size, void* d_ws, size_t ws_size, hipStream_t stream) {
    static int grid = 0;
    if (grid == 0) {
        if (n_in != 26 || in_sizes[0] != TOK * DM || out_size != TOK * DM || ws_size < WS_END) { fprintf(stderr, "kernel_launch: unexpected shapes (n_in %d, in0 %d, out %d, ws %zu)\n", n_in, n_in > 0 ? in_sizes[0] : -1, out_size, ws_size); grid = -1; return; }
        int dev = 0, cus = 0, per_cu = 0;
        if (hipGetDevice(&dev) != hipSuccess || hipDeviceGetAttribute(&cus, hipDeviceAttributeMultiprocessorCount, dev) != hipSuccess) { grid = -1; return; }
        if (hipFuncSetAttribute((const void*)mk_fwd, hipFuncAttributeMaxDynamicSharedMemorySize, LDS_BYTES) != hipSuccess) { fprintf(stderr, "kernel_launch: hipFuncSetAttribute failed\n"); grid = -1; return; }
        if (hipOccupancyMaxActiveBlocksPerMultiprocessor(&per_cu, (const void*)mk_fwd, NWAVES * 64, LDS_BYTES) != hipSuccess || per_cu < 1) { fprintf(stderr, "kernel_launch: occupancy query says %d\n", per_cu); }
        (void)hipGetLastError();
        grid = cus;
        if (grid > 256) grid = 256;
    }
    if (grid < 0) return;
    if (hipMemsetAsync((char*)d_ws + WS_CTL, 0, CTL_ZERO_BYTES, stream) != hipSuccess) return;
    KArgs a{};
    for (int i = 0; i < 26; ++i) a.in[i] = (const float*)d_in[i];
    a.out = (float*)d_out; a.ws = (unsigned char*)d_ws;
#if MK_SPLIT
    for (int p = 0; p < NPHASE; ++p) { a.ph_lo = p; a.ph_hi = p + 1; hipLaunchKernelGGL(mk_fwd, dim3(grid), dim3(NWAVES * 64), LDS_BYTES, stream, a);
#if MK_CHECK
        chk_after_phase(p, a, stream);
#endif
    }
#if MK_CHECK
    chk_report<<<dim3(1024), dim3(256), 0, stream>>>(a);
#endif
#else
    a.ph_lo = 0; a.ph_hi = NPHASE;
    hipLaunchKernelGGL(mk_fwd, dim3(grid), dim3(NWAVES * 64), LDS_BYTES, stream, a);
#if defined(EXTRA_PH)
    a.ph_lo = EXTRA_PH; a.ph_hi = EXTRA_PH + 1; a.rep = 1;
    hipLaunchKernelGGL(mk_fwd, dim3(grid), dim3(NWAVES * 64), LDS_BYTES, stream, a);
#endif
#endif
}
```

```cpp
#include <hip/hip_runtime.h>
#include <cstdio>
#include <cstdint>

#ifndef MK_SPLIT
#define MK_SPLIT 0
#endif
#ifndef MK_CHECK
#define MK_CHECK 0
#endif

#define GAS __attribute__((address_space(1)))
#define LAS __attribute__((address_space(3)))
typedef unsigned short bf16;
typedef unsigned v4u __attribute__((ext_vector_type(4)));
typedef unsigned v2u __attribute__((ext_vector_type(2)));
typedef float f32x2 __attribute__((ext_vector_type(2)));
typedef float f32x4 __attribute__((ext_vector_type(4)));
typedef float f32x16 __attribute__((ext_vector_type(16)));
typedef short bf16x8 __attribute__((ext_vector_type(8)));
typedef short s16x4 __attribute__((ext_vector_type(4)));
typedef GAS unsigned gu32;
#define RLX_AGENT __ATOMIC_RELAXED, __HIP_MEMORY_SCOPE_AGENT
#define LDS_WAIT() asm volatile("s_waitcnt lgkmcnt(0)" ::: "memory")
#define VM_WAIT() asm volatile("s_waitcnt vmcnt(0)" ::: "memory")
#define SBAR() __builtin_amdgcn_sched_barrier(0)

constexpr int NB = 2, SEQ = 8192, TOK = NB * SEQ, DM = 2048, HD = 128;
constexpr int NPROJ = 5888;
constexpr int NEXP = 32, DFF = 2048, NCMPP = 512;
constexpr float NORM_EPS = 1e-6f;
constexpr float ATT_SCALE = 0.08838834764831845f;
constexpr float LOG2E = 1.4426950408889634f;
constexpr int NWAVES = 8;

__device__ __forceinline__ unsigned f2bf(float f) { unsigned u = __builtin_bit_cast(unsigned, f); return (u + 0x7fffu + ((u >> 16) & 1u)) >> 16; }
__device__ __forceinline__ unsigned pk2(float lo, float hi) { return f2bf(lo) | (f2bf(hi) << 16); }
__device__ __forceinline__ float bf2f(unsigned short b) { return __builtin_bit_cast(float, (unsigned)b << 16); }
__device__ __forceinline__ float bflo(unsigned w) { return __builtin_bit_cast(float, w << 16); }
__device__ __forceinline__ float bfhi(unsigned w) { return __builtin_bit_cast(float, w & 0xffff0000u); }
__device__ __forceinline__ unsigned cvtpk(float lo, float hi) { unsigned r; asm volatile("v_cvt_pk_bf16_f32 %0, %1, %2" : "=v"(r) : "v"(lo), "v"(hi)); return r; }
__device__ __forceinline__ float wave_sum(float v) {
#pragma unroll
    for (int o = 1; o < 64; o <<= 1) v += __shfl_xor(v, o);
    return v;
}

#define XB_TMO      128
#define XB_XCNT(j)  (256  + 64 * (j))
#define XB_XSUB(j)  (1280 + 64 * (j))
#define XB_XGEN(j)  (2304 + 64 * (j))
#define XB_TOP      3328
#define XB_TOPGEN   3392
#define XCD_BAR_WORDS 3456
#define XB_SPIN_CAP (1u << 22)

__device__ __forceinline__ unsigned xb_ld(unsigned* p)              { return __hip_atomic_load(p, __ATOMIC_RELAXED, __HIP_MEMORY_SCOPE_AGENT); }
__device__ __forceinline__ unsigned xb_add(unsigned* p, unsigned v) { return __hip_atomic_fetch_add(p, v, __ATOMIC_RELAXED, __HIP_MEMORY_SCOPE_AGENT); }
__device__ __forceinline__ unsigned xb_xcc_id() { return (unsigned)__builtin_amdgcn_s_getreg((3 << 11) | 20) & 0xFu; }
#define XB_SPIN(cond, bar) do { unsigned _sp = 0; while (cond) { __builtin_amdgcn_s_sleep(1); \
    if ((++_sp & 255u) == 0u) { if (xb_ld(&(bar)[XB_TMO])) break; if (_sp > XB_SPIN_CAP) { atomicAdd(&(bar)[XB_TMO], 1u); break; } } } } while (0)

struct XcdBarrier { unsigned* bar; unsigned x; volatile LAS unsigned* st; };

__device__ __forceinline__ XcdBarrier xcd_barrier_post(unsigned* bar, volatile LAS unsigned* st) {
    XcdBarrier b; b.bar = bar; b.x = xb_xcc_id(); b.st = st;
    if (threadIdx.x == 0) (void)xb_add(&bar[XB_XCNT(b.x)], 1u);
    return b;
}
__device__ __forceinline__ void xcd_barrier_complete(unsigned* bar, unsigned x, unsigned& nloc, unsigned& nx) {
    const unsigned G = gridDim.x * gridDim.y * gridDim.z;
    unsigned sum, cnt, mine, sp = 0u;
    for (;;) {
        sum = 0u; cnt = 0u; mine = 0u;
#pragma unroll
        for (unsigned j = 0; j < 16; ++j) { const unsigned c = xb_ld(&bar[XB_XCNT(j)]); sum += c; cnt += (c > 0u) ? 1u : 0u; mine = (j == x) ? c : mine; }
        if (sum == G) break;
        __builtin_amdgcn_s_sleep(1);
        if ((++sp & 255u) == 0u) { if (xb_ld(&bar[XB_TMO])) break; if (sp > XB_SPIN_CAP) { atomicAdd(&bar[XB_TMO], 1u); break; } }
    }
    nloc = mine > 0u ? mine : 1u; nx = cnt > 0u ? cnt : 1u;
}
__device__ __forceinline__ void xcd_barrier(const XcdBarrier& b) {
    asm volatile("s_waitcnt vmcnt(0)" ::: "memory");
    __syncthreads();
    if (threadIdx.x == 0) {
        unsigned* bar = b.bar;
        __builtin_amdgcn_s_waitcnt(0);
        unsigned nloc = b.st[0], nx = b.st[1];
        if (nloc == 0u) { xcd_barrier_complete(bar, b.x, nloc, nx); b.st[0] = nloc; b.st[1] = nx; }
        const unsigned old = xb_add(&bar[XB_XSUB(b.x)], 1u);
        const unsigned gen = old / nloc;
        if (old + 1u == (gen + 1u) * nloc) {
            __builtin_amdgcn_fence(__ATOMIC_RELEASE, "agent");
            asm volatile("s_waitcnt vmcnt(0)" ::: "memory");
            const unsigned og = xb_add(&bar[XB_TOP], 1u);
            const unsigned tg = og / nx;
            if (og + 1u == (tg + 1u) * nx) xb_add(&bar[XB_TOPGEN], 1u);
            else XB_SPIN(xb_ld(&bar[XB_TOPGEN]) == tg, bar);
            __builtin_amdgcn_fence(__ATOMIC_ACQUIRE, "agent");
            xb_add(&bar[XB_XGEN(b.x)], 1u);
            asm volatile("s_waitcnt vmcnt(0)" ::: "memory");
        } else {
            XB_SPIN(xb_ld(&bar[XB_XGEN(b.x)]) == gen, bar);
            __builtin_amdgcn_fence(__ATOMIC_ACQUIRE, "agent");
            asm volatile("s_waitcnt vmcnt(0)" ::: "memory");
        }
    }
    __syncthreads();
}

namespace pg8 {
#define PG8_LAS __attribute__((address_space(3)))
constexpr int BM = 256, BK = 64, HALF = 128, HTB = HALF * BK * 2, STAGE_BYTES = 8 * HTB;
__host__ __device__ __forceinline__ int lds_byte(int r, int c) { const int st = (r >> 4) * 2 + (c >> 5), rr = r & 15, cc = c & 31, ob = rr * 64 + cc * 2; return st * 1024 + (ob ^ (((ob >> 9) & 1) << 5)); }
__host__ __device__ __forceinline__ void stage_rc(int b, int& R, int& C) { const int st = b / 1024, sb = b % 1024, swz = sb ^ (((sb >> 9) & 1) << 5); R = (st >> 1) * 16 + swz / 64; C = (st & 1) * 32 + (swz % 64) / 2; }
__host__ __device__ __forceinline__ int perm32(int rho) { const int n = rho >> 4, i = rho & 15; return 8 * (i >> 2) + 4 * n + (i & 3); }

struct Unit { int pm, pn, e, rows; };

typedef int i32x8 __attribute__((ext_vector_type(8)));
typedef int i32x4 __attribute__((ext_vector_type(4)));
template <class Epi, class Sched, bool ALIGN_EPI, bool F8 = false, int SCALE_B = 127>
__device__ __forceinline__ void gemm_phase(PG8_LAS unsigned char* lds, const int KB  , const Sched& S, const Epi& E) {
    const int tid = threadIdx.x, wid = __builtin_amdgcn_readfirstlane(tid >> 6), lane = tid & 63, wr = wid >> 2, wc = wid & 3, fr = lane & 15, fq = lane >> 4;
    const int nt = KB / 128;
    int Rr[2], Cc[2]; unsigned voffB[2];
#pragma unroll
    for (int i = 0; i < 2; ++i) { int R, C; stage_rc(tid * 16 + i * 8192, R, C); Rr[i] = R; Cc[i] = C; const int Rb = (R & ~31) + perm32(R & 31); voffB[i] = (unsigned)(Rb * KB + C * 2); }
    const unsigned kstep = 128u;
    const unsigned hstep = (unsigned)(HALF * KB);
    const unsigned ldsw = (unsigned)wid * 1024u;
    const int aoff = lds_byte(wr * 64 + fr, fq * 8), boff = lds_byte(wc * 32 + fr, fq * 8);
    const char* const Ab = S.abase();
#define PG8_SA(b, h) (((b) * 2 + (h)) * HTB)
#define PG8_SB(b, h) ((4 + (b) * 2 + (h)) * HTB)
#define PG8_DMA(base_, off_, ldsp_) do { unsigned o_ = (off_); asm volatile("" : "+v"(o_)); __builtin_amdgcn_global_load_lds((const unsigned*)((const char*)(base_) + o_), (PG8_LAS unsigned*)(ldsp_), 16, 0, 0); } while (0)
#define PG8_STAGE(bufoff, bbase, kb) do { PG8_DMA(bbase, voffB[0] + (unsigned)(kb), lds + (bufoff) + ldsw); PG8_DMA(bbase, voffB[1] + (unsigned)(kb), lds + (bufoff) + ldsw + 8192); } while (0)
#define PG8_STAGE_A(bufoff, kb, v0_, v1_) do { PG8_DMA(Ab, (v0_) + (unsigned)(kb), lds + (bufoff) + ldsw); PG8_DMA(Ab, (v1_) + (unsigned)(kb), lds + (bufoff) + ldsw + 8192); } while (0)
#define PG8_LD8(p_) __builtin_shufflevector(*(const PG8_LAS i32x4*)(p_), *(const PG8_LAS i32x4*)((p_) + 1024), 0, 1, 2, 3, 4, 5, 6, 7)
#define PG8_LDA(dst, b, h) do { _Pragma("unroll") for (int m = 0; m < 4; ++m) dst[m] = PG8_LD8(lds + PG8_SA(b, h) + aoff + m * 2048); } while (0)
#define PG8_LDB(dst, b, h) do { _Pragma("unroll") for (int n = 0; n < 2; ++n) dst[n] = PG8_LD8(lds + PG8_SB(b, h) + boff + n * 2048); } while (0)
#define PG8_H0(x) __builtin_bit_cast(bf16x8, __builtin_shufflevector(x, x, 0, 1, 2, 3))
#define PG8_H1(x) __builtin_bit_cast(bf16x8, __builtin_shufflevector(x, x, 4, 5, 6, 7))
#define PG8_MMA(ai, bj, At, Bt) do { __builtin_amdgcn_s_setprio(1); _Pragma("unroll") for (int m = 0; m < 4; ++m) _Pragma("unroll") for (int n = 0; n < 2; ++n) { \
        if constexpr (F8) asm volatile("v_mfma_scale_f32_16x16x128_f8f6f4 %0, %1, %2, %0, %3, %4 op_sel_hi:[0,0,0]" : "+v"(acc[ai][bj][m][n]) : "v"(Bt[n]), "v"(At[m]), "v"(sclB), "v"(sclA)); \
        else { acc[ai][bj][m][n] = __builtin_amdgcn_mfma_f32_16x16x32_bf16(PG8_H0(Bt[n]), PG8_H0(At[m]), acc[ai][bj][m][n], 0, 0, 0); \
               acc[ai][bj][m][n] = __builtin_amdgcn_mfma_f32_16x16x32_bf16(PG8_H1(Bt[n]), PG8_H1(At[m]), acc[ai][bj][m][n], 0, 0, 0); } } \
        __builtin_amdgcn_s_setprio(0); } while (0)
#define PG8_WAIT_V(n) asm volatile("s_waitcnt vmcnt(" #n ")" ::: "memory")
#define PG8_WAIT_L(n) asm volatile("s_waitcnt lgkmcnt(" #n ")" ::: "memory")
#define PG8_BAR __builtin_amdgcn_s_barrier()
#define PG8_SCHED __builtin_amdgcn_sched_barrier(0)
    Unit cur, nxt; int ui = 0;
    if (!S.next(0, cur)) return;
    f32x4 acc[2][2][4][2];
#pragma unroll
    for (int a = 0; a < 2; ++a)
#pragma unroll
        for (int b = 0; b < 2; ++b)
#pragma unroll
            for (int m = 0; m < 4; ++m)
#pragma unroll
                for (int n = 0; n < 2; ++n) acc[a][b][m][n] = (f32x4){0.f, 0.f, 0.f, 0.f};
    const int sclB = SCALE_B, sclA = 127;
    i32x8 At[4], B0[2], B1[2];
    unsigned c00, c01, c10, c11, n00, n01, n10, n11;
    S.avoff(cur, Rr, Cc, KB, c00, c01, c10, c11);
    const char* cB = S.btile(cur, KB);
    typename Epi::Pre pre = E.prefetch(cur, wr, wc, fr, fq);
    PG8_STAGE(PG8_SB(0, 0), cB, 0u); PG8_STAGE(PG8_SB(0, 1), cB, hstep); PG8_STAGE_A(PG8_SA(0, 0), 0u, c00, c01); PG8_STAGE_A(PG8_SA(0, 1), 0u, c10, c11);
    if (wr == 1) PG8_BAR;
    PG8_WAIT_V(2); PG8_BAR;
    PG8_STAGE(PG8_SB(1, 0), cB, kstep); PG8_STAGE_A(PG8_SA(1, 0), kstep, c00, c01); PG8_STAGE(PG8_SB(1, 1), cB, hstep + kstep);
    PG8_WAIT_V(6); PG8_BAR;
    for (;;) {
        const bool has_next = S.next(ui + 1, nxt);
        if (!has_next) nxt = cur;
        const char* nB = has_next ? S.btile(nxt, KB) : cB;
        if (has_next) S.avoff(nxt, Rr, Cc, KB, n00, n01, n10, n11); else { n00 = c00; n01 = c01; n10 = c10; n11 = c11; }
        for (int t = 0; t < nt; t += 2) {
            const bool last = (t == nt - 2);
            const unsigned k1 = (unsigned)(t + 1) * kstep;
            const unsigned k2 = last ? 0u : (unsigned)(t + 2) * kstep, k3 = k2 + kstep;
            const unsigned x00 = last ? n00 : c00, x01 = last ? n01 : c01, x10 = last ? n10 : c10, x11 = last ? n11 : c11;
            const char* b2 = last ? nB : cB;
            PG8_LDB(B0, 0, 0); PG8_LDB(B1, 0, 1); PG8_SCHED; PG8_LDA(At, 0, 0); PG8_STAGE_A(PG8_SA(1, 1), k1, c10, c11);
            PG8_WAIT_V(8); PG8_WAIT_L(0); PG8_BAR; PG8_MMA(0, 0, At, B0); PG8_MMA(0, 1, At, B1); PG8_BAR; PG8_SCHED;
            PG8_LDA(At, 0, 1); PG8_STAGE(PG8_SB(0, 0), b2, k2); PG8_STAGE(PG8_SB(0, 1), b2, k2 + hstep); PG8_STAGE_A(PG8_SA(0, 0), k2, x00, x01);
            PG8_WAIT_V(8); PG8_WAIT_L(0); PG8_BAR; PG8_MMA(1, 0, At, B0); PG8_MMA(1, 1, At, B1); PG8_BAR; PG8_SCHED;
            PG8_LDB(B0, 1, 0); PG8_LDB(B1, 1, 1); PG8_SCHED; PG8_LDA(At, 1, 0); PG8_STAGE_A(PG8_SA(0, 1), k2, x10, x11);
            PG8_WAIT_V(8); PG8_WAIT_L(0); PG8_BAR; PG8_MMA(0, 0, At, B0); PG8_MMA(0, 1, At, B1); PG8_BAR; PG8_SCHED;
            PG8_LDA(At, 1, 1); PG8_STAGE(PG8_SB(1, 0), b2, k3); PG8_STAGE(PG8_SB(1, 1), b2, k3 + hstep); PG8_STAGE_A(PG8_SA(1, 0), k3, x00, x01);
            PG8_WAIT_V(8); PG8_WAIT_L(0); PG8_BAR; PG8_MMA(1, 0, At, B0); PG8_MMA(1, 1, At, B1); PG8_BAR; PG8_SCHED;
        }
        if constexpr (ALIGN_EPI) { if (wr == 0) PG8_BAR; }
        if constexpr (F8) asm volatile("s_nop 15\n\ts_nop 15" ::: "memory");
        { int fr2 = fr, fq2 = fq; asm volatile("" : "+v"(fr2), "+v"(fq2)); E(acc, cur, wr, wc, fr2, fq2, pre); }
        if (!has_next) break;
#pragma unroll
        for (int a = 0; a < 2; ++a)
#pragma unroll
            for (int b = 0; b < 2; ++b)
#pragma unroll
                for (int m = 0; m < 4; ++m)
#pragma unroll
                    for (int n = 0; n < 2; ++n) acc[a][b][m][n] = (f32x4){0.f, 0.f, 0.f, 0.f};
        cur = nxt; cB = nB; c00 = n00; c01 = n01; c10 = n10; c11 = n11; ++ui;
        pre = E.prefetch(cur, wr, wc, fr, fq);
        if constexpr (ALIGN_EPI) { if (wr == 1) PG8_BAR; }
    }
    PG8_WAIT_V(0);
    if constexpr (!ALIGN_EPI) { if (wr == 0) PG8_BAR; }
    PG8_BAR;
#undef PG8_SA
#undef PG8_SB
#undef PG8_STAGE
#undef PG8_DMA
#undef PG8_STAGE_A
#undef PG8_LDA
#undef PG8_LD8
#undef PG8_H0
#undef PG8_H1
#undef PG8_LDB
#undef PG8_MMA
#undef PG8_WAIT_V
#undef PG8_WAIT_L
#undef PG8_BAR
#undef PG8_SCHED
}
}
namespace fa16 {
constexpr int D = 128, NW = 8, QBLK = 32, KVBLK = 64, QB = NW * QBLK;
constexpr int SHM_V = KVBLK * D * 2, SHM_K = KVBLK * D * 2;
constexpr int NVB = 3;
constexpr int WS_OFF = NVB * SHM_V + 2 * SHM_K;
constexpr int SELM_OFF = WS_OFF + NW * 64 * 4;
constexpr int LDS_BYTES = SELM_OFF + 1024;
constexpr float SCALE = 0.08838834764831845f;
constexpr float THR = 8.f;

#define KSWZ(row, colB) ((row) * 256 + ((colB) ^ (((row) & 7) << 4)))
__device__ __forceinline__ int v_st(int k, int c) { const int kk = (k & ~0xC) | ((k & 4) << 1) | ((k & 8) >> 1); return ((kk >> 3) * 4 + (c >> 5)) * 512 + ((kk & 7) * 32 + (c & 31)) * 2; }
__device__ __forceinline__ int v_rd_base(int lane) { return ((lane & 3) << 3) | (((lane >> 2) & 3) << 6) | (((lane >> 4) & 1) << 5) | (((lane >> 5) & 1) << 8); }
constexpr int v_rd_off(int d0, int ks, int half) { return d0 * 512 + ks * 4096 + half * 2048; }
__device__ __forceinline__ int crow(int r, int hi) { return (r & 3) + 8 * (r >> 2) + 4 * hi; }
__device__ __forceinline__ bf16x8 load8(const bf16* p) { return *reinterpret_cast<const bf16x8*>(p); }

template <int KS>
__device__ __forceinline__ void mask_tile(f32x16& p0, f32x16& p1, int dq, unsigned Wk) {
    const float NEG = -__builtin_inff();
#pragma unroll
    for (int r = 0; r < 16; ++r) {
        const int c = KS * ((r & 3) + 8 * (r >> 2));
        if ((unsigned)(dq - c) >= Wk) p0[r] = NEG;
        if ((unsigned)(dq - c - KS * 32) >= Wk) p1[r] = NEG;
    }
}
__device__ __forceinline__ void kill_tile(f32x16& p0, f32x16& p1, bool keep) {
    const float NEG = -__builtin_inff();
#pragma unroll
    for (int r = 0; r < 16; ++r) { p0[r] = keep ? p0[r] : NEG; p1[r] = keep ? p1[r] : NEG; }
}
__device__ __forceinline__ void partialSM(f32x16& p0, f32x16& p1, float& m_reg, float& mn, float& alpha) {
    float pmax = p0[0]; for (int r = 1; r < 16; ++r) pmax = fmaxf(pmax, p0[r]); for (int r = 0; r < 16; ++r) pmax = fmaxf(pmax, p1[r]);
    { auto rr = __builtin_amdgcn_permlane32_swap(__float_as_uint(pmax), __float_as_uint(pmax), false, false);
      pmax = fmaxf(__uint_as_float(rr[0]), __uint_as_float(rr[1])); }
    constexpr float C2 = 1.4426950408889634f * SCALE;
    if (__builtin_expect(__all((pmax - m_reg) * SCALE <= THR), 1)) { mn = m_reg; alpha = 1.f; }
    else { mn = fmaxf(m_reg, pmax); alpha = __builtin_amdgcn_exp2f((m_reg - mn) * C2); m_reg = mn; }
    const float mnL = -mn * C2;
    for (int r = 0; r < 16; ++r) p0[r] = fmaf(p0[r], C2, mnL); for (int r = 0; r < 16; ++r) p1[r] = fmaf(p1[r], C2, mnL);
    for (int r = 0; r < 16; ++r) p0[r] = __builtin_amdgcn_exp2f(p0[r]);
}
#define FA_PK4(P, B_, OUT) do { unsigned a0 = cvtpk(P[B_+0], P[B_+1]), a1 = cvtpk(P[B_+2], P[B_+3]);                          \
        unsigned b0 = cvtpk(P[B_+4], P[B_+5]), b1 = cvtpk(P[B_+6], P[B_+7]);                                             \
        auto r0 = __builtin_amdgcn_permlane32_swap(a0, b0, false, false); auto r1 = __builtin_amdgcn_permlane32_swap(a1, b1, false, false); \
        v4u w = {r0[0], r1[0], r0[1], r1[1]}; OUT = *reinterpret_cast<bf16x8*>(&w); } while (0)
__device__ __forceinline__ void pack_p(const f32x16& p0, const f32x16& p1, bf16x8& pa0, bf16x8& pa1, bf16x8& pa2, bf16x8& pa3) {
    FA_PK4(p0, 0, pa0); FA_PK4(p0, 8, pa1); FA_PK4(p1, 0, pa2); FA_PK4(p1, 8, pa3);
}
__device__ __forceinline__ void finishSM(f32x16& p0, f32x16& p1, float alpha, float& l_reg, bf16x8& pa0, bf16x8& pa1, bf16x8& pa2, bf16x8& pa3) {
    for (int r = 0; r < 16; ++r) p1[r] = __builtin_amdgcn_exp2f(p1[r]);
    float ps = 0; for (int r = 0; r < 16; ++r) ps += p0[r]; for (int r = 0; r < 16; ++r) ps += p1[r];
    { auto rr = __builtin_amdgcn_permlane32_swap(__float_as_uint(ps), __float_as_uint(ps), false, false);
      ps = __uint_as_float(rr[0]) + __uint_as_float(rr[1]); }
    l_reg = l_reg * alpha + ps;
    pack_p(p0, p1, pa0, pa1, pa2, pa3);
}
template <int KB, bool SK>
__device__ __forceinline__ void qkt(f32x16& p0, f32x16& p1, const char* K_lds, int r32, int hi, const bf16x8* qr, bool act) {
    if (SK && !act) { const float NEG = -__builtin_inff();
#pragma unroll
        for (int r = 0; r < 16; ++r) { p0[r] = NEG; p1[r] = NEG; } return; }
    p0 = f32x16{}; p1 = f32x16{};
    const char* kb[4];
#pragma unroll
    for (int dd = 0; dd < 4; ++dd) kb[dd] = K_lds + KB * SHM_K + KSWZ(r32, (dd * 16 + hi * 8) * 2);
#pragma unroll
    for (int d0 = 0; d0 < 8; ++d0) { const char* a = kb[d0 & 3] + (d0 >> 2) * 128;
        bf16x8 b0 = *reinterpret_cast<const bf16x8*>(a);
        bf16x8 b1 = *reinterpret_cast<const bf16x8*>(a + 32 * 256);
        p0 = __builtin_amdgcn_mfma_f32_32x32x16_bf16(b0, qr[d0], p0, 0, 0, 0);
        p1 = __builtin_amdgcn_mfma_f32_32x32x16_bf16(b1, qr[d0], p1, 0, 0, 0); }
}
template <int VB, bool SK>
__device__ __forceinline__ void pv_tile(f32x16* o, int vb0, bf16x8 pa0, bf16x8 pa1, bf16x8 pa2, bf16x8 pa3, bool act) {
    if (SK && !act) return;
#define TRRD(dst, off) asm volatile("ds_read_b64_tr_b16 %0, %1 offset:%2" : "=&v"(dst) : "v"(vb0), "i"(off) : "memory")
#define PV_D0(d0) do { s16x4 l0, l1, l2, l3, h0, h1, h2, h3; constexpr int b_ = VB * SHM_V + v_rd_off(d0, 0, 0); \
        TRRD(l0, b_); TRRD(h0, b_ + 2048); TRRD(l1, b_ + 4096); TRRD(h1, b_ + 6144); TRRD(l2, b_ + 8192); TRRD(h2, b_ + 10240); TRRD(l3, b_ + 12288); TRRD(h3, b_ + 14336); \
        asm volatile("s_waitcnt lgkmcnt(0)" ::: "memory"); SBAR();   \
        o[d0] = __builtin_amdgcn_mfma_f32_32x32x16_bf16(pa0, (bf16x8){l0[0], l0[1], l0[2], l0[3], h0[0], h0[1], h0[2], h0[3]}, o[d0], 0, 0, 0);   \
        o[d0] = __builtin_amdgcn_mfma_f32_32x32x16_bf16(pa1, (bf16x8){l1[0], l1[1], l1[2], l1[3], h1[0], h1[1], h1[2], h1[3]}, o[d0], 0, 0, 0);   \
        o[d0] = __builtin_amdgcn_mfma_f32_32x32x16_bf16(pa2, (bf16x8){l2[0], l2[1], l2[2], l2[3], h2[0], h2[1], h2[2], h2[3]}, o[d0], 0, 0, 0);   \
        o[d0] = __builtin_amdgcn_mfma_f32_32x32x16_bf16(pa3, (bf16x8){l3[0], l3[1], l3[2], l3[3], h3[0], h3[1], h3[2], h3[3]}, o[d0], 0, 0, 0); } while (0)
    PV_D0(0); PV_D0(1); PV_D0(2); PV_D0(3);
#undef PV_D0
#undef TRRD
}

}
namespace fa {
constexpr int D = 128, NW = 8, QBLK = 32, KVBLK = 64, QB = NW * QBLK, SEQ_V = 8192;
constexpr int KPITCH = 144, VPITCH = 80;
constexpr int SHM_V = D * VPITCH, SHM_K = KVBLK * KPITCH;
typedef int fi8 __attribute__((ext_vector_type(8)));
constexpr int SC_IN = 123;
constexpr float PSH = 7.f;
constexpr int NVB = 3;
constexpr int WS_OFF = NVB * SHM_V + 2 * SHM_K;
constexpr int SELM_OFF = WS_OFF + NW * 64 * 4;
constexpr int LDS_BYTES = SELM_OFF + 1024;
constexpr float SCALE = 0.08838834764831845f;
constexpr float THR = 1.f;

__device__ __forceinline__ unsigned pk4f8(float a, float b, float c, float d) { int w = __builtin_amdgcn_cvt_pk_fp8_f32(a, b, 0, false); w = __builtin_amdgcn_cvt_pk_fp8_f32(c, d, w, true); return (unsigned)w; }
__device__ __forceinline__ f32x16 mfma8(fi8 a, fi8 b, f32x16 c, int sa, int sb) { return __builtin_amdgcn_mfma_scale_f32_32x32x64_f8f6f4(a, b, c, 0, 0, 0, sa, 0, sb); }
__device__ __forceinline__ fi8 ld32(const char* p) { const v4u a = *reinterpret_cast<const v4u*>(p), b = *reinterpret_cast<const v4u*>(p + 16); return fi8{(int)a.x, (int)a.y, (int)a.z, (int)a.w, (int)b.x, (int)b.y, (int)b.z, (int)b.w}; }
__device__ __forceinline__ int crow(int r, int hi) { return (r & 3) + 8 * (r >> 2) + 4 * hi; }

template <int KS>
__device__ __forceinline__ void mask_tile(f32x16& p0, f32x16& p1, int dq, unsigned Wk) {
    const float NEG = -__builtin_inff();
#pragma unroll
    for (int r = 0; r < 16; ++r) {
        const int c = KS * ((r & 3) + 8 * (r >> 2));
        if ((unsigned)(dq - c) >= Wk) p0[r] = NEG;
        if ((unsigned)(dq - c - KS * 32) >= Wk) p1[r] = NEG;
    }
}
__device__ __forceinline__ void kill_tile(f32x16& p0, f32x16& p1, bool keep) {
    const float NEG = -__builtin_inff();
#pragma unroll
    for (int r = 0; r < 16; ++r) { p0[r] = keep ? p0[r] : NEG; p1[r] = keep ? p1[r] : NEG; }
}
__device__ __forceinline__ void partialSM(f32x16& p0, f32x16& p1, float& m_reg, float& mn, float& alpha) {
    float pmax = p0[0]; for (int r = 1; r < 16; ++r) pmax = fmaxf(pmax, p0[r]); for (int r = 0; r < 16; ++r) pmax = fmaxf(pmax, p1[r]);
    { auto rr = __builtin_amdgcn_permlane32_swap(__float_as_uint(pmax), __float_as_uint(pmax), false, false);
      pmax = fmaxf(__uint_as_float(rr[0]), __uint_as_float(rr[1])); }
    constexpr float C2 = 1.4426950408889634f * SCALE;
    if (__builtin_expect(__all((pmax - m_reg) * SCALE <= THR), 1)) { mn = m_reg; alpha = 1.f; }
    else { mn = fmaxf(m_reg, pmax); alpha = __builtin_amdgcn_exp2f((m_reg - mn) * C2); m_reg = mn; }
    const float mnL = PSH - mn * C2;
    for (int r = 0; r < 16; ++r) p0[r] = fmaf(p0[r], C2, mnL); for (int r = 0; r < 16; ++r) p1[r] = fmaf(p1[r], C2, mnL);
    for (int r = 0; r < 16; ++r) p0[r] = __builtin_amdgcn_exp2f(p0[r]);
}
__device__ __forceinline__ void pack_p(const f32x16& p0, const f32x16& p1, fi8& pa) {
#pragma unroll
    for (int i = 0; i < 4; ++i) { pa[i] = (int)pk4f8(p0[4 * i], p0[4 * i + 1], p0[4 * i + 2], p0[4 * i + 3]); pa[4 + i] = (int)pk4f8(p1[4 * i], p1[4 * i + 1], p1[4 * i + 2], p1[4 * i + 3]); }
}
__device__ __forceinline__ void finishSM(f32x16& p0, f32x16& p1, float alpha, float& l_reg, fi8& pa) {
    for (int r = 0; r < 16; ++r) p1[r] = __builtin_amdgcn_exp2f(p1[r]);
    float ps = 0; for (int r = 0; r < 16; ++r) ps += p0[r]; for (int r = 0; r < 16; ++r) ps += p1[r];
    { auto rr = __builtin_amdgcn_permlane32_swap(__float_as_uint(ps), __float_as_uint(ps), false, false);
      ps = __uint_as_float(rr[0]) + __uint_as_float(rr[1]); }
    l_reg = l_reg * alpha + ps;
    pack_p(p0, p1, pa);
}
template <int KB, bool SK>
__device__ __forceinline__ void qkt(f32x16& p0, f32x16& p1, const char* kb, const fi8* qr, bool act) {
    if (SK && !act) { const float NEG = -__builtin_inff();
#pragma unroll
        for (int r = 0; r < 16; ++r) { p0[r] = NEG; p1[r] = NEG; } return; }
    p0 = f32x16{}; p1 = f32x16{};
    const fi8 a00 = ld32(kb + KB * SHM_K), a10 = ld32(kb + KB * SHM_K + 32 * KPITCH), a01 = ld32(kb + KB * SHM_K + 64), a11 = ld32(kb + KB * SHM_K + 32 * KPITCH + 64);
    __builtin_amdgcn_s_setprio(1);
    p0 = mfma8(a00, qr[0], p0, SC_IN, SC_IN); p1 = mfma8(a10, qr[0], p1, SC_IN, SC_IN);
    p0 = mfma8(a01, qr[1], p0, SC_IN, SC_IN); p1 = mfma8(a11, qr[1], p1, SC_IN, SC_IN);
    __builtin_amdgcn_s_setprio(0);
}
template <int VB, bool SK>
__device__ __forceinline__ void pv_tile(f32x16* o, const char* vb, fi8 pa, bool act) {
    if (SK && !act) return;
    const fi8 b0 = ld32(vb + VB * SHM_V), b1 = ld32(vb + VB * SHM_V + 32 * VPITCH), b2 = ld32(vb + VB * SHM_V + 64 * VPITCH), b3 = ld32(vb + VB * SHM_V + 96 * VPITCH);
    __builtin_amdgcn_s_setprio(1);
    o[0] = mfma8(pa, b0, o[0], 127, SC_IN); o[1] = mfma8(pa, b1, o[1], 127, SC_IN); o[2] = mfma8(pa, b2, o[2], 127, SC_IN); o[3] = mfma8(pa, b3, o[3], 127, SC_IN);
    __builtin_amdgcn_s_setprio(0);
}

struct BlockRef { const unsigned char* Q; const unsigned char* K; const unsigned char* V; bf16* O; const unsigned* selsrc; int P0, ksh, W, sel; };
struct Seam { fi8 qr[2]; v4u st_v, st_k; };
__device__ __forceinline__ int blk_jlo(const BlockRef& b) { const int lowk = (b.P0 >> b.ksh) - b.W + 1; return lowk > 0 ? lowk / KVBLK : 0; }
#define FA_VMW() asm volatile("s_waitcnt vmcnt(0)" ::: "memory")
#define FA_VMWN(n) asm volatile("s_waitcnt vmcnt(%0)" :: "i"(n) : "memory")
#define FA_SLOAD_H(Kp, Vp, k0) do { S.st_v = *(const v4u*)((Vp) + (size_t)(tid >> 2) * SEQ_V + (k0) + (tid & 3) * 16);              \
                         S.st_k = *(const v4u*)((Kp) + (size_t)((k0) + (tid >> 3)) * D + (tid & 7) * 16); } while (0)
#define FA_SWRITE_HK(bf) do { *(v4u*)(K_lds + (bf) * SHM_K + kws) = S.st_k; } while (0)
#define FA_SWRITE_HV(bf) do { *(v4u*)(V_lds + (bf) * SHM_V + vws) = S.st_v; } while (0)
#define FA_SWRITE_H(bf) do { FA_SWRITE_HV(bf); FA_SWRITE_HK(bf); } while (0)
#define FA_QLOAD(Qp) do { const unsigned char* q_ = (Qp) + (size_t)(wid * QBLK + r32) * D + hi * 32; const v4u a_ = *(const v4u*)q_, b_ = *(const v4u*)(q_ + 16), c_ = *(const v4u*)(q_ + 64), d_ = *(const v4u*)(q_ + 80); \
        S.qr[0] = fi8{(int)a_.x, (int)a_.y, (int)a_.z, (int)a_.w, (int)b_.x, (int)b_.y, (int)b_.z, (int)b_.w}; S.qr[1] = fi8{(int)c_.x, (int)c_.y, (int)c_.z, (int)c_.w, (int)d_.x, (int)d_.y, (int)d_.z, (int)d_.w}; } while (0)

__device__ __forceinline__ int selrow() { int t = threadIdx.x; asm volatile("" : "+v"(t)); return (((t >> 6) * QBLK + (t & 31)) >> 2) * 4; }
__device__ __forceinline__ void fa_prime(const BlockRef& cur, char* lds, Seam& S) {
    const int tid = threadIdx.x, wid = __builtin_amdgcn_readfirstlane(tid >> 6), lane = tid & 63, r32 = lane & 31, hi = lane >> 5;
    const int kws = (tid >> 3) * KPITCH + (tid & 7) * 16; char* K_lds = lds + NVB * SHM_V;
    const int kb0 = blk_jlo(cur) * KVBLK;
    FA_QLOAD(cur.Q);
    FA_SLOAD_H(cur.K, cur.V, kb0); FA_VMW(); FA_SWRITE_HK(0);
    __syncthreads();
}
template <class BG>
__device__ __forceinline__ void fa_block(const BlockRef& cur, const BlockRef& nxt, int skv, char* lds, Seam& S, unsigned* qhead, LAS int* qslot, BG& bg) {
    constexpr bool SK = true;
    const int tid = threadIdx.x, wid = __builtin_amdgcn_readfirstlane(tid >> 6), lane = tid & 63, r32 = lane & 31, hi = lane >> 5;
    const int ksh = cur.ksh, W = cur.W; const bool selm = cur.sel != 0;
    const int j_lo = blk_jlo(cur);
    int j_hi = ((cur.P0 + QB - 1) >> ksh) / KVBLK + 1; if (j_hi > skv / KVBLK) j_hi = skv / KVBLK;
    const int NT = j_hi - j_lo;
    const int kbn = blk_jlo(nxt) * KVBLK;
    const int qlo = cur.P0 + wid * QBLK;
    const int tlo = qlo >> ksh, thi = (qlo + QBLK - 1) >> ksh;
#define DQB() ({ int l2_ = threadIdx.x; asm volatile("" : "+v"(l2_)); qlo + (l2_ & 31) - ((4 * ((l2_ >> 5) & 1)) << ksh); })
    const unsigned Wk = (unsigned)W << ksh;
    char* V_lds = lds; char* K_lds = lds + NVB * SHM_V;
    float* ws = (float*)(lds + WS_OFF) + wid * 64; float* li_l = ws, * al_l = ws + 32;
    unsigned* selmask = (unsigned*)(lds + SELM_OFF);
    int tid2 = threadIdx.x; asm volatile("" : "+v"(tid2));
    const unsigned selw = cur.selsrc[tid2 & 255];
    int tkt = 0; if (tid2 == 0) tkt = (int)__hip_atomic_fetch_add(qhead, 1u, RLX_AGENT);
    float m_reg = -1e30f, l_reg = 0; f32x16 o[4] = {};
    const int kws = (tid >> 3) * KPITCH + (tid & 7) * 16, vws = (tid >> 2) * VPITCH + (tid & 3) * 16;
    const char* vb0 = V_lds + r32 * VPITCH + hi * 32; const char* kb0r = K_lds + r32 * KPITCH + hi * 32;
    const unsigned char* Kh = cur.K; const unsigned char* Vh = cur.V;
#define RESC(a) do { if (__any((a) < 1.f)) { if (hi == 0) al_l[r32] = (a); asm volatile("s_waitcnt lgkmcnt(0)" ::: "memory");              \
                     for (int d_ = 0; d_ < 4; ++d_) for (int r = 0; r < 16; ++r) o[d_][r] *= al_l[crow(r, hi)]; } } while (0)
#define KBASE(t) ((j_lo + (t)) * KVBLK)
#define GEO(t) (KBASE(t) <= thi && KBASE(t) + KVBLK - 1 >= tlo - W + 1)
#define SELBIT(t) ((!selm || (j_lo + (t)) == 0) ? true : (((selmask[selrow() + ((j_lo + (t)) >> 5)] >> ((j_lo + (t)) & 31)) & 1u) != 0u))
#define MASKT(P0_, P1_, t, act_, bit_) do { const int kb_ = KBASE(t); if (act_) { if (kb_ + KVBLK - 1 > tlo || kb_ <= thi - W) { \
        if (ksh) mask_tile<4>(P0_, P1_, DQB() - (kb_ << 2), Wk); else mask_tile<1>(P0_, P1_, DQB() - kb_, Wk); } \
        if (selm) kill_tile(P0_, P1_, bit_); } } while (0)
    constexpr int NQL = 4;
#define SEAM_K0() do { FA_VMWN(NQL); FA_SWRITE_HK(0); SBAR(); } while (0)
    f32x16 pA0, pA1, pB0, pB1; float mnA, mnB, alA, alB; fi8 pa;
    bool bitA, bitB, actA, actB;
    FA_SWRITE_HV(0); SBAR();
    if (NT > 1) { FA_SLOAD_H(Kh, Vh, KBASE(1)); }
    bitA = true; actA = GEO(0);
    if (selm && j_lo != 0) { bitA = SELBIT(0); actA = actA && __any(bitA); }
    SBAR(); qkt<0, SK>(pA0, pA1, kb0r, S.qr, actA);
    MASKT(pA0, pA1, 0, actA, bitA); partialSM(pA0, pA1, m_reg, mnA, alA);
    if (NT > 1) { FA_VMW(); FA_SWRITE_H(1); }
    if (selm && tid2 < 256) selmask[tid2] = selw;
    if (tid2 == 0) *qslot = tkt;
    __syncthreads();
#define VADV(x) ((x) == NVB - 1 ? 0 : (x) + 1)
#define HALF_STEP(PX0, PX1, mnX, alX, actX, bitX, PY0, PY1, alY, actY, t, KB) do {                                           \
        bitX = SELBIT(t); actX = GEO(t) && (!selm || __any(bitX));                                                            \
        SBAR(); qkt<KB, SK>(PX0, PX1, kb0r, S.qr, actX);                                                            \
        finishSM(PY0, PY1, alY, l_reg, pa); SBAR();                                                           \
        if ((t) + 1 < NT) { FA_SLOAD_H(Kh, Vh, KBASE((t) + 1)); SBAR(); }                                                     \
        pv_tile<0, SK>(o, vb0 + vp * SHM_V, pa, actY); MASKT(PX0, PX1, (t), actX, bitX); partialSM(PX0, PX1, m_reg, mnX, alX); \
        if ((t) + 1 < NT) { FA_VMW(); FA_SWRITE_HV(vn); FA_SWRITE_HK((KB) ^ 1); }                                             \
        vp = VADV(vp); vn = VADV(vn);                                                                                         \
        RESC(alX); __syncthreads(); } while (0)
    int vp = 0, vn = 2;
    for (int t = 1; t + 1 < NT; t += 2) {
        HALF_STEP(pB0, pB1, mnB, alB, actB, bitB, pA0, pA1, alA, actA, t, 1);
        HALF_STEP(pA0, pA1, mnA, alA, actA, bitA, pB0, pB1, alB, actB, t + 1, 0);
        bg.slot();
    }
    const bool even = (NT & 1) == 0;
    if (even) { bitB = SELBIT(NT - 1); actB = GEO(NT - 1) && (!selm || __any(bitB)); SBAR(); qkt<1, SK>(pB0, pB1, kb0r, S.qr, actB); SBAR(); }
    FA_SLOAD_H(nxt.K, nxt.V, kbn); SBAR();
    FA_QLOAD(nxt.Q);
    SBAR();
    finishSM(pA0, pA1, alA, l_reg, pa); SBAR();
    pv_tile<0, SK>(o, vb0 + vp * SHM_V, pa, actA);
    if (even) { MASKT(pB0, pB1, NT - 1, actB, bitB); partialSM(pB0, pB1, m_reg, mnB, alB); __syncthreads(); RESC(alB);
        finishSM(pB0, pB1, alB, l_reg, pa); SBAR(); pv_tile<0, SK>(o, vb0 + VADV(vp) * SHM_V, pa, actB); }
    SBAR(); SEAM_K0();
    if (hi == 0) li_l[r32] = l_reg; asm volatile("s_waitcnt lgkmcnt(0)" ::: "memory");
    float rli[16];
#pragma unroll
    for (int r = 0; r < 16; ++r) { const float lv = li_l[crow(r, hi)]; rli[r] = lv > 0.f ? __builtin_amdgcn_rcpf(lv) : 0.f; }
    int t3 = threadIdx.x; asm volatile("" : "+v"(t3));
    bf16* Ow = cur.O + (unsigned)(((t3 >> 6) * QBLK + 4 * ((t3 >> 5) & 1)) * D + (t3 & 31));
#pragma unroll
    for (int r = 0; r < 16; ++r) { const int orow = (r & 3) + 8 * (r >> 2);
#pragma unroll
        for (int d0 = 0; d0 < 4; ++d0) { const float v = o[d0][r] * rli[r];
            const float vn = __shfl_xor(v, 1);
            if ((t3 & 1) == 0) *(unsigned*)(Ow + orow * D + d0 * 32) = cvtpk(v, vn); } }
    __syncthreads();
#undef DQB
#undef RESC
#undef KBASE
#undef GEO
#undef SELBIT
#undef MASKT
#undef SEAM_K0
#undef HALF_STEP
#undef VADV
}
}
constexpr size_t MiB = 1u << 20;
constexpr size_t WS_CTL = 0, CTL_ZERO_BYTES = 1 * MiB;
constexpr size_t WS_ITEMS = 1 * MiB;
constexpr size_t WS_SCAL = 1 * MiB + 65536;
constexpr size_t WS_ROPE = 2 * MiB;
constexpr size_t WS_WIN_T = 4 * MiB, WS_WOUT_T = 28 * MiB, WS_WCAT = 36 * MiB;
constexpr size_t WS_XN = 40 * MiB;
constexpr size_t WS_QNSA = 104 * MiB;
constexpr size_t WS_KV6 = 136 * MiB, KV6_STRIDE = 10 * MiB;
constexpr size_t WS_KCA = WS_KV6, WS_VCA = WS_KV6 + KV6_STRIDE, WS_KSLC = WS_KV6 + 2 * KV6_STRIDE, WS_VSLC = WS_KV6 + 3 * KV6_STRIDE, WS_KWIN = WS_KV6 + 4 * KV6_STRIDE, WS_VWIN = WS_KV6 + 5 * KV6_STRIDE;
constexpr size_t WS_QD = 196 * MiB, WS_KD = 228 * MiB, WS_VD = 260 * MiB;
constexpr size_t WS_GATES = 292 * MiB;
constexpr size_t WS_G = 294 * MiB, G_STRIDE = 5 * MiB;
constexpr size_t WS_KCMP = 304 * MiB, WS_VCMP = 305 * MiB;
constexpr size_t WS_SELM = 306 * MiB;
constexpr size_t WS_OCMP = 308 * MiB, WS_OSLC = 340 * MiB, WS_OWIN = 372 * MiB;
constexpr size_t WS_ODIFF = 404 * MiB;
constexpr size_t WS_MIX = 468 * MiB;
constexpr size_t WS_HN = 532 * MiB;
constexpr size_t WS_LIST = 596 * MiB, WS_GATEW = 598 * MiB;
constexpr size_t WS_HB = 600 * MiB;
constexpr size_t WS_Q8NSA = 744 * MiB, WS_K8SLC = 760 * MiB, WS_K8WIN = 764 * MiB, WS_Q8D = 768 * MiB, WS_K8D = 784 * MiB;
constexpr size_t WS_VT = 800 * MiB;
constexpr size_t WS_HBF = 824 * MiB;
constexpr size_t WS_YS = 888 * MiB;
constexpr size_t WS_WGU_T = 1184 * MiB, WS_WD_T = 1656 * MiB;
constexpr size_t WS_INV = 1448 * MiB;
constexpr size_t WS_END = 1912 * MiB;
constexpr int CW_TMO = 0, CW_CODE = 1;
constexpr int CW_BAR = 4096;
constexpr int CW_QHEAD = 8192;
constexpr int CW_ECNT = 12288;
constexpr int CW_CHK = 16384;
constexpr int RING_BYTES = 131072;
constexpr int LDSX_OFF = RING_BYTES;
constexpr int LDSCTL_OFF = RING_BYTES + 8192, MISC_OFF = LDSCTL_OFF + 320;
constexpr int LDS_BYTES = 147456;
constexpr int NITEMS_ATT = 2048;

struct KArgs { const float* in[26]; float* out; unsigned char* ws; int ph_lo, ph_hi, rep, pad; };

struct DenseSched {
    const char* A; const char* Bt; int nM, nN, nwg, G, c;
    __device__ __forceinline__ void init(const void* A_, const void* Bt_, int M, int N, int G_, int c_) { A = (const char*)A_; Bt = (const char*)Bt_; nM = M / 256; nN = N / 256; nwg = nM * nN; G = G_; c = c_; }
    __device__ __forceinline__ const char* abase() const { return A; }
    __device__ __forceinline__ bool next(int i, pg8::Unit& u) const {
        const long L = (long)i * G + c; if (L >= nwg) return false;
        int wgid = (int)L; { const int q = nwg / 8, r = nwg % 8, xcd = wgid % 8, off = wgid / 8; wgid = (xcd < r ? xcd * (q + 1) : r * (q + 1) + (xcd - r) * q) + off; }
        const int nig = 8 * nN, gid = wgid / nig, fm = gid * 8, gsz = (nM - fm) < 8 ? (nM - fm) : 8;
        u.pm = fm + ((wgid % nig) % gsz); u.pn = (wgid % nig) / gsz; u.e = 0; u.rows = 256;
        if (nN == 8) u.pn = ((u.pn & 3) << 1) | (u.pn >> 2);
        return true;
    }
    __device__ __forceinline__ void avoff(const pg8::Unit& u, const int (&R)[2], const int (&C)[2], int KB, unsigned& v00, unsigned& v01, unsigned& v10, unsigned& v11) const {
        const unsigned base = (unsigned)(u.pm * 256) * (unsigned)KB;
        v00 = base + (unsigned)(R[0] * KB + C[0] * 2); v01 = base + (unsigned)(R[1] * KB + C[1] * 2);
        v10 = v00 + (unsigned)(128 * KB); v11 = v01 + (unsigned)(128 * KB);
    }
    __device__ __forceinline__ const char* btile(const pg8::Unit& u, int KB) const { return Bt + (size_t)u.pn * 256 * KB; }
};
struct CmpSched {
    const char* A; const char* Bt; int c;
    __device__ __forceinline__ const char* abase() const { return A; }
    __device__ __forceinline__ bool next(int i, pg8::Unit& u) const { if (i > 0 || c >= 36) return false; u.e = c / 18; const int r = c % 18; u.pm = r >> 1; u.pn = r & 1; u.rows = 256; return true; }
    __device__ __forceinline__ void avoff(const pg8::Unit& u, const int (&R)[2], const int (&C)[2], int KB, unsigned& v00, unsigned& v01, unsigned& v10, unsigned& v11) const {
        const unsigned base = (unsigned)u.e * (unsigned)KV6_STRIDE + (unsigned)(u.pm * 256) * (unsigned)KB;
        v00 = base + (unsigned)(R[0] * KB + C[0] * 2); v01 = base + (unsigned)(R[1] * KB + C[1] * 2);
        v10 = v00 + (unsigned)(128 * KB); v11 = v01 + (unsigned)(128 * KB);
    }
    __device__ __forceinline__ const char* btile(const pg8::Unit& u, int KB) const { return Bt + ((size_t)u.e * 512 + (size_t)u.pn * 256) * KB; }
};
template <bool GATHER, int NT_>
struct MoeSched {
    const char* A; const char* Bt; size_t bstride; const int* list; const LAS int* tb; const LAS int* cnt; int G, c, ntot;
    __device__ __forceinline__ const char* abase() const { return A; }
    __device__ __forceinline__ bool next(int i, pg8::Unit& u) const {
        int mt;
        if (G == 256) {
            const int x = c & 7, j = c >> 3;
            if (NT_ == 16) { u.pn = (x & 3) * 4 + (j & 3); mt = i * 16 + (x >> 2) * 8 + (j >> 2); }
            else           { u.pn = (x & 1) * 4 + (j & 3); mt = i * 32 + (x >> 1) * 8 + (j >> 2); }
            if (mt >= ntot) return false;
        } else { const long L = (long)i * G + c; if (L >= (long)ntot * NT_) return false; mt = (int)(L / NT_); u.pn = (int)(L % NT_); }
        u.pm = mt;
        int e = 0;
#pragma unroll
        for (int st = 16; st > 0; st >>= 1) e = (__builtin_amdgcn_readfirstlane(tb[e + st]) <= mt) ? e + st : e;
        u.e = e; const int left = __builtin_amdgcn_readfirstlane(cnt[e]) - (mt - __builtin_amdgcn_readfirstlane(tb[e])) * 256; u.rows = left < 256 ? left : 256; return true;
    }
    __device__ __forceinline__ void avoff(const pg8::Unit& u, const int (&R)[2], const int (&C)[2], int KB, unsigned& v00, unsigned& v01, unsigned& v10, unsigned& v11) const {
        if constexpr (GATHER) {
            const int* le = list + (size_t)u.e * TOK + (size_t)(u.pm - __builtin_amdgcn_readfirstlane(tb[u.e])) * 256;
            const int lim = u.rows - 1;
            const int r00 = R[0] < lim ? R[0] : lim, r01 = R[1] < lim ? R[1] : lim, r10 = R[0] + 128 < lim ? R[0] + 128 : lim, r11 = R[1] + 128 < lim ? R[1] + 128 : lim;
            v00 = (unsigned)(le[r00] >> 2) * (unsigned)KB + (unsigned)C[0] * 2u; v01 = (unsigned)(le[r01] >> 2) * (unsigned)KB + (unsigned)C[1] * 2u;
            v10 = (unsigned)(le[r10] >> 2) * (unsigned)KB + (unsigned)C[0] * 2u; v11 = (unsigned)(le[r11] >> 2) * (unsigned)KB + (unsigned)C[1] * 2u;
        } else {
            const unsigned base = (unsigned)(u.pm * 256) * (unsigned)KB;
            v00 = base + (unsigned)(R[0] * KB + C[0] * 2); v01 = base + (unsigned)(R[1] * KB + C[1] * 2);
            v10 = v00 + (unsigned)(128 * KB); v11 = v01 + (unsigned)(128 * KB);
        }
    }
    __device__ __forceinline__ const char* btile(const pg8::Unit& u, int KB) const { return Bt + (size_t)u.e * bstride + (size_t)u.pn * 256 * KB; }
};

#ifndef EPI_NT
#define EPI_NT 0
#endif
#if EPI_NT
#define EPI_ST(ptr_, val_) __builtin_nontemporal_store((val_), (ptr_))
#else
#define EPI_ST(ptr_, val_) (*(ptr_) = (val_))
#endif
__device__ __forceinline__ unsigned f8pk4(float a, float b, float c, float d) { int w = __builtin_amdgcn_cvt_pk_fp8_f32(a, b, 0, false); w = __builtin_amdgcn_cvt_pk_fp8_f32(c, d, w, true); return (unsigned)w; }
__device__ __forceinline__ v4u pack8bf(const f32x4 a, const f32x4 b) { v4u w; w.x = cvtpk(a[0], a[1]); w.y = cvtpk(a[2], a[3]); w.z = cvtpk(b[0], b[1]); w.w = cvtpk(b[2], b[3]); return w; }
struct NoPre {};
struct EpiInProj {
    unsigned char* ws; typedef NoPre Pre;
    __device__ __forceinline__ Pre prefetch(const pg8::Unit&, int, int, int, int) const { return Pre{}; }
    __device__ __forceinline__ void operator()(const f32x4 (&acc)[2][2][4][2], const pg8::Unit& u, int wr, int wc, int fr, int fq, const Pre&) const {
        const int pn = u.pn, cw = wc * 32 + 8 * fq;
        if (pn == 22) {
            if (wc == 0 && fq < 3) { float* gates = (float*)(ws + WS_GATES);
#pragma unroll
                for (int ai = 0; ai < 2; ++ai)
#pragma unroll
                    for (int m = 0; m < 4; ++m) { const int row = u.pm * 256 + ai * 128 + wr * 64 + m * 16 + fr; f32x4 a = acc[ai][0][m][0], b = acc[ai][0][m][1];
#pragma unroll
                        for (int k = 0; k < 4; ++k) { a[k] = 1.f / (1.f + __expf(-a[k])); b[k] = 1.f / (1.f + __expf(-b[k])); }
                        *(f32x4*)(gates + (size_t)row * 24 + cw) = a; *(f32x4*)(gates + (size_t)row * 24 + cw + 4) = b; } }
            return;
        }
#pragma unroll
        for (int bj = 0; bj < 2; ++bj) {
            size_t base, sb, st;
            if (pn < 4) { const int kvh = pn >> 1, g = 2 * (pn & 1) + bj; base = WS_QNSA / 2 + ((size_t)kvh * SEQ * 4 + g) * 128; sb = (size_t)2 * SEQ * 512; st = 512; }
            else if (pn < 10) { base = (WS_KV6 + (size_t)(pn - 4) * KV6_STRIDE) / 2 + (size_t)bj * SEQ * 128; sb = (size_t)2 * SEQ * 128; st = 128; }
            else { const int idx = pn - 10, h = idx & 3; const size_t rb = idx < 4 ? WS_QD : (idx < 8 ? WS_KD : WS_VD); base = rb / 2 + (size_t)(h * 2 + bj) * SEQ * 128; sb = (size_t)8 * SEQ * 128; st = 128; }
            bf16* dst0 = (bf16*)ws + base + cw;
#pragma unroll
            for (int ai = 0; ai < 2; ++ai)
#pragma unroll
                for (int m = 0; m < 4; ++m) { const int row = u.pm * 256 + ai * 128 + wr * 64 + m * 16 + fr, b = row >> 13, t = row & (SEQ - 1);
                    EPI_ST((v4u*)(dst0 + (size_t)b * sb + (size_t)t * st), pack8bf(acc[ai][bj][m][0], acc[ai][bj][m][1])); }
        }
    }
};
struct EpiG {
    unsigned char* ws; typedef NoPre Pre;
    __device__ __forceinline__ Pre prefetch(const pg8::Unit&, int, int, int, int) const { return Pre{}; }
    __device__ __forceinline__ void operator()(const f32x4 (&acc)[2][2][4][2], const pg8::Unit& u, int wr, int wc, int fr, int fq, const Pre&) const {
        float* G = (float*)(ws + WS_G + (size_t)u.e * G_STRIDE);
#pragma unroll
        for (int ai = 0; ai < 2; ++ai)
#pragma unroll
            for (int m = 0; m < 4; ++m) { const int row = u.pm * 256 + ai * 128 + wr * 64 + m * 16 + fr;
#pragma unroll
                for (int bj = 0; bj < 2; ++bj) { float* p = G + (size_t)row * 512 + u.pn * 256 + bj * 128 + wc * 32 + 8 * fq; *(f32x4*)p = acc[ai][bj][m][0]; *(f32x4*)(p + 4) = acc[ai][bj][m][1]; } }
    }
};
#ifndef PROBE_EPI
#define PROBE_EPI 0
#endif
struct EpiOutProj {
    const float* x; bf16* h; int probe; typedef NoPre Pre;
    __device__ __forceinline__ Pre prefetch(const pg8::Unit&, int, int, int, int) const { return Pre{}; }
    __device__ __forceinline__ void operator()(const f32x4 (&acc)[2][2][4][2], const pg8::Unit& u, int wr, int wc, int fr, int fq, const Pre&) const {
        if (PROBE_EPI == 2 && probe) return;
#pragma unroll
        for (int ai = 0; ai < 2; ++ai) {
            f32x4 xv[4][2][2];
#pragma unroll
            for (int m = 0; m < 4; ++m) { const int row = u.pm * 256 + ai * 128 + wr * 64 + m * 16 + fr;
#pragma unroll
                for (int bj = 0; bj < 2; ++bj) { const size_t o = (size_t)row * DM + u.pn * 256 + bj * 128 + wc * 32 + 8 * fq; if (PROBE_EPI == 1 && probe) { xv[m][bj][0] = acc[ai][bj][m][1]; xv[m][bj][1] = acc[ai][bj][m][0]; } else { xv[m][bj][0] = *(const GAS f32x4*)(x + o); xv[m][bj][1] = *(const GAS f32x4*)(x + o + 4); } } }
#pragma unroll
            for (int m = 0; m < 4; ++m) { const int row = u.pm * 256 + ai * 128 + wr * 64 + m * 16 + fr;
#pragma unroll
                for (int bj = 0; bj < 2; ++bj) { const size_t o = (size_t)row * DM + u.pn * 256 + bj * 128 + wc * 32 + 8 * fq;
                    const f32x4 s0 = xv[m][bj][0] + acc[ai][bj][m][0], s1 = xv[m][bj][1] + acc[ai][bj][m][1];
                    v4u pk; pk.x = pk2(s0.x, s0.y); pk.y = pk2(s0.z, s0.w); pk.z = pk2(s1.x, s1.y); pk.w = pk2(s1.z, s1.w);
                    EPI_ST((v4u*)(h + o), pk); } }
        }
    }
};
struct EpiGateUp {
    const float* bgu; unsigned char* HB; int probe;
    struct Pre { f32x4 g0, g1, u0, u1; };
    __device__ __forceinline__ Pre prefetch(const pg8::Unit& u, int wr, int wc, int fr, int fq) const {
        const float* bg = bgu + (size_t)u.e * 4096 + u.pn * 128 + wc * 32 + 8 * fq; Pre p; p.g0 = *(const f32x4*)bg; p.g1 = *(const f32x4*)(bg + 4); p.u0 = *(const f32x4*)(bg + 2048); p.u1 = *(const f32x4*)(bg + 2052); return p; }
    __device__ __forceinline__ void operator()(const f32x4 (&acc)[2][2][4][2], const pg8::Unit& u, int wr, int wc, int fr, int fq, const Pre& pre) const {
        if (PROBE_EPI == 2 && probe) return;
        const int col = u.pn * 128 + wc * 32 + 8 * fq;
        const f32x4 g0 = pre.g0, g1 = pre.g1, u0 = pre.u0, u1 = pre.u1;
#pragma unroll
        for (int ai = 0; ai < 2; ++ai)
#pragma unroll
            for (int m = 0; m < 4; ++m) { const int r = ai * 128 + wr * 64 + m * 16 + fr;
                f32x4 ga = acc[ai][0][m][0] + g0, gb = acc[ai][0][m][1] + g1, ua = acc[ai][1][m][0] + u0, ub = acc[ai][1][m][1] + u1, ha, hb;
#pragma unroll
                for (int k = 0; k < 4; ++k) {
                    float gl = fminf(ga[k], 7.f), up = __builtin_amdgcn_fmed3f(ua[k], -7.f, 7.f), q = gl * __builtin_amdgcn_rcpf(1.f + __builtin_amdgcn_exp2f(gl * (-1.702f * LOG2E))); ha[k] = fmaf(up, q, q);
                    gl = fminf(gb[k], 7.f); up = __builtin_amdgcn_fmed3f(ub[k], -7.f, 7.f); q = gl * __builtin_amdgcn_rcpf(1.f + __builtin_amdgcn_exp2f(gl * (-1.702f * LOG2E))); hb[k] = fmaf(up, q, q); }
                if (r < u.rows) { v2u o; o.x = f8pk4(ha[0], ha[1], ha[2], ha[3]); o.y = f8pk4(hb[0], hb[1], hb[2], hb[3]); EPI_ST((v2u*)(HB + (size_t)(u.pm * 256 + r) * DFF + col), o); } }
    }
};
#define MOE_ATOMIC 0
struct EpiDown {
    const float* bd; bf16* YS; const int* list; const float* gatew; const LAS int* tb; float* out; int probe;
    struct Pre { float gw[2][4]; f32x4 bv[2][2]; };
    __device__ __forceinline__ Pre prefetch(const pg8::Unit& u, int wr, int wc, int fr, int fq) const {
        const size_t lbase = (size_t)u.e * TOK + (size_t)(u.pm - __builtin_amdgcn_readfirstlane(tb[u.e])) * 256; Pre p;
#pragma unroll
        for (int ai = 0; ai < 2; ++ai)
#pragma unroll
            for (int m = 0; m < 4; ++m) { const int r = ai * 128 + wr * 64 + m * 16 + fr, rc = r < u.rows ? r : u.rows - 1; p.gw[ai][m] = gatew[lbase + rc]; }
#pragma unroll
        for (int bj = 0; bj < 2; ++bj) { const float* b = bd + (size_t)u.e * DM + u.pn * 256 + bj * 128 + wc * 32 + 8 * fq; p.bv[bj][0] = *(const f32x4*)b; p.bv[bj][1] = *(const f32x4*)(b + 4); }
        return p; }
    __device__ __forceinline__ void operator()(const f32x4 (&acc)[2][2][4][2], const pg8::Unit& u, int wr, int wc, int fr, int fq, const Pre& pre) const {
        if (PROBE_EPI == 2 && probe) return;
#pragma unroll
        for (int ai = 0; ai < 2; ++ai)
#pragma unroll
            for (int m = 0; m < 4; ++m) { const int r = ai * 128 + wr * 64 + m * 16 + fr;
                if (r < u.rows) {
#pragma unroll
                    for (int bj = 0; bj < 2; ++bj) { const int col = u.pn * 256 + bj * 128 + wc * 32 + 8 * fq;
                        const f32x4 a = (acc[ai][bj][m][0] + pre.bv[bj][0]) * pre.gw[ai][m], c = (acc[ai][bj][m][1] + pre.bv[bj][1]) * pre.gw[ai][m];
                        EPI_ST((v4u*)(YS + (size_t)(u.pm * 256 + r) * DM + col), pack8bf(a, c)); } } }
    }
};

template <bool F8>
__device__ __forceinline__ void p0_transpose_item(const float* W, int ldw, void* WT, int ldt, int k0, int n0s, int n0d, int nvalid, float wscale, LAS float* scr, int lane) {
    f32x4 v[16]; const int kk0 = lane >> 3, n4 = (lane & 7) * 4;
#pragma unroll
    for (int i = 0; i < 16; ++i) v[i] = n4 < nvalid ? *(const GAS f32x4*)(W + (size_t)(k0 + 8 * i + kk0) * ldw + n0s + n4) : (f32x4){0.f, 0.f, 0.f, 0.f};
#pragma unroll
    for (int i = 0; i < 16; ++i) { LAS float* s = scr + (8 * i + kk0) * 33 + n4; s[0] = v[i].x; s[1] = v[i].y; s[2] = v[i].z; s[3] = v[i].w; }
    LDS_WAIT(); asm volatile("" ::: "memory");
    if constexpr (F8) {
        const int c = lane & 7;
#pragma unroll
        for (int j = 0; j < 4; ++j) { const int n = (lane >> 3) + 8 * j; const LAS float* s = scr + (16 * c) * 33 + n; v4u o;
            o.x = f8pk4(s[0 * 33] * wscale, s[1 * 33] * wscale, s[2 * 33] * wscale, s[3 * 33] * wscale); o.y = f8pk4(s[4 * 33] * wscale, s[5 * 33] * wscale, s[6 * 33] * wscale, s[7 * 33] * wscale);
            o.z = f8pk4(s[8 * 33] * wscale, s[9 * 33] * wscale, s[10 * 33] * wscale, s[11 * 33] * wscale); o.w = f8pk4(s[12 * 33] * wscale, s[13 * 33] * wscale, s[14 * 33] * wscale, s[15 * 33] * wscale);
            *(GAS v4u*)((unsigned char*)WT + (size_t)(n0d + n) * ldt + k0 + 16 * c) = o; }
    } else {
        const int c = lane & 15;
#pragma unroll
        for (int j = 0; j < 8; ++j) { const int n = (lane >> 4) + 4 * j; const LAS float* s = scr + (8 * c) * 33 + n;
            v4u o; o.x = pk2(s[0 * 33], s[1 * 33]); o.y = pk2(s[2 * 33], s[3 * 33]); o.z = pk2(s[4 * 33], s[5 * 33]); o.w = pk2(s[6 * 33], s[7 * 33]);
            *(GAS v4u*)((bf16*)WT + (size_t)(n0d + n) * ldt + k0 + 8 * c) = o; }
    }
    LDS_WAIT(); asm volatile("" ::: "memory");
}
#ifndef BG_IN_FLASH
#define BG_IN_FLASH 1
#endif
constexpr int BG_ITEMS = 32 * 16 * 128 + 32 * 16 * 64, BG_TILE_BYTES = 64 * 33 * 4, BG_LDS_OFF = 69632;
struct BgItem { const float* W; unsigned char* WT; int ldw, k0, n0s, n0d; };
__device__ __forceinline__ BgItem bg_decode(const KArgs& a, int I) {
    BgItem b;
    if (I < 65536) { const int e = I >> 11, q = I & 2047, kb = q >> 7, nb = q & 127, n0 = nb * 32, bj = n0 >> 11, rem = n0 & 2047, pn = rem >> 7, i0 = rem & 127;
        b.W = a.in[22] + (size_t)e * 2048 * 4096; b.ldw = 4096; b.WT = a.ws + WS_WGU_T + (size_t)e * 4096 * 2048; b.k0 = kb * 128; b.n0s = n0; b.n0d = pn * 256 + bj * 128 + i0; }
    else { const int J = I - 65536, e = J >> 10, q = J & 1023, kb = q >> 6, nb = q & 63;
        b.W = a.in[24] + (size_t)e * 2048 * 2048; b.ldw = 2048; b.WT = a.ws + WS_WD_T + (size_t)e * 2048 * 2048; b.k0 = kb * 128; b.n0s = nb * 32; b.n0d = nb * 32; }
    return b;
}
__device__ __forceinline__ void bg_load(const BgItem& b, f32x4 (&v)[16], int lane) {
    const unsigned voff = (unsigned)(((lane >> 3) * b.ldw + (lane & 7) * 4) * 4);
#pragma unroll
    for (int i = 0; i < 16; ++i) v[i] = *(const GAS f32x4*)((const char*)(b.W + (size_t)(b.k0 + 8 * i) * b.ldw + b.n0s) + voff);
}
__device__ __forceinline__ void bg_store(const BgItem& b, const f32x4 (&v)[16], LAS float* scr, int lane) {
    const int kk0 = lane >> 3, n4 = (lane & 7) * 4;
#pragma unroll
    for (int hf = 0; hf < 2; ++hf) {
#pragma unroll
        for (int i = 0; i < 8; ++i) { LAS float* s = scr + (8 * i + kk0) * 33 + n4; const f32x4 x = v[hf * 8 + i]; s[0] = x.x; s[1] = x.y; s[2] = x.z; s[3] = x.w; }
        LDS_WAIT(); asm volatile("" ::: "memory");
        const int c = lane & 3;
#pragma unroll
        for (int j = 0; j < 2; ++j) { const int n = (lane >> 2) + 16 * j; const LAS float* s = scr + (16 * c) * 33 + n; v4u o;
            o.x = f8pk4(s[0 * 33] * 32.f, s[1 * 33] * 32.f, s[2 * 33] * 32.f, s[3 * 33] * 32.f); o.y = f8pk4(s[4 * 33] * 32.f, s[5 * 33] * 32.f, s[6 * 33] * 32.f, s[7 * 33] * 32.f);
            o.z = f8pk4(s[8 * 33] * 32.f, s[9 * 33] * 32.f, s[10 * 33] * 32.f, s[11 * 33] * 32.f); o.w = f8pk4(s[12 * 33] * 32.f, s[13 * 33] * 32.f, s[14 * 33] * 32.f, s[15 * 33] * 32.f);
            *(GAS v4u*)(b.WT + (size_t)(b.n0d + n) * 2048 + b.k0 + 64 * hf + 16 * c) = o; }
        LDS_WAIT(); asm volatile("" ::: "memory");
    }
}
__device__ __forceinline__ void bg_conv_item(const KArgs& a, LAS float* scr, int I, int lane) { f32x4 v[16]; const BgItem b = bg_decode(a, I); bg_load(b, v, lane); bg_store(b, v, scr, lane); }
__device__ __forceinline__ void bg_conv_pair(const KArgs& a, LAS float* scr, int I0, int I1, int lane) {
    f32x4 va[16], vb[16]; const BgItem b0 = bg_decode(a, I0), b1 = bg_decode(a, I1);
    bg_load(b0, va, lane); bg_load(b1, vb, lane); bg_store(b0, va, scr, lane); bg_store(b1, vb, scr, lane);
}
struct BgAsync {
    const KArgs& a; LAS float* tile; int I, st, q, pend, pq, on, tick; BgItem pb;
    __device__ __forceinline__ void convert() {
        int l_ = threadIdx.x; asm volatile("" : "+v"(l_)); const int n = l_ & 31, c = (l_ >> 5) & 1;
#pragma unroll
        for (int g = 0; g < 2; ++g) { const LAS float* s = tile + (16 * (c + 2 * g)) * 32 + n; float x[16];
#pragma unroll
            for (int j = 0; j < 16; ++j) x[j] = s[j * 32];
            v4u o; o.x = f8pk4(x[0] * 32.f, x[1] * 32.f, x[2] * 32.f, x[3] * 32.f); o.y = f8pk4(x[4] * 32.f, x[5] * 32.f, x[6] * 32.f, x[7] * 32.f);
            o.z = f8pk4(x[8] * 32.f, x[9] * 32.f, x[10] * 32.f, x[11] * 32.f); o.w = f8pk4(x[12] * 32.f, x[13] * 32.f, x[14] * 32.f, x[15] * 32.f);
            *(GAS v4u*)(pb.WT + (size_t)(pb.n0d + n) * 2048 + pb.k0 + 64 * pq + 16 * (c + 2 * g)) = o; }
        LDS_WAIT(); asm volatile("" ::: "memory");
    }
    __device__ __forceinline__ void issue() {
        pb = bg_decode(a, I); int l_ = threadIdx.x; asm volatile("" : "+v"(l_));
        const unsigned voff = (unsigned)((((l_ >> 3) & 7) * pb.ldw + (l_ & 7) * 4) * 4);
#pragma unroll
        for (int i = 0; i < 8; ++i) { unsigned o_ = voff; asm volatile("" : "+v"(o_)); __builtin_amdgcn_global_load_lds((const unsigned*)((const char*)(pb.W + (size_t)(pb.k0 + 64 * q + 8 * i) * pb.ldw + pb.n0s) + o_), (LAS unsigned*)((LAS unsigned char*)tile + i * 1024), 16, 0, 0); }
        pq = q; pend = 1; if (++q == 2) { q = 0; I += st; }
    }
    __device__ __forceinline__ void slot() {
        if (!on) return;
        if ((tick ^= 1) != 0) return;
        if (pend) { VM_WAIT(); convert(); pend = 0; }
        if (I < BG_ITEMS) issue();
    }
    __device__ __forceinline__ void drain(LAS float* scr, int lane) {
        if (!on) return;
        if (pend) { VM_WAIT(); convert(); pend = 0; }
        if (q != 0 && I < BG_ITEMS) { issue(); VM_WAIT(); convert(); pend = 0; }
        _Pragma("unroll 1") while (I < BG_ITEMS) { if (I + st < BG_ITEMS) { bg_conv_pair(a, scr, I, I + st, lane); I += 2 * st; } else { bg_conv_item(a, scr, I, lane); I += st; } }
    }
};
__device__ __forceinline__ void p0_prologue(const KArgs& a, LAS unsigned char* lds, int gw, int NGW, int wave, int lane) {
    unsigned char* ws = a.ws;
    LAS float* scr = (LAS float*)(lds + wave * 16896);
    const int gtid = blockIdx.x * 512 + threadIdx.x, GT = gridDim.x * 512;
    for (int idx = gtid; idx < SEQ * 16; idx += GT) { const int pos = idx >> 4, i = idx & 15; const float inv = powf(500000.f, -(float)(2 * i) / 32.f); const float ang = (float)pos * inv;
        ((float*)(ws + WS_ROPE))[idx] = cosf(ang); ((float*)(ws + WS_ROPE))[SEQ * 16 + idx] = sinf(ang); }
    for (int idx = gtid; idx < 2 * 256 * 2048; idx += GT) { const int e = idx / (256 * 2048), r = (idx / 2048) % 256, cidx = idx % 2048;
        const float v = r < 2 ? a.in[5 + e][r * 2048 + cidx] : 0.f; ((bf16*)(ws + WS_KCA + (size_t)e * KV6_STRIDE))[(size_t)(2048 + r) * 2048 + cidx] = (bf16)f2bf(v); }
    if (blockIdx.x == 1 && wave == 0) { float s1 = a.in[13][lane] * a.in[14][lane] + a.in[13][lane + 64] * a.in[14][lane + 64], s2 = a.in[15][lane] * a.in[16][lane] + a.in[15][lane + 64] * a.in[16][lane + 64];
        s1 = wave_sum(s1); s2 = wave_sum(s2); if (lane == 0) ((float*)(ws + WS_SCAL))[0] = expf(s1) - expf(s2) + 0.2f; }
    if (blockIdx.x == 0 && threadIdx.x == 0) { int* it = (int*)(ws + WS_ITEMS); int n = 0;
        for (int c = 128; c >= 1; --c) {
            if ((c & 3) == 0) { const int qb = c / 4 - 1; for (int id = 0; id < 32; ++id) it[n++] = (0 << 16) | (id << 8) | qb; }
            { const int u = c - 1; for (int id = 0; id < 4; ++id) it[n++] = (1 << 16) | (id << 8) | u; }
            if (c < 9) { const int u = c - 1; for (int id = 0; id < 4; ++id) it[n++] = (2 << 16) | (id << 8) | u; }
            else if (c == 9) { for (int u = 8; u < 128; ++u) for (int id = 0; id < 4; ++id) it[n++] = (2 << 16) | (id << 8) | u; }
        } }
    constexpr int I_IN = 16 * 184, I_OUT = 16 * 64, I_CAT = 2 * 2 * 16 * 8;
    constexpr int NIT = I_IN + I_OUT + I_CAT;
    for (int it = gw; it < NIT; it += NGW) {
        int r = it;
        if (r < I_IN) { const int kb = r / 184, nb = r % 184, n0 = nb * 32; int ns, nv;
            if (n0 < 2560) { ns = n0; nv = 32; } else if (n0 < 5632) { ns = n0 + 24; nv = 32; } else if (n0 == 5632) { ns = 2560; nv = 24; } else { ns = 0; nv = 0; }
            p0_transpose_item<false>(a.in[2], 5656, ws + WS_WIN_T, 2048, kb * 128, ns, n0, nv, 1.f, scr, lane); continue; } r -= I_IN;
        if (r < I_OUT) { const int kb = r / 64, nb = r % 64; p0_transpose_item<false>(a.in[18], 2048, ws + WS_WOUT_T, 2048, kb * 128, nb * 32, nb * 32, 32, 1.f, scr, lane); continue; } r -= I_OUT;
        { const int e = r / 256, q = r % 256, part = q / 128, kb = (q % 128) / 8, nb = q % 8;
            p0_transpose_item<false>(a.in[e ? 9 : 7] + (size_t)part * 2048 * 256, 256, ws + WS_WCAT + (size_t)e * 2 * MiB, 2048, kb * 128, nb * 32, part * 256 + nb * 32, 32, 1.f, scr, lane); }
    }
    if (!BG_IN_FLASH) { for (int I = gw; I < BG_ITEMS; I += NGW) bg_conv_item(a, scr, I, lane); }
    for (int m = gw; m < TOK; m += 2 * NGW) {
        const int m2 = m + NGW < TOK ? m + NGW : m;
        const GAS f32x4* xr = (const GAS f32x4*)(a.in[0] + (size_t)m * DM) + lane; const GAS f32x4* xr2 = (const GAS f32x4*)(a.in[0] + (size_t)m2 * DM) + lane; const GAS f32x4* gr = (const GAS f32x4*)a.in[1] + lane;
        f32x4 v[8], w[8]; float s = 0.f, s2 = 0.f;
#pragma unroll
        for (int j = 0; j < 8; ++j) { v[j] = xr[64 * j]; w[j] = xr2[64 * j]; }
#pragma unroll
        for (int j = 0; j < 8; ++j) { s += (v[j].x * v[j].x + v[j].y * v[j].y) + (v[j].z * v[j].z + v[j].w * v[j].w); s2 += (w[j].x * w[j].x + w[j].y * w[j].y) + (w[j].z * w[j].z + w[j].w * w[j].w); }
        const float rstd = 1.f / sqrtf(wave_sum(s) * (1.f / DM) + NORM_EPS), rstd2 = 1.f / sqrtf(wave_sum(s2) * (1.f / DM) + NORM_EPS);
        GAS unsigned long long* o8 = (GAS unsigned long long*)(ws + WS_XN + (size_t)m * DM * 2) + lane; GAS unsigned long long* o82 = (GAS unsigned long long*)(ws + WS_XN + (size_t)m2 * DM * 2) + lane;
#pragma unroll
        for (int j = 0; j < 8; ++j) { const f32x4 g = gr[64 * j];
            o8[64 * j] = (unsigned long long)pk2(v[j].x * rstd * g.x, v[j].y * rstd * g.y) | ((unsigned long long)pk2(v[j].z * rstd * g.z, v[j].w * rstd * g.w) << 32);
            o82[64 * j] = (unsigned long long)pk2(w[j].x * rstd2 * g.x, w[j].y * rstd2 * g.y) | ((unsigned long long)pk2(w[j].z * rstd2 * g.z, w[j].w * rstd2 * g.w) << 32); }
    }
}

__device__ __forceinline__ void p1b_norm(const KArgs& a, int gw, int NGW, int lane) {
    unsigned char* ws = a.ws; const float* ropec = (const float*)(ws + WS_ROPE); const float* ropes = ropec + SEQ * 16;
    constexpr int R0 = TOK * 8, R1 = TOK * 2;
    const int sub = lane & 15, rq = lane >> 4;
#define NLOAD(S, u, r4_) { const int rr_ = (r4_) + (u) * NGW; ok##S##u = rr_ < n4;                                                                  \
        if (ok##S##u) { const int row = rr_ * 4 + rq; w##S##u = *(const v4u*)(base + (size_t)row * 128 + sub * 8);                                   \
            if (sub < 4) { const int pos = (row >> psh) & (SEQ - 1); const float* cp = ropec + pos * 16 + (sub & 1) * 8; const float* sp = ropes + pos * 16 + (sub & 1) * 8; \
                c0##S##u = *(const f32x4*)cp; c1##S##u = *(const f32x4*)(cp + 4); s0##S##u = *(const f32x4*)sp; s1##S##u = *(const f32x4*)(sp + 4); } } }
#define NDO(S, u, r4_) if (ok##S##u) { const int row = ((r4_) + (u) * NGW) * 4 + rq; const v4u w = w##S##u;                                         \
        float x[8] = {bflo(w.x), bfhi(w.x), bflo(w.y), bfhi(w.y), bflo(w.z), bfhi(w.z), bflo(w.w), bfhi(w.w)};                                        \
        float ss = 0.f;                                                                                                                              \
        _Pragma("unroll") for (int k = 0; k < 8; ++k) ss += x[k] * x[k];                                                                             \
        ss += __shfl_xor(ss, 1); ss += __shfl_xor(ss, 2); ss += __shfl_xor(ss, 4); ss += __shfl_xor(ss, 8);                                           \
        const float rstd = 1.f / sqrtf(ss * (1.f / 128.f) + NORM_EPS);                                                                               \
        x[0] *= rstd * gv0.x; x[1] *= rstd * gv0.y; x[2] *= rstd * gv0.z; x[3] *= rstd * gv0.w; x[4] *= rstd * gv1.x; x[5] *= rstd * gv1.y; x[6] *= rstd * gv1.z; x[7] *= rstd * gv1.w; \
        const float cc[8] = {c0##S##u.x, c0##S##u.y, c0##S##u.z, c0##S##u.w, c1##S##u.x, c1##S##u.y, c1##S##u.z, c1##S##u.w};                         \
        const float sn[8] = {s0##S##u.x, s0##S##u.y, s0##S##u.z, s0##S##u.w, s1##S##u.x, s1##S##u.y, s1##S##u.z, s1##S##u.w};                         \
        float y[8];                                                                                                                                  \
        _Pragma("unroll") for (int k = 0; k < 8; ++k) { const float other = __shfl_xor(x[k], 2);                                                     \
            y[k] = sub < 2 ? x[k] * cc[k] - other * sn[k] : (sub < 4 ? x[k] * cc[k] + other * sn[k] : x[k]); }                                         \
        v4u o; o.x = pk2(y[0], y[1]); o.y = pk2(y[2], y[3]); o.z = pk2(y[4], y[5]); o.w = pk2(y[6], y[7]); if (wb) *(v4u*)(base + (size_t)row * 128 + sub * 8) = o; \
        v2u o8; o8.x = f8pk4(16.f * y[0], 16.f * y[1], 16.f * y[2], 16.f * y[3]); o8.y = f8pk4(16.f * y[4], 16.f * y[5], 16.f * y[6], 16.f * y[7]);     \
        *(v2u*)(b8 + (size_t)row * 128 + sub * 8) = o8; }
#define NDECL(S, u) bool ok##S##u = false; v4u w##S##u = {0u, 0u, 0u, 0u}; f32x4 c0##S##u = {1.f, 1.f, 1.f, 1.f}, c1##S##u = c0##S##u, s0##S##u = {0.f, 0.f, 0.f, 0.f}, s1##S##u = s0##S##u;
#define NLOAD4(S, r4_) NLOAD(S, 0, r4_) NLOAD(S, 1, r4_) NLOAD(S, 2, r4_) NLOAD(S, 3, r4_)
#define NDO4(S, r4_) NDO(S, 0, r4_) NDO(S, 1, r4_) NDO(S, 2, r4_) NDO(S, 3, r4_)
    _Pragma("unroll 1") for (int t = 0; t < 5; ++t) {
        bf16* base; unsigned char* b8; const float* g; int n4, psh = 0;
        if (t == 0) { base = (bf16*)(ws + WS_QNSA); b8 = ws + WS_Q8NSA; g = a.in[3]; n4 = R0 / 4; psh = 2; }
        else if (t == 1) { base = (bf16*)(ws + WS_KSLC); b8 = ws + WS_K8SLC; g = a.in[4] + 128; n4 = R1 / 4; }
        else if (t == 2) { base = (bf16*)(ws + WS_KWIN); b8 = ws + WS_K8WIN; g = a.in[4] + 256; n4 = R1 / 4; }
        else if (t == 3) { base = (bf16*)(ws + WS_QD); b8 = ws + WS_Q8D; g = a.in[11]; n4 = R0 / 4; }
        else { base = (bf16*)(ws + WS_KD); b8 = ws + WS_K8D; g = a.in[12]; n4 = R0 / 4; }
        const f32x4 gv0 = *(const f32x4*)(g + sub * 8), gv1 = *(const f32x4*)(g + sub * 8 + 4);
        const bool wb = t == 0 || MK_CHECK;
        NDECL(A, 0) NDECL(A, 1) NDECL(A, 2) NDECL(A, 3) NDECL(B, 0) NDECL(B, 1) NDECL(B, 2) NDECL(B, 3)
        int r = gw;
        NLOAD4(A, r)
        _Pragma("unroll 1") while (r < n4) {
            NLOAD4(B, r + 4 * NGW)
            NDO4(A, r)
            r += 4 * NGW; if (r >= n4) break;
            NLOAD4(A, r + 4 * NGW)
            NDO4(B, r)
            r += 4 * NGW;
        }
    }
#undef NLOAD
#undef NDO
#undef NDECL
#undef NLOAD4
#undef NDO4
}
__device__ __forceinline__ void p1c_vt(const KArgs& a, int gw, int NGW, int lane) {
    unsigned char* ws = a.ws;
    for (int it = gw; it < 24 * (SEQ / 64); it += NGW) {
        const int pl = it >> 7, tile = it & 127;
        const bf16* src = (const bf16*)(ws + (pl < 4 ? WS_VSLC : (pl < 8 ? WS_VWIN : WS_VD))) + ((size_t)(pl < 4 ? pl : (pl < 8 ? pl - 4 : pl - 8)) * SEQ + tile * 64) * 128;
        unsigned char* dst = ws + WS_VT + ((size_t)pl * 128 + 2 * lane) * SEQ + tile * 64;
#pragma unroll
        for (int c = 0; c < 4; ++c) {
            unsigned w[16];
#pragma unroll
            for (int i = 0; i < 16; ++i) { const int key = 32 * (c & 1) + (i & 3) + 8 * (i >> 2) + 4 * (c >> 1); w[i] = ((const unsigned*)(src + (size_t)key * 128))[lane]; }
            v4u lo, hi;
            lo.x = f8pk4(16.f * bflo(w[0]), 16.f * bflo(w[1]), 16.f * bflo(w[2]), 16.f * bflo(w[3]));     hi.x = f8pk4(16.f * bfhi(w[0]), 16.f * bfhi(w[1]), 16.f * bfhi(w[2]), 16.f * bfhi(w[3]));
            lo.y = f8pk4(16.f * bflo(w[4]), 16.f * bflo(w[5]), 16.f * bflo(w[6]), 16.f * bflo(w[7]));     hi.y = f8pk4(16.f * bfhi(w[4]), 16.f * bfhi(w[5]), 16.f * bfhi(w[6]), 16.f * bfhi(w[7]));
            lo.z = f8pk4(16.f * bflo(w[8]), 16.f * bflo(w[9]), 16.f * bflo(w[10]), 16.f * bflo(w[11]));   hi.z = f8pk4(16.f * bfhi(w[8]), 16.f * bfhi(w[9]), 16.f * bfhi(w[10]), 16.f * bfhi(w[11]));
            lo.w = f8pk4(16.f * bflo(w[12]), 16.f * bflo(w[13]), 16.f * bflo(w[14]), 16.f * bflo(w[15])); hi.w = f8pk4(16.f * bfhi(w[12]), 16.f * bfhi(w[13]), 16.f * bfhi(w[14]), 16.f * bfhi(w[15]));
            *(v4u*)(dst + c * 16) = lo; *(v4u*)(dst + SEQ + c * 16) = hi;
        }
    }
}

__device__ __forceinline__ float gelu_tanh(float x) { const float u = 0.7978845608028654f * (x + 0.044715f * x * x * x); return 0.5f * x * (1.f + tanhf(u)); }
__device__ __forceinline__ void p2b_compress2(const KArgs& a, LAS unsigned char* lds) {
    unsigned char* ws = a.ws; const int tid = threadIdx.x, wave = tid >> 6, lane = tid & 63;
    LAS float* h1 = (LAS float*)lds;
    LAS float* cb = (LAS float*)(lds + 16384);
    const float* ropec = (const float*)(ws + WS_ROPE); const float* ropes = ropec + SEQ * 16;
    for (int item = blockIdx.x; item < 256; item += gridDim.x) {
        const int e = item >> 7, r0 = (item & 127) * 16;
        const float* G = (const float*)(ws + WS_G + (size_t)e * G_STRIDE); const float* w2 = a.in[e ? 10 : 8];
        __syncthreads();
        for (int idx = tid; idx < 16 * 256; idx += 512) { const int r = idx >> 8, n = idx & 255, row = r0 + r;
            const float v = G[(size_t)row * 512 + n] + G[(size_t)(row + 1) * 512 + 256 + n] + G[(size_t)2048 * 512 + n] + G[(size_t)2049 * 512 + 256 + n];
            h1[idx] = gelu_tanh(v); }
        __syncthreads();
        const int d = tid & 127, rg = tid >> 7; float acc0 = 0.f, acc1 = 0.f, acc2 = 0.f, acc3 = 0.f;
#pragma unroll 4
        for (int n = 0; n < 256; ++n) { const float w = w2[n * 128 + d]; acc0 += h1[(rg * 4 + 0) * 256 + n] * w; acc1 += h1[(rg * 4 + 1) * 256 + n] * w; acc2 += h1[(rg * 4 + 2) * 256 + n] * w; acc3 += h1[(rg * 4 + 3) * 256 + n] * w; }
        cb[(rg * 4 + 0) * 128 + d] = acc0; cb[(rg * 4 + 1) * 128 + d] = acc1; cb[(rg * 4 + 2) * 128 + d] = acc2; cb[(rg * 4 + 3) * 128 + d] = acc3;
        __syncthreads();
#pragma unroll
        for (int rr = 0; rr < 2; ++rr) { const int r = wave * 2 + rr, row = r0 + r, i = row & 511;
            float x0 = cb[r * 128 + lane], x1 = cb[r * 128 + lane + 64];
            bf16* dst = (bf16*)(ws + (e ? WS_VCMP : WS_KCMP)) + (size_t)row * 128;
            if (e == 0) {
                const float ss = wave_sum(x0 * x0 + x1 * x1); const float rstd = 1.f / sqrtf(ss * (1.f / 128.f) + NORM_EPS);
                x0 *= rstd * a.in[4][lane]; x1 *= rstd * a.in[4][lane + 64];
                const int pos = 16 * i + 31; const float other = __shfl_xor(x0, 16);
                if (lane < 32 && pos < SEQ) { const int ai = lane & 15; const float c = ropec[pos * 16 + ai], s = ropes[pos * 16 + ai]; x0 = lane < 16 ? x0 * c - other * s : x0 * c + other * s; }
            }
            if (i == 511) { x0 = 0.f; x1 = 0.f; }
            dst[lane] = (bf16)f2bf(x0); dst[lane + 64] = (bf16)f2bf(x1);
        }
    }
    __syncthreads();
}
__device__ __forceinline__ void p4_cmp_unit(const KArgs& a, char* lds, int unit) {
    using namespace fa16;
    unsigned char* ws = a.ws;
    const int tid = threadIdx.x, wid = __builtin_amdgcn_readfirstlane(tid >> 6), lane = tid & 63, r32 = lane & 31, hi = lane >> 5;
    const int bk = unit >> 7, u = unit & 127;
    char* V_lds = lds; char* K_lds = lds + 2 * SHM_V;
    float* imp = (float*)(lds + 69632);
    const bf16* Q = (const bf16*)(ws + WS_QNSA) + ((size_t)bk * SEQ + 64 * u) * 512;
    const bf16* Kc = (const bf16*)(ws + WS_KCMP) + (size_t)bk * NCMPP * 128;
    const bf16* Vc = (const bf16*)(ws + WS_VCMP) + (size_t)bk * NCMPP * 128;
    bf16* Oc = (bf16*)(ws + WS_OCMP) + ((size_t)bk * SEQ + 64 * u) * 512;
    bf16x8 qr[8];
#pragma unroll
    for (int d0 = 0; d0 < 8; ++d0) qr[d0] = load8(Q + (size_t)(wid * 32 + r32) * 128 + d0 * 16 + hi * 8);
    const int trow = 64 * u + ((wid * 32 + r32) >> 2);
    const int imax = (trow - 31) >> 4;
    const int ntile = ((4 * u + 2) >> 6) + 1;
    constexpr float C2 = LOG2E * SCALE; const float NEG = -__builtin_inff();
    const int sr = tid >> 4, sc = (tid & 15) * 8, vst0 = v_st(sr, sc), vst1 = v_st(32 + sr, sc), kws = KSWZ(sr, sc * 2);
    const int vb0 = (int)(uintptr_t)V_lds + v_rd_base(lane);
    float m = -1e30f, l = 0.f;
    bf16x8 sk0 = load8(Kc + (size_t)sr * 128 + sc), sk1 = load8(Kc + (size_t)(32 + sr) * 128 + sc), sv0, sv1;
    __syncthreads();
    *(bf16x8*)(K_lds + kws) = sk0; *(bf16x8*)(K_lds + kws + 32 * 256) = sk1;
    __syncthreads();
    int sb = 0;
    for (int kt = 0; kt < ntile; ++kt) {
        { const int nk = kt + 1 < ntile ? kt + 1 : 0;
          sk0 = load8(Kc + (size_t)(64 * nk + sr) * 128 + sc); sk1 = load8(Kc + (size_t)(64 * nk + 32 + sr) * 128 + sc);
          if (kt + 1 == ntile) { sv0 = load8(Vc + (size_t)sr * 128 + sc); sv1 = load8(Vc + (size_t)(32 + sr) * 128 + sc); } }
        f32x16 p0, p1; qkt<0, false>(p0, p1, K_lds + sb * SHM_K, r32, hi, qr, true);
        float pmax = NEG;
#pragma unroll
        for (int r = 0; r < 16; ++r) { const int i0 = 64 * kt + crow(r, hi); if (i0 > imax) p0[r] = NEG; if (i0 + 32 > imax) p1[r] = NEG; pmax = fmaxf(pmax, fmaxf(p0[r], p1[r])); }
        { auto rr = __builtin_amdgcn_permlane32_swap(__float_as_uint(pmax), __float_as_uint(pmax), false, false); pmax = fmaxf(__uint_as_float(rr[0]), __uint_as_float(rr[1])); }
        const float mn = fmaxf(m, pmax); float ps = 0.f;
#pragma unroll
        for (int r = 0; r < 16; ++r) ps += __builtin_amdgcn_exp2f((p0[r] - mn) * C2) + __builtin_amdgcn_exp2f((p1[r] - mn) * C2);
        { auto rr = __builtin_amdgcn_permlane32_swap(__float_as_uint(ps), __float_as_uint(ps), false, false); ps = __uint_as_float(rr[0]) + __uint_as_float(rr[1]); }
        l = l * __builtin_amdgcn_exp2f((m - mn) * C2) + ps; m = mn;
        { char* kw_ = K_lds + (sb ^ 1) * SHM_K + kws; *(bf16x8*)kw_ = sk0; *(bf16x8*)(kw_ + 32 * 256) = sk1;
          if (kt + 1 == ntile) { char* vw_ = V_lds + (sb ^ 1) * SHM_V; *(bf16x8*)(vw_ + vst0) = sv0; *(bf16x8*)(vw_ + vst1) = sv1; } }
        sb ^= 1;
        __syncthreads();
    }
    const float rl = l > 0.f ? 1.f / l : 0.f;
    f32x16 o[4] = {}; float carry = 0.f;
    for (int kt = 0; kt < ntile; ++kt) {
        if (kt + 1 < ntile) { sk0 = load8(Kc + (size_t)(64 * (kt + 1) + sr) * 128 + sc); sk1 = load8(Kc + (size_t)(64 * (kt + 1) + 32 + sr) * 128 + sc);
                              sv0 = load8(Vc + (size_t)(64 * (kt + 1) + sr) * 128 + sc); sv1 = load8(Vc + (size_t)(64 * (kt + 1) + 32 + sr) * 128 + sc); }
        f32x16 p0, p1; qkt<0, false>(p0, p1, K_lds + sb * SHM_K, r32, hi, qr, true);
#pragma unroll
        for (int r = 0; r < 16; ++r) { const int i0 = 64 * kt + crow(r, hi);
            p0[r] = i0 > imax ? 0.f : __builtin_amdgcn_exp2f((p0[r] - m) * C2) * rl; p1[r] = i0 + 32 > imax ? 0.f : __builtin_amdgcn_exp2f((p1[r] - m) * C2) * rl; }
        float Lq[8], Qs[8];
#pragma unroll
        for (int s = 0; s < 4; ++s) { Qs[s] = (p0[4 * s] + p0[4 * s + 1]) + (p0[4 * s + 2] + p0[4 * s + 3]); Lq[s] = p0[4 * s + 3];
                                      Qs[4 + s] = (p1[4 * s] + p1[4 * s + 1]) + (p1[4 * s + 2] + p1[4 * s + 3]); Lq[4 + s] = p1[4 * s + 3]; }
#pragma unroll
        for (int s = 0; s < 8; ++s) { const float av = s == 0 ? carry : Lq[s - 1], bv = Lq[s];
            auto rr = __builtin_amdgcn_permlane32_swap(__float_as_uint(av), __float_as_uint(bv), false, false);
            const float recv = hi ? __uint_as_float(rr[0]) : __uint_as_float(rr[1]);
            float v = Qs[s] + recv; v += __shfl_xor(v, 1); v += __shfl_xor(v, 2);
            if ((r32 & 3) == 0) imp[(wid * 8 + (r32 >> 2)) * 128 + 16 * kt + 2 * s + hi] = v; }
        carry = Lq[7];
        bf16x8 pa0, pa1, pa2, pa3; pack_p(p0, p1, pa0, pa1, pa2, pa3);
        pv_tile<0, false>(o, vb0 + sb * SHM_V, pa0, pa1, pa2, pa3, true);
        if (kt + 1 < ntile) { char* kw_ = K_lds + (sb ^ 1) * SHM_K + kws; *(bf16x8*)kw_ = sk0; *(bf16x8*)(kw_ + 32 * 256) = sk1;
                              char* vw_ = V_lds + (sb ^ 1) * SHM_V; *(bf16x8*)(vw_ + vst0) = sv0; *(bf16x8*)(vw_ + vst1) = sv1; }
        sb ^= 1;
        __syncthreads();
    }
    { bf16* Ow = Oc + (size_t)(wid * 32) * 128;
#pragma unroll
      for (int r = 0; r < 16; ++r) { const int orow = crow(r, hi);
#pragma unroll
        for (int d0 = 0; d0 < 4; ++d0) { const float v = o[d0][r]; const float vn = __shfl_xor(v, 1);
            if ((r32 & 1) == 0) *(unsigned*)(Ow + (size_t)orow * 128 + d0 * 32 + r32) = cvtpk(v, vn); } } }
    __syncthreads();
    { const int tl = lane >> 3, c = lane & 7; float v[16];
#pragma unroll
      for (int k = 0; k < 16; ++k) { const int j = 16 * c + k; const float x = imp[(wid * 8 + tl) * 128 + j];
          v[k] = j > u ? NEG : ((j == 0 || j == u || j == u - 1) ? 1e9f : x); }
      unsigned word = 0u;
#pragma unroll 1
      for (int round = 0; round < 16; ++round) {
          float best = v[0]; int bi = 16 * c;
#pragma unroll
          for (int k = 1; k < 16; ++k) if (v[k] > best) { best = v[k]; bi = 16 * c + k; }
#pragma unroll
          for (int x = 1; x < 8; x <<= 1) { const float ob = __shfl_xor(best, x); const int oi = __shfl_xor(bi, x); if (ob > best || (ob == best && oi < bi)) { best = ob; bi = oi; } }
          if (best > -1.0f) { if ((bi >> 5) == c) word |= 1u << (bi & 31);
#pragma unroll
              for (int k = 0; k < 16; ++k) if (16 * c + k == bi) v[k] = NEG; }
      }
      if (c < 4) ((unsigned*)(ws + WS_SELM))[((size_t)bk * SEQ + 64 * u + wid * 8 + tl) * 4 + c] = word; }
    __syncthreads();
}

__device__ __forceinline__ fa::BlockRef p5_ref(unsigned char* ws, int item) {
    const int kind = item >> 16, id = (item >> 8) & 255, x = item & 255; fa::BlockRef r;
    r.selsrc = (const unsigned*)(ws + WS_SELM);
    if (kind == 0) { const int bhc = id >> 1, half = id & 1, bh = id >> 2;
        r.Q = ws + WS_Q8D + ((size_t)bhc * SEQ + 256 * x) * 128; r.K = ws + WS_K8D + (size_t)bhc * SEQ * 128;
        r.V = ws + WS_VT + (size_t)(8 + bh * 2 + half) * SEQ * 128; r.O = (bf16*)(ws + WS_ODIFF) + ((size_t)id * SEQ + 256 * x) * 128;
        r.P0 = 256 * x; r.ksh = 0; r.W = 1 << 20; r.sel = 0; }
    else { const size_t ro = ((size_t)id * SEQ + 64 * x) * 512;
        r.Q = ws + WS_Q8NSA + ro; r.K = ws + (kind == 1 ? WS_K8SLC : WS_K8WIN) + (size_t)id * SEQ * 128; r.V = ws + WS_VT + (size_t)((kind == 1 ? 0 : 4) + id) * SEQ * 128;
        r.O = (bf16*)(ws + (kind == 1 ? WS_OSLC : WS_OWIN)) + ro; r.P0 = 256 * x; r.ksh = 2; r.W = kind == 1 ? (1 << 20) : 512; r.sel = kind == 1 ? 1 : 0;
        if (kind == 1) r.selsrc = (const unsigned*)(ws + WS_SELM) + ((size_t)id * SEQ + 64 * x) * 4; }
    return r;
}
__device__ __forceinline__ void p5_flash(const KArgs& a, char* lds, LAS int* qslot, int rep, int vcu) {
    unsigned char* ws = a.ws; const int tid = threadIdx.x, wave = __builtin_amdgcn_readfirstlane(tid >> 6), lane = tid & 63;
    unsigned* head = (unsigned*)(ws + WS_CTL) + CW_QHEAD + 64 * rep; const int* items = (const int*)(ws + WS_ITEMS);
    int t0_ = threadIdx.x; asm volatile("" : "+v"(t0_)); const int w0_ = __builtin_amdgcn_readfirstlane(t0_ >> 6);
    BgAsync bg{a, (LAS float*)((LAS unsigned char*)lds + BG_LDS_OFF + w0_ * BG_TILE_BYTES), __builtin_amdgcn_readfirstlane(vcu * NWAVES + wave), (int)gridDim.x * NWAVES, 0, 0, 0, (rep == 0 && BG_IN_FLASH) ? 1 : 0, 0, BgItem{}};
#define P5_FETCH(dst) do { if (tid == 0) *qslot = (int)__hip_atomic_fetch_add(head, 1u, RLX_AGENT); __syncthreads(); dst = __builtin_amdgcn_readfirstlane(*qslot); __syncthreads(); } while (0)
    int ci, ni; P5_FETCH(ci);
    if (ci < NITEMS_ATT) {
        P5_FETCH(ni);
        fa::BlockRef cur = p5_ref(ws, items[ci]); fa::Seam S;
        fa::fa_prime(cur, lds, S);
        int par = 0;
        for (;;) {
            const bool last = ni >= NITEMS_ATT;
            const fa::BlockRef nxt = last ? cur : p5_ref(ws, items[ni]);
            fa::fa_block(cur, nxt, SEQ, lds, S, head, qslot + par, bg);
            ni = __builtin_amdgcn_readfirstlane(qslot[par]); par ^= 1;
            if (last) break;
            cur = nxt;
        }
    }
    { int t1_ = threadIdx.x; asm volatile("" : "+v"(t1_)); bg.drain(bg.tile, t1_ & 63); }
#undef P5_FETCH
}

__device__ __forceinline__ void p6_combine(const KArgs& a, int gw, int NGW, int lane) {
    unsigned char* ws = a.ws; const float lam = ((const float*)(ws + WS_SCAL))[0];
    const float* gates = (const float*)(ws + WS_GATES); const float* sg = a.in[17];
    for (int tok = gw; tok < TOK; tok += NGW) {
        const int b = tok >> 13, t = tok & (SEQ - 1); bf16* mix = (bf16*)(ws + WS_MIX) + (size_t)tok * DM;
#pragma unroll
        for (int c = 0; c < 2; ++c) { const int col = c * 512 + lane * 8, h = col >> 7, d = col & 127, kvh = h >> 2, g = h & 3;
            const size_t ro = ((((size_t)(b * 2 + kvh) * SEQ + t) * 4 + g) * 128 + d) * 2;
            const v4u oc = *(const v4u*)(ws + WS_OCMP + ro), os = *(const v4u*)(ws + WS_OSLC + ro), ow = *(const v4u*)(ws + WS_OWIN + ro);
            const float gc = gates[(size_t)tok * 24 + h * 3 + 0], gs = gates[(size_t)tok * 24 + h * 3 + 1], gwn = gates[(size_t)tok * 24 + h * 3 + 2];
            v4u o;
            o.x = pk2(gc * bflo(oc.x) + gs * bflo(os.x) + gwn * bflo(ow.x), gc * bfhi(oc.x) + gs * bfhi(os.x) + gwn * bfhi(ow.x));
            o.y = pk2(gc * bflo(oc.y) + gs * bflo(os.y) + gwn * bflo(ow.y), gc * bfhi(oc.y) + gs * bfhi(os.y) + gwn * bfhi(ow.y));
            o.z = pk2(gc * bflo(oc.z) + gs * bflo(os.z) + gwn * bflo(ow.z), gc * bfhi(oc.z) + gs * bfhi(os.z) + gwn * bfhi(ow.z));
            o.w = pk2(gc * bflo(oc.w) + gs * bflo(os.w) + gwn * bflo(ow.w), gc * bfhi(oc.w) + gs * bfhi(os.w) + gwn * bfhi(ow.w));
            *(v4u*)(mix + col) = o; }
#pragma unroll
        for (int c = 0; c < 2; ++c) { const int h = 2 * c + (lane >> 5), l32 = lane & 31, half = l32 >> 4, d = (l32 & 15) * 8;
            const size_t i0 = ((size_t)((((b * 4 + h) * 2 + 0) * 2 + half)) * SEQ + t) * 128 + d, i1 = ((size_t)((((b * 4 + h) * 2 + 1) * 2 + half)) * SEQ + t) * 128 + d;
            const v4u o0 = *(const v4u*)((const bf16*)(ws + WS_ODIFF) + i0), o1 = *(const v4u*)((const bf16*)(ws + WS_ODIFF) + i1);
            float x[8] = {bflo(o0.x) - lam * bflo(o1.x), bfhi(o0.x) - lam * bfhi(o1.x), bflo(o0.y) - lam * bflo(o1.y), bfhi(o0.y) - lam * bfhi(o1.y),
                          bflo(o0.z) - lam * bflo(o1.z), bfhi(o0.z) - lam * bfhi(o1.z), bflo(o0.w) - lam * bflo(o1.w), bfhi(o0.w) - lam * bfhi(o1.w)};
            float ss = 0.f;
#pragma unroll
            for (int k = 0; k < 8; ++k) ss += x[k] * x[k];
            ss += __shfl_xor(ss, 1); ss += __shfl_xor(ss, 2); ss += __shfl_xor(ss, 4); ss += __shfl_xor(ss, 8); ss += __shfl_xor(ss, 16);
            const float rstd = 0.8f / sqrtf(ss * (1.f / 256.f) + NORM_EPS);
            const float* gp = sg + half * 128 + d; const f32x4 g0 = *(const f32x4*)gp, g1 = *(const f32x4*)(gp + 4);
            v4u o; o.x = pk2(x[0] * rstd * g0.x, x[1] * rstd * g0.y); o.y = pk2(x[2] * rstd * g0.z, x[3] * rstd * g0.w); o.z = pk2(x[4] * rstd * g1.x, x[5] * rstd * g1.y); o.w = pk2(x[6] * rstd * g1.z, x[7] * rstd * g1.w);
            *(v4u*)(mix + 1024 + h * 256 + half * 128 + d) = o; }
    }
}

__device__ __forceinline__ void p8_router(const KArgs& a, char* lds) {
    unsigned char* ws = a.ws; const bf16* h = (const bf16*)(ws + WS_HBF); const float* gn = a.in[19]; const float* wr_ = a.in[20]; const float* br = a.in[21];
    const int tid = threadIdx.x, wave = __builtin_amdgcn_readfirstlane(tid >> 6), lane = tid & 63, n = lane & 31, kh = lane >> 5, tg = wave & 1, kq = wave >> 1;
    float* part = (float*)lds;
    float* ssp = (float*)(lds + 32768);
    float* rstd_l = (float*)(lds + 32768 + 1024);
    int* lcnt = (int*)(lds + 32768 + 2048);
    int* gbase = lcnt + 32;
    unsigned* ecnt = (unsigned*)(ws + WS_CTL) + CW_ECNT;
    for (int tile = blockIdx.x; tile < TOK / 64; tile += gridDim.x) {
        const int t0 = tile * 64;
        __syncthreads();
        if (tid < 32) lcnt[tid] = 0;
        const bf16* hrow = h + (size_t)(t0 + 32 * tg + n) * DM;
        f32x16 acc = {}; float ss = 0.f;
#pragma unroll 4
        for (int c = 0; c < 64; ++c) { const int kb = kq * 512 + 8 * c + 4 * kh;
            const v2u hw = *(const v2u*)(hrow + kb); const f32x4 hv = {bflo(hw.x), bfhi(hw.x), bflo(hw.y), bfhi(hw.y)}, gv = *(const f32x4*)(gn + kb);
            ss += (hv.x * hv.x + hv.y * hv.y) + (hv.z * hv.z + hv.w * hv.w);
#pragma unroll
            for (int e4 = 0; e4 < 4; ++e4) acc = __builtin_amdgcn_mfma_f32_32x32x2f32(wr_[(size_t)(kb + e4) * 32 + n], hv[e4] * gv[e4], acc, 0, 0, 0); }
        { auto rr = __builtin_amdgcn_permlane32_swap(__float_as_uint(ss), __float_as_uint(ss), false, false); ss = __uint_as_float(rr[0]) + __uint_as_float(rr[1]); }
#pragma unroll
        for (int r = 0; r < 16; ++r) part[((tg * 4 + kq) * 16 + r) * 64 + lane] = acc[r];
        if (kh == 0) ssp[(tg * 4 + kq) * 32 + n] = ss;
        __syncthreads();
        int te[4] = {0, 0, 0, 0}; float tgv[4] = {0.f, 0.f, 0.f, 0.f}; int rk[4] = {0, 0, 0, 0};
        if (kq == 0) {
            float lg[16]; const float sst = (ssp[(tg * 4 + 0) * 32 + n] + ssp[(tg * 4 + 1) * 32 + n]) + (ssp[(tg * 4 + 2) * 32 + n] + ssp[(tg * 4 + 3) * 32 + n]);
            const float rstd = 1.f / sqrtf(sst * (1.f / DM) + NORM_EPS);
            if (kh == 0) rstd_l[32 * tg + n] = rstd;
#pragma unroll
            for (int r = 0; r < 16; ++r) { const float s = (part[((tg * 4 + 0) * 16 + r) * 64 + lane] + part[((tg * 4 + 1) * 16 + r) * 64 + lane]) + (part[((tg * 4 + 2) * 16 + r) * 64 + lane] + part[((tg * 4 + 3) * 16 + r) * 64 + lane]);
                lg[r] = s * rstd + br[fa::crow(r, kh)]; }
            float tv[4];
#pragma unroll
            for (int k = 0; k < 4; ++k) { float best = lg[0]; int be = fa::crow(0, kh);
#pragma unroll
                for (int r = 1; r < 16; ++r) if (lg[r] > best) { best = lg[r]; be = fa::crow(r, kh); }
                auto rv = __builtin_amdgcn_permlane32_swap(__float_as_uint(best), __float_as_uint(best), false, false); auto re = __builtin_amdgcn_permlane32_swap((unsigned)be, (unsigned)be, false, false);
                const float ob = kh ? __uint_as_float(rv[0]) : __uint_as_float(rv[1]); const int oe = kh ? (int)re[0] : (int)re[1];
                if (ob > best || (ob == best && oe < be)) { best = ob; be = oe; }
                tv[k] = best; te[k] = be;
#pragma unroll
                for (int r = 0; r < 16; ++r) if (fa::crow(r, kh) == be) lg[r] = -__builtin_inff(); }
            const float e1 = __expf(tv[1] - tv[0]), e2 = __expf(tv[2] - tv[0]), e3 = __expf(tv[3] - tv[0]), inv = 1.f / (1.f + e1 + e2 + e3);
            tgv[0] = inv; tgv[1] = e1 * inv; tgv[2] = e2 * inv; tgv[3] = e3 * inv;
            if (kh == 0) {
#pragma unroll
                for (int k = 0; k < 4; ++k) rk[k] = atomicAdd(&lcnt[te[k]], 1); }
        }
        __syncthreads();
        if (tid < 32) gbase[tid] = (int)__hip_atomic_fetch_add(ecnt + 64 * tid, (unsigned)lcnt[tid], RLX_AGENT);
        __syncthreads();
        if (kq == 0 && kh == 0) { const int tok = t0 + 32 * tg + n;
#pragma unroll
            for (int k = 0; k < 4; ++k) { const size_t p = (size_t)te[k] * TOK + gbase[te[k]] + rk[k]; ((int*)(ws + WS_LIST))[p] = tok * 4 + k; ((float*)(ws + WS_GATEW))[p] = tgv[k]; ((int*)(ws + WS_INV))[tok * 4 + k] = (te[k] << 16) | (gbase[te[k]] + rk[k]); } }
#pragma unroll 1
        for (int q = 0; q < 8; ++q) { const int tl = wave * 8 + q; const float rs = rstd_l[tl];
            const GAS v2u* xr = (const GAS v2u*)(h + (size_t)(t0 + tl) * DM) + lane; const GAS f32x4* gr = (const GAS f32x4*)gn + lane;
            GAS unsigned* o4 = (GAS unsigned*)(ws + WS_HN + (size_t)(t0 + tl) * DM) + lane;
#pragma unroll
            for (int j = 0; j < 8; ++j) { const v2u vw = xr[64 * j]; const f32x4 g = gr[64 * j]; o4[64 * j] = f8pk4(bflo(vw.x) * rs * g.x, bfhi(vw.x) * rs * g.y, bflo(vw.y) * rs * g.z, bfhi(vw.y) * rs * g.w); } }
    }
    __syncthreads();
}

__device__ __forceinline__ void p11_final(const KArgs& a, int gw, int NGW, int lane, const LAS int* tb) {
    const bf16* YS = (const bf16*)(a.ws + WS_YS); const int* INV = (const int*)(a.ws + WS_INV);
    for (int tok = gw; tok < TOK; tok += NGW) {
        GAS f32x4* o = (GAS f32x4*)(a.out + (size_t)tok * DM) + lane; const GAS v2u* hb = (const GAS v2u*)((const bf16*)(a.ws + WS_HBF) + (size_t)tok * DM) + lane;
        size_t rowo[4];
#pragma unroll
        for (int k = 0; k < 4; ++k) { const int iv = __builtin_amdgcn_readfirstlane(INV[tok * 4 + k]); rowo[k] = ((size_t)__builtin_amdgcn_readfirstlane(tb[iv >> 16]) * 256 + (iv & 0xffff)) * DM; }
        f32x4 v[8]; v2u y[8][4];
#pragma unroll
        for (int j = 0; j < 8; ++j) { { const v2u hw = hb[64 * j]; v[j] = f32x4{bflo(hw.x), bfhi(hw.x), bflo(hw.y), bfhi(hw.y)}; }
#pragma unroll
            for (int k = 0; k < 4; ++k) y[j][k] = *(const GAS v2u*)(YS + rowo[k] + 256 * j + 4 * lane); }
#pragma unroll
        for (int j = 0; j < 8; ++j) {
#pragma unroll
            for (int k = 0; k < 4; ++k) { v[j].x += bflo(y[j][k].x); v[j].y += bfhi(y[j][k].x); v[j].z += bflo(y[j][k].y); v[j].w += bfhi(y[j][k].y); }
            o[64 * j] = v[j]; }
    }
}

constexpr int NPHASE = 12;
__global__ void __launch_bounds__(NWAVES * 64, 2) mk_fwd(KArgs args) {
    extern __shared__ __attribute__((aligned(16))) unsigned char lds[];
    LAS unsigned char* L = (LAS unsigned char*)lds;
    const int tid = threadIdx.x, lane = tid & 63, wave = __builtin_amdgcn_readfirstlane(tid >> 6);
    const int G = gridDim.x; const int bx = blockIdx.x; const int vcu = (G % 8 == 0) ? (bx % 8) * (G / 8) + bx / 8 : bx;
    const int gw = vcu * NWAVES + wave, NGW = G * NWAVES;
    unsigned char* ws = args.ws; gu32* ctl = (gu32*)(ws + WS_CTL);
    for (int u = tid; u < (LDS_BYTES - LDSCTL_OFF) / 4; u += NWAVES * 64) ((LAS unsigned*)(L + LDSCTL_OFF))[u] = 0u;
    __syncthreads();
    volatile LAS unsigned* MISC = (volatile LAS unsigned*)(L + MISC_OFF);
    XcdBarrier bar; bar.bar = (unsigned*)ctl + CW_BAR; bar.x = 0; bar.st = nullptr;
    if (!MK_SPLIT) bar = xcd_barrier_post((unsigned*)ctl + CW_BAR, MISC + 8);
    const int lo = args.ph_lo, hi = args.ph_hi;
#ifndef PH_MASK
#define PH_MASK 0xFFF
#endif
#define IN(k) (((PH_MASK >> (k)) & 1) && lo <= (k) && (k) < hi)
#define SEAM(k) do { if (IN(k) && IN((k) + 1)) xcd_barrier(bar); } while (0)
#ifndef ALIGN_MULTI
#define ALIGN_MULTI true
#endif
#ifndef REP_MASK
#define REP_MASK 0
#endif
#define REPS(k) (1 + ((REP_MASK >> (k)) & 1))

    if (IN(0)) { _Pragma("unroll") for (int rep = 0; rep < REPS(0); ++rep) { if (rep) xcd_barrier(bar); p0_prologue(args, L, gw, NGW, wave, lane); } } SEAM(0);
    if (IN(1)) { _Pragma("unroll") for (int rep = 0; rep < REPS(1); ++rep) { if (rep) xcd_barrier(bar); DenseSched S; S.init(ws + WS_XN, ws + WS_WIN_T, TOK, NPROJ, G, bx); EpiInProj E{ws};
        pg8::gemm_phase<EpiInProj, DenseSched, ALIGN_MULTI>(L, DM * 2, S, E); } } SEAM(1);
    if (IN(2)) {
        if (G >= 72) { if (bx < 36) { CmpSched S{(const char*)(ws + WS_KCA), (const char*)(ws + WS_WCAT), bx}; EpiG E{ws}; pg8::gemm_phase<EpiG, CmpSched, false>(L, 2048 * 2, S, E); }
                       else { p1b_norm(args, (bx - 36) * NWAVES + wave, (G - 36) * NWAVES, lane); p1c_vt(args, (bx - 36) * NWAVES + wave, (G - 36) * NWAVES, lane); } }
        else { for (int c = bx; c < 36; c += G) { CmpSched S{(const char*)(ws + WS_KCA), (const char*)(ws + WS_WCAT), c}; EpiG E{ws}; pg8::gemm_phase<EpiG, CmpSched, false>(L, 2048 * 2, S, E); }
               p1b_norm(args, gw, NGW, lane); p1c_vt(args, gw, NGW, lane); }
    } SEAM(2);
    if (IN(3)) { p2b_compress2(args, L); } SEAM(3);
    if (IN(4)) { for (int x = bx; x < 256; x += G) { p4_cmp_unit(args, (char*)lds, x); p4_cmp_unit(args, (char*)lds, 511 - x); } } SEAM(4);
    if (IN(5)) { _Pragma("unroll") for (int rep = 0; rep < REPS(5); ++rep) { if (rep) xcd_barrier(bar); p5_flash(args, (char*)lds, (LAS int*)(L + LDSCTL_OFF + 64), rep + args.rep, vcu); } } SEAM(5);
    if (IN(6)) { int l6_ = threadIdx.x; asm volatile("" : "+v"(l6_)); p6_combine(args, gw, NGW, l6_ & 63); } SEAM(6);
    if (IN(7)) { _Pragma("unroll") for (int rep = 0; rep < REPS(7); ++rep) { if (rep) xcd_barrier(bar); DenseSched S; S.init(ws + WS_MIX, ws + WS_WOUT_T, TOK, DM, G, bx); EpiOutProj E{args.in[0], (bf16*)(ws + (args.rep ? WS_YS : WS_HBF)), args.rep};
        pg8::gemm_phase<EpiOutProj, DenseSched, ALIGN_MULTI>(L, DM * 2, S, E); } } SEAM(7);
    if (IN(8)) { p8_router(args, (char*)lds); } SEAM(8);
    LAS int* tb = (LAS int*)(L + LDSX_OFF); LAS int* cn = tb + 64;
    if (IN(9) || IN(10) || IN(11)) {
        __syncthreads();
        if (tid == 0) { int s = 0; for (int e = 0; e < NEXP; ++e) { const int c = (int)__hip_atomic_load((unsigned*)ctl + CW_ECNT + 64 * e, RLX_AGENT); cn[e] = c; tb[e] = s; s += (c + 255) >> 8; } tb[NEXP] = s; }
        __syncthreads();
    }
    if (IN(9)) { _Pragma("unroll") for (int rep = 0; rep < REPS(9); ++rep) { if (rep) xcd_barrier(bar); MoeSched<true, 16> S{(const char*)(ws + WS_HN), (const char*)(ws + WS_WGU_T), (size_t)4096 * 2048, (const int*)(ws + WS_LIST), tb, cn, G, bx, __builtin_amdgcn_readfirstlane(tb[NEXP])};
        EpiGateUp E{args.in[23], ws + WS_HB, args.rep};
        pg8::gemm_phase<EpiGateUp, MoeSched<true, 16>, ALIGN_MULTI, true, 122>(L, DM, S, E); } } SEAM(9);
    if (IN(10)) { _Pragma("unroll") for (int rep = 0; rep < REPS(10); ++rep) { if (rep) xcd_barrier(bar); MoeSched<false, 8> S{(const char*)(ws + WS_HB), (const char*)(ws + WS_WD_T), (size_t)2048 * 2048, (const int*)(ws + WS_LIST), tb, cn, G, bx, __builtin_amdgcn_readfirstlane(tb[NEXP])};
        EpiDown E{args.in[25], (bf16*)(ws + WS_YS), (const int*)(ws + WS_LIST), (const float*)(ws + WS_GATEW), tb, args.out, args.rep};
        pg8::gemm_phase<EpiDown, MoeSched<false, 8>, ALIGN_MULTI, true, 122>(L, DFF, S, E); } } SEAM(10);
    if (IN(11)) { int l11_ = threadIdx.x; asm volatile("" : "+v"(l11_)); p11_final(args, gw, NGW, l11_ & 63, tb); }
#undef IN
#undef SEAM
}
#if MK_CHECK
constexpr int NSTAGE = 16;
__device__ __forceinline__ unsigned hsh(unsigned x) { x ^= x >> 16; x *= 0x7feb352du; x ^= x >> 15; x *= 0x846ca68bu; x ^= x >> 16; return x; }
__device__ void chk_commit(unsigned char* ws, int stage, float err) {
    __shared__ float red[256];
    if (!(err == err)) err = 1e30f;
    red[threadIdx.x] = err; __syncthreads();
    for (int s = 128; s > 0; s >>= 1) { if (threadIdx.x < s) red[threadIdx.x] = fmaxf(red[threadIdx.x], red[threadIdx.x + s]); __syncthreads(); }
    if (threadIdx.x == 0) atomicMax((unsigned*)(ws + WS_CTL) + CW_CHK + 64 * stage, __float_as_uint(red[0]));
    __syncthreads();
}
__device__ float blk_sum(float v) { __shared__ float r2[256]; r2[threadIdx.x] = v; __syncthreads();
    for (int s = 128; s > 0; s >>= 1) { if (threadIdx.x < s) r2[threadIdx.x] += r2[threadIdx.x + s]; __syncthreads(); } const float o = r2[0]; __syncthreads(); return o; }
__device__ float blk_max(float v) { __shared__ float r3[256]; r3[threadIdx.x] = v; __syncthreads();
    for (int s = 128; s > 0; s >>= 1) { if (threadIdx.x < s) r3[threadIdx.x] = fmaxf(r3[threadIdx.x], r3[threadIdx.x + s]); __syncthreads(); } const float o = r3[0]; __syncthreads(); return o; }
__device__ __forceinline__ float relerr(float a, float ref, float floor_) { return fabsf(a - ref) / (fabsf(ref) + floor_); }
__device__ __forceinline__ int orig_col(int c) { return c < 2560 ? c : (c < 5632 ? c + 24 : (c < 5656 ? c - 5632 + 2560 : -1)); }
__device__ __forceinline__ float f8dec(unsigned v) { const unsigned e = (v >> 3) & 15u, m = v & 7u; const float a = e == 0u ? (float)m * 0.001953125f : (float)(8u + m) * exp2f((float)e - 10.f); return (v & 128u) ? -a : a; }
__device__ __forceinline__ unsigned f8enc(float x) { return f8pk4(x, 0.f, 0.f, 0.f) & 255u; }
__device__ __forceinline__ float qw(float w) { return f8dec(f8enc(w * 32.f)) * 0.03125f; }
__device__ __forceinline__ float rope_inv(int i) { return powf(500000.f, -(float)(2 * i) / 32.f); }

__global__ void chk0(KArgs a) {
    unsigned char* ws = a.ws; const int tid = threadIdx.x; float err = 0.f;
    const int row = hsh(blockIdx.x * 7919u + 1u) % TOK; const float* x = a.in[0] + (size_t)row * DM;
    float ss = 0.f; for (int c = tid; c < DM; c += 256) ss += x[c] * x[c];
    ss = blk_sum(ss); const float rstd = 1.f / sqrtf(ss / DM + NORM_EPS);
    for (int c = tid; c < DM; c += 256) err = fmaxf(err, relerr(bf2f(((const bf16*)(ws + WS_XN))[(size_t)row * DM + c]), x[c] * rstd * a.in[1][c], 0.05f));
    const unsigned r = hsh(blockIdx.x * 256u + tid + 12345u);
    { const int c = r % NPROJ, k = (r >> 13) % 2048, oc = orig_col(c); const float ref = oc < 0 ? 0.f : a.in[2][(size_t)k * 5656 + oc]; err = fmaxf(err, relerr(bf2f(((const bf16*)(ws + WS_WIN_T))[(size_t)c * 2048 + k]), ref, 0.01f)); }
    { const int c = r % 2048, k = (r >> 11) % 2048; err = fmaxf(err, relerr(bf2f(((const bf16*)(ws + WS_WOUT_T))[(size_t)c * 2048 + k]), a.in[18][(size_t)k * 2048 + c], 0.01f)); }
    { const int e = r & 1, n = (r >> 1) % 512, k = (r >> 10) % 2048; const float ref = a.in[e ? 9 : 7][(size_t)((n >> 8) * 2048 + k) * 256 + (n & 255)];
      err = fmaxf(err, relerr(bf2f(((const bf16*)(ws + WS_WCAT + (size_t)e * 2 * MiB))[(size_t)n * 2048 + k]), ref, 0.005f)); }
    { const int pos = r % SEQ, i = (r >> 13) & 15; const float ang = (float)pos * rope_inv(i); err = fmaxf(err, fabsf(((const float*)(ws + WS_ROPE))[pos * 16 + i] - cosf(ang)) + fabsf(((const float*)(ws + WS_ROPE))[SEQ * 16 + pos * 16 + i] - sinf(ang))); }
    { const int e = r & 1, rr = (r >> 1) % 4, c = (r >> 3) % 2048; const float ref = rr < 2 ? a.in[5 + e][rr * 2048 + c] : 0.f; err = fmaxf(err, relerr(bf2f(((const bf16*)(ws + WS_KCA + (size_t)e * KV6_STRIDE))[(size_t)(2048 + rr) * 2048 + c]), ref, 0.002f)); }
    chk_commit(ws, 0, err);
}
__global__ void chk0b(KArgs a) {
    unsigned char* ws = a.ws; const int tid = threadIdx.x; float err = 0.f; const unsigned r = hsh(blockIdx.x * 256u + tid + 54321u);
    { const int e = r % 32, rho = (r >> 5) % 4096, k = (r >> 17) % 2048, pn = rho >> 8, bj = (rho >> 7) & 1, i = rho & 127, col = bj * 2048 + pn * 128 + i;
      err = fmaxf(err, (float)((unsigned)(ws + WS_WGU_T)[((size_t)e * 4096 + rho) * 2048 + k] != f8enc(a.in[22][((size_t)e * 2048 + k) * 4096 + col] * 32.f))); }
    { const int e = r % 32, c = (r >> 5) % 2048, k = (r >> 16) % 2048; err = fmaxf(err, (float)((unsigned)(ws + WS_WD_T)[((size_t)e * 2048 + c) * 2048 + k] != f8enc(a.in[24][((size_t)e * 2048 + k) * 2048 + c] * 32.f))); }
    chk_commit(ws, 0, err);
}
__device__ __forceinline__ float inproj_fetch(unsigned char* ws, int row, int c) {
    const int b = row >> 13, t = row & (SEQ - 1);
    if (c >= 5632) return ((const float*)(ws + WS_GATES))[(size_t)row * 24 + (c - 5632)];
    if (c < 1024) { const int h = c >> 7, d = c & 127, kvh = h >> 2, g = h & 3; return bf2f(((const bf16*)(ws + WS_QNSA))[((((size_t)(b * 2 + kvh)) * SEQ + t) * 4 + g) * 128 + d]); }
    if (c < 2560) { const int q = (c - 1024) >> 8, kvh = ((c - 1024) >> 7) & 1, d = c & 127; return bf2f(((const bf16*)(ws + WS_KV6 + (size_t)q * KV6_STRIDE))[((size_t)(b * 2 + kvh) * SEQ + t) * 128 + d]); }
    const int cc = c - 2560, which = cc >> 10, h = (cc >> 8) & 3, sub = (cc >> 7) & 1, d = cc & 127;
    const size_t base = which == 0 ? WS_QD : (which == 1 ? WS_KD : WS_VD);
    return bf2f(((const bf16*)(ws + base))[((size_t)((b * 4 + h) * 2 + sub) * SEQ + t) * 128 + d]);
}
__global__ void chk1(KArgs a) {
    unsigned char* ws = a.ws; const unsigned r = hsh(blockIdx.x * 256u + threadIdx.x + 777u);
    const int row = r % TOK, c = (r >> 14) % 5656, oc = orig_col(c);
    float s = 0.f; for (int k = 0; k < DM; ++k) s += bf2f(((const bf16*)(ws + WS_XN))[(size_t)row * DM + k]) * a.in[2][(size_t)k * 5656 + oc];
    const float ref = c >= 5632 ? 1.f / (1.f + expf(-s)) : s;
    chk_commit(ws, 1, relerr(inproj_fetch(ws, row, c), ref, 0.3f));
}
__device__ float raw_proj(const KArgs& a, int row, int oc) { float s = 0.f; for (int k = 0; k < DM; ++k) s += bf2f(((const bf16*)(a.ws + WS_XN))[(size_t)row * DM + k]) * a.in[2][(size_t)k * 5656 + oc]; return bf2f((bf16)f2bf(s)); }
__global__ void chk2(KArgs a) {
    unsigned char* ws = a.ws; const int tid = threadIdx.x; const unsigned r = hsh(blockIdx.x * 31u + 5u);
    const int kind = blockIdx.x % 5, row = (r >> 3) % TOK, b = row >> 13, t = row & (SEQ - 1);
    int oc0; const float* g; const bf16* dst;
    if (kind == 0) { const int h = r & 7; oc0 = h * 128; g = a.in[3]; dst = (const bf16*)(ws + WS_QNSA) + ((((size_t)(b * 2 + (h >> 2))) * SEQ + t) * 4 + (h & 3)) * 128; }
    else if (kind == 1) { const int kvh = r & 1; oc0 = 1536 + kvh * 128; g = a.in[4] + 128; dst = (const bf16*)(ws + WS_KSLC) + ((size_t)(b * 2 + kvh) * SEQ + t) * 128; }
    else if (kind == 2) { const int kvh = r & 1; oc0 = 2048 + kvh * 128; g = a.in[4] + 256; dst = (const bf16*)(ws + WS_KWIN) + ((size_t)(b * 2 + kvh) * SEQ + t) * 128; }
    else { const int hc = r & 7; oc0 = (kind == 3 ? 2584 : 3608) + hc * 128; g = a.in[kind == 3 ? 11 : 12]; dst = (const bf16*)(ws + (kind == 3 ? WS_QD : WS_KD)) + ((size_t)(b * 8 + hc) * SEQ + t) * 128; }
    __shared__ float v[128];
    float x = 0.f; if (tid < 128) x = raw_proj(a, row, oc0 + tid);
    const float ss = blk_sum(tid < 128 ? x * x : 0.f); const float rstd = 1.f / sqrtf(ss / 128.f + NORM_EPS);
    if (tid < 128) v[tid] = x * rstd * g[tid]; __syncthreads();
    float err = 0.f;
    if (tid < 128) { float y = v[tid];
        if (tid < 32) { const int i = tid & 15; const float ang = (float)t * rope_inv(i), c = cosf(ang), s = sinf(ang); y = tid < 16 ? v[tid] * c - v[tid + 16] * s : v[tid] * c + v[tid - 16] * s; }
        err = relerr(bf2f(dst[tid]), y, 0.6f); }
    chk_commit(ws, 2, err);
}
__global__ void chk3(KArgs a) {
    unsigned char* ws = a.ws; const unsigned r = hsh(blockIdx.x * 256u + threadIdx.x + 99u);
    const int e = r & 1, n = (r >> 1) % 512; int row = (r >> 10) % 2050; const int part = n >> 8;
    const bf16* A = (const bf16*)(ws + WS_KCA + (size_t)e * KV6_STRIDE) + (size_t)row * 2048; const float* w1 = a.in[e ? 9 : 7];
    float s = 0.f; for (int k = 0; k < 2048; ++k) s += bf2f(A[k]) * w1[(size_t)(part * 2048 + k) * 256 + (n & 255)];
    chk_commit(ws, 3, relerr(((const float*)(ws + WS_G + (size_t)e * G_STRIDE))[(size_t)row * 512 + n], s, 0.3f));
}
__device__ __forceinline__ float gelu_ref(float x) { return 0.5f * x * (1.f + tanhf(0.7978845608028654f * (x + 0.044715f * x * x * x))); }
__global__ void chk4(KArgs a) {
    unsigned char* ws = a.ws; const int tid = threadIdx.x; const unsigned r = hsh(blockIdx.x * 131u + 3u);
    const int e = blockIdx.x & 1, bk = (r >> 1) & 3; int i = (r >> 3) % 511; if (blockIdx.x < 4) i = blockIdx.x < 2 ? 0 : 510;
    const bf16* A = (const bf16*)(ws + WS_KCA + (size_t)e * KV6_STRIDE) + ((size_t)bk * SEQ + 16 * i) * 128; const float* pe = a.in[5 + e]; const float* w1 = a.in[e ? 9 : 7]; const float* w2 = a.in[e ? 10 : 8];
    __shared__ float hid[256]; __shared__ float ov[128];
    float s = 0.f; for (int k = 0; k < 4096; ++k) s += (bf2f(A[k]) + pe[k]) * w1[(size_t)k * 256 + tid];
    hid[tid] = gelu_ref(s); __syncthreads();
    float o = 0.f; if (tid < 128) for (int n = 0; n < 256; ++n) o += hid[n] * w2[n * 128 + tid];
    float err = 0.f;
    if (e == 0) { const float ss = blk_sum(tid < 128 ? o * o : 0.f); const float rstd = 1.f / sqrtf(ss / 128.f + NORM_EPS);
        if (tid < 128) ov[tid] = o * rstd * a.in[4][tid]; __syncthreads();
        if (tid < 128) { float y = ov[tid]; if (tid < 32) { const int q = tid & 15; const float ang = (float)(16 * i + 31) * rope_inv(q), c = cosf(ang), sn = sinf(ang); y = tid < 16 ? ov[tid] * c - ov[tid + 16] * sn : ov[tid] * c + ov[tid - 16] * sn; }
            err = relerr(bf2f(((const bf16*)(ws + WS_KCMP))[((size_t)bk * 512 + i) * 128 + tid]), y, 0.6f); } }
    else if (tid < 128) err = relerr(bf2f(((const bf16*)(ws + WS_VCMP))[((size_t)bk * 512 + i) * 128 + tid]), o, 0.3f);
    chk_commit(ws, 4, err);
}
__global__ void chk5(KArgs a) {
    unsigned char* ws = a.ws; const int tid = threadIdx.x; const unsigned r = hsh(blockIdx.x * 977u + 11u);
    const int bk = r & 3; int t = (r >> 2) % SEQ; if (blockIdx.x < 8) t = blockIdx.x * 9; if (blockIdx.x == 8) t = SEQ - 1;
    __shared__ float p[4][512]; __shared__ float imp[128]; __shared__ int sel[128];
    const bf16* Q = (const bf16*)(ws + WS_QNSA) + ((size_t)bk * SEQ + t) * 512; const bf16* Kc = (const bf16*)(ws + WS_KCMP) + (size_t)bk * 512 * 128; const bf16* Vc = (const bf16*)(ws + WS_VCMP) + (size_t)bk * 512 * 128;
    for (int idx = tid; idx < 4 * 512; idx += 256) { const int g = idx >> 9, i = idx & 511; float s = -1e30f;
        if (i < 511 && 16 * i + 31 <= t) { s = 0.f; for (int d = 0; d < 128; ++d) s += bf2f(Q[g * 128 + d]) * bf2f(Kc[(size_t)i * 128 + d]); s *= ATT_SCALE; }
        p[g][i] = s; }
    __syncthreads();
    if (tid < 4) { float m = -1e30f; for (int i = 0; i < 512; ++i) m = fmaxf(m, p[tid][i]); float l = 0.f;
        for (int i = 0; i < 512; ++i) { const float e = p[tid][i] > -1e29f ? expf(p[tid][i] - m) : 0.f; p[tid][i] = e; l += e; }
        const float rl = 1.f / fmaxf(l, 1e-30f); for (int i = 0; i < 512; ++i) p[tid][i] *= rl; }
    __syncthreads();
    float err = 0.f;
    for (int idx = tid; idx < 512; idx += 256) { const int g = idx >> 7, d = idx & 127; float o = 0.f; for (int i = 0; i < 511; ++i) o += p[g][i] * bf2f(Vc[(size_t)i * 128 + d]);
        err = fmaxf(err, relerr(bf2f(((const bf16*)(ws + WS_OCMP))[(((size_t)bk * SEQ + t) * 4 + g) * 128 + d]), o, 0.02f)); }
    chk_commit(ws, 5, err);
    const int cur = t >> 6;
    if (tid < 128) { const int j = tid; float v = 0.f; for (int i = 4 * j - 1; i <= 4 * j + 3; ++i) if (i >= 0 && i < 511) v += (p[0][i] + p[1][i]) + (p[2][i] + p[3][i]);
        if (j == 0 || j == cur || j == cur - 1) v = 1e9f; if (j > cur) v = -1e30f; imp[j] = v; }
    __syncthreads();
    if (tid < 128) { const float v = imp[tid]; int rank = 0; for (int j = 0; j < 128; ++j) rank += (imp[j] > v || (imp[j] == v && j < tid)) ? 1 : 0; sel[tid] = (rank < 16 && v > -1.f) ? 1 : 0; }
    __syncthreads();
    float e2 = 0.f;
    if (tid < 128) { const unsigned w = ((const unsigned*)(ws + WS_SELM))[((size_t)bk * SEQ + t) * 4 + (tid >> 5)]; e2 = (float)((int)((w >> (tid & 31)) & 1u) != sel[tid]); }
    e2 = blk_sum(e2) / 32.f;
    chk_commit(ws, 6, e2);
}
__global__ void chk6(KArgs a) {
    unsigned char* ws = a.ws; const int tid = threadIdx.x; const unsigned r = hsh(blockIdx.x * 613u + 17u);
    const int kind = blockIdx.x % 3; int t = (r >> 8) % SEQ; if (blockIdx.x < 12) t = (blockIdx.x / 3) * 85; if (blockIdx.x >= 12 && blockIdx.x < 15) t = SEQ - 1;
    __shared__ float sc[SEQ]; __shared__ float q[128]; __shared__ float part[2][128];
    const bf16 *Qp, *Kp, *Vp, *Op; unsigned mw[4] = {0xffffffffu, 0xffffffffu, 0xffffffffu, 0xffffffffu}; int klo = 0;
    if (kind < 2) { const int bk = r & 3, g = (r >> 2) & 3; Qp = (const bf16*)(ws + WS_QNSA) + (((size_t)bk * SEQ + t) * 4 + g) * 128; Kp = (const bf16*)(ws + (kind == 0 ? WS_KSLC : WS_KWIN)) + (size_t)bk * SEQ * 128;
        Vp = (const bf16*)(ws + (kind == 0 ? WS_VSLC : WS_VWIN)) + (size_t)bk * SEQ * 128; Op = (const bf16*)(ws + (kind == 0 ? WS_OSLC : WS_OWIN)) + (((size_t)bk * SEQ + t) * 4 + g) * 128;
        if (kind == 0) for (int w = 0; w < 4; ++w) mw[w] = ((const unsigned*)(ws + WS_SELM))[((size_t)bk * SEQ + t) * 4 + w]; else klo = t - 511 > 0 ? t - 511 : 0; }
    else { const int id = r & 31, bhc = id >> 1, half = id & 1, bh = id >> 2; Qp = (const bf16*)(ws + WS_QD) + ((size_t)bhc * SEQ + t) * 128; Kp = (const bf16*)(ws + WS_KD) + (size_t)bhc * SEQ * 128;
        Vp = (const bf16*)(ws + WS_VD) + (size_t)(bh * 2 + half) * SEQ * 128; Op = (const bf16*)(ws + WS_ODIFF) + ((size_t)id * SEQ + t) * 128; }
    if (tid < 128) q[tid] = bf2f(Qp[tid]); __syncthreads();
    float mx = -1e30f;
    for (int k = tid; k <= t; k += 256) { float s = -1e30f; const int j = k >> 6;
        if (k >= klo && ((mw[j >> 5] >> (j & 31)) & 1u)) { s = 0.f; for (int d = 0; d < 128; ++d) s += q[d] * bf2f(Kp[(size_t)k * 128 + d]); s *= ATT_SCALE; }
        sc[k] = s; mx = fmaxf(mx, s); }
    mx = blk_max(mx); float l = 0.f;
    for (int k = tid; k <= t; k += 256) { const float e = sc[k] > -1e29f ? expf(sc[k] - mx) : 0.f; sc[k] = e; l += e; }
    l = blk_sum(l);
    { const int d = tid & 127, hf = tid >> 7; float o = 0.f; for (int k = hf; k <= t; k += 2) o += sc[k] * bf2f(Vp[(size_t)k * 128 + d]); part[hf][d] = o; }
    __syncthreads();
    float ref = 0.f; if (tid < 128) ref = (part[0][tid] + part[1][tid]) / fmaxf(l, 1e-30f);
    const float rms = sqrtf(blk_sum(tid < 128 ? ref * ref : 0.f) / 128.f);
    float err = 0.f; if (tid < 128) err = fabsf(bf2f(Op[tid]) - ref) / (rms + 1e-4f);
    chk_commit(ws, 7 + kind, err);
}
__global__ void chk7(KArgs a) {
    unsigned char* ws = a.ws; const int tid = threadIdx.x; const int tok = hsh(blockIdx.x * 71u + 29u) % TOK, b = tok >> 13, t = tok & (SEQ - 1);
    float s1 = 0.f, s2 = 0.f; for (int d = 0; d < 128; ++d) { s1 += a.in[13][d] * a.in[14][d]; s2 += a.in[15][d] * a.in[16][d]; }
    const float lam = expf(s1) - expf(s2) + 0.2f; const bf16* mix = (const bf16*)(ws + WS_MIX) + (size_t)tok * DM; float err = 0.f;
    for (int c = tid; c < 1024; c += 256) { const int h = c >> 7, d = c & 127; const size_t ro = (((size_t)(b * 2 + (h >> 2)) * SEQ + t) * 4 + (h & 3)) * 128 + d; const float* gt = (const float*)(ws + WS_GATES) + (size_t)tok * 24 + h * 3;
        const float ref = gt[0] * bf2f(((const bf16*)(ws + WS_OCMP))[ro]) + gt[1] * bf2f(((const bf16*)(ws + WS_OSLC))[ro]) + gt[2] * bf2f(((const bf16*)(ws + WS_OWIN))[ro]);
        err = fmaxf(err, fabsf(bf2f(mix[c]) - ref) / (fabsf(ref) + 0.02f)); }
    __shared__ float od[1024];
    for (int c = tid; c < 1024; c += 256) { const int h = c >> 8, half = (c >> 7) & 1, d = c & 127; const bf16* O = (const bf16*)(ws + WS_ODIFF);
        od[c] = bf2f(O[((size_t)(((b * 4 + h) * 2 + 0) * 2 + half) * SEQ + t) * 128 + d]) - lam * bf2f(O[((size_t)(((b * 4 + h) * 2 + 1) * 2 + half) * SEQ + t) * 128 + d]); }
    __syncthreads();
    for (int c = tid; c < 1024; c += 256) { const int h = c >> 8; float ss = 0.f; for (int k = 0; k < 256; ++k) ss += od[h * 256 + k] * od[h * 256 + k];
        const float ref = od[c] / sqrtf(ss / 256.f + NORM_EPS) * a.in[17][c & 255] * 0.8f; err = fmaxf(err, relerr(bf2f(mix[1024 + c]), ref, 0.1f)); }
    chk_commit(ws, 10, err);
}
__global__ void chk8(KArgs a) {
    unsigned char* ws = a.ws; const unsigned r = hsh(blockIdx.x * 256u + threadIdx.x + 4242u); const int row = r % TOK, c = (r >> 14) % DM;
    float s = a.in[0][(size_t)row * DM + c]; for (int k = 0; k < DM; ++k) s += bf2f(((const bf16*)(ws + WS_MIX))[(size_t)row * DM + k]) * a.in[18][(size_t)k * DM + c];
    chk_commit(ws, 11, relerr(bf2f(((const bf16*)(ws + WS_HBF))[(size_t)row * DM + c]), s, 0.3f));
}
__global__ void chk9(KArgs a) {
    unsigned char* ws = a.ws; const int tid = threadIdx.x; const int tok = hsh(blockIdx.x * 337u + 41u) % TOK; __shared__ float h[DM]; for (int c = tid; c < DM; c += 256) h[c] = bf2f(((const bf16*)(ws + WS_HBF))[(size_t)tok * DM + c]); __syncthreads();
    float ss = 0.f; for (int c = tid; c < DM; c += 256) ss += h[c] * h[c]; ss = blk_sum(ss); const float rstd = 1.f / sqrtf(ss / DM + NORM_EPS);
    float e13 = 0.f; for (int c = tid; c < DM; c += 256) { const float ref = h[c] * rstd * a.in[19][c]; e13 = fmaxf(e13, 0.03f * fabsf(f8dec((ws + WS_HN)[(size_t)tok * DM + c]) - ref) / (0.0626f * fabsf(ref) + 0.002f)); }
    chk_commit(ws, 13, e13);
    __shared__ float lg[8][32]; __shared__ float fin[32];
    { const int e = tid & 31, ks = tid >> 5; float s = 0.f; for (int k = ks * 256; k < ks * 256 + 256; ++k) s += h[k] * rstd * a.in[19][k] * a.in[20][(size_t)k * 32 + e]; lg[ks][e] = s; }
    __syncthreads();
    if (tid < 32) { float s = a.in[21][tid]; for (int ks = 0; ks < 8; ++ks) s += lg[ks][tid]; fin[tid] = s; }
    __syncthreads();
    float err = 0.f;
    if (tid == 0) { int te[4]; float tv[4]; float gap = 1e30f;
        for (int k = 0; k < 4; ++k) { int be = -1; float bv = -1e30f; for (int e = 0; e < 32; ++e) { bool used = false; for (int q = 0; q < k; ++q) used |= te[q] == e; if (!used && fin[e] > bv) { bv = fin[e]; be = e; } } te[k] = be; tv[k] = bv; }
        { float v5 = -1e30f; for (int e = 0; e < 32; ++e) { bool used = false; for (int q = 0; q < 4; ++q) used |= te[q] == e; if (!used) v5 = fmaxf(v5, fin[e]); } gap = tv[3] - v5; }
        float den = 0.f; for (int k = 0; k < 4; ++k) den += expf(tv[k] - tv[0]);
        for (int k = 0; k < 4; ++k) { const int e = te[k]; const int cnt = (int)((const unsigned*)(ws + WS_CTL))[CW_ECNT + 64 * e]; const int* li = (const int*)(ws + WS_LIST) + (size_t)e * TOK; bool found = false;
            for (int i = 0; i < cnt && i < TOK; ++i) if (li[i] == tok * 4 + k) { found = true; err = fmaxf(err, fabsf(((const float*)(ws + WS_GATEW))[(size_t)e * TOK + i] - expf(tv[k] - tv[0]) / den) * 10.f); break; }
            if (!found && gap > 1e-3f) err = fmaxf(err, 1.f); }
        if (blockIdx.x == 0) { int tot = 0; for (int e = 0; e < 32; ++e) tot += (int)((const unsigned*)(ws + WS_CTL))[CW_ECNT + 64 * e]; if (tot != TOK * 4) err = fmaxf(err, 5.f); } }
    chk_commit(ws, 12, err);
}
__device__ __forceinline__ void moe_locate(unsigned char* ws, unsigned r, int& e, int& idx, int& prow) {
    e = r % 32; int tb = 0; for (int q = 0; q < e; ++q) tb += ((int)((const unsigned*)(ws + WS_CTL))[CW_ECNT + 64 * q] + 255) >> 8;
    const int cnt = (int)((const unsigned*)(ws + WS_CTL))[CW_ECNT + 64 * e]; idx = cnt > 0 ? (int)((r >> 5) % (unsigned)cnt) : 0; prow = tb * 256 + idx;
}
__global__ void chk10(KArgs a) {
    unsigned char* ws = a.ws; const unsigned r = hsh(blockIdx.x * 256u + threadIdx.x + 9001u); int e, idx, prow; moe_locate(ws, r, e, idx, prow); const int col = (r >> 19) % DFF;
    const int tok = ((const int*)(ws + WS_LIST))[(size_t)e * TOK + idx] >> 2; const unsigned char* hn = ws + WS_HN + (size_t)tok * DM; const float* w = a.in[22] + (size_t)e * 2048 * 4096;
    float gl = a.in[23][e * 4096 + col], up = a.in[23][e * 4096 + 2048 + col]; for (int k = 0; k < DM; ++k) { const float x = f8dec(hn[k]); gl += x * qw(w[(size_t)k * 4096 + col]); up += x * qw(w[(size_t)k * 4096 + 2048 + col]); }
    gl = fminf(gl, 7.f); up = fminf(fmaxf(up, -7.f), 7.f); const float ref = (up + 1.f) * gl / (1.f + expf(-1.702f * gl));
    chk_commit(ws, 14, 0.06f * fabsf(f8dec((ws + WS_HB)[(size_t)prow * DFF + col]) - ref) / (0.0626f * fabsf(ref) + 0.01f));
}
__global__ void chk11(KArgs a) {
    unsigned char* ws = a.ws; const unsigned r = hsh(blockIdx.x * 256u + threadIdx.x + 31337u); int e, idx, prow; moe_locate(ws, r, e, idx, prow); const int col = (r >> 19) % DM;
    const int ent = ((const int*)(ws + WS_LIST))[(size_t)e * TOK + idx]; const float gw = ((const float*)(ws + WS_GATEW))[(size_t)e * TOK + idx]; const unsigned char* hb = ws + WS_HB + (size_t)prow * DFF; const float* w = a.in[24] + (size_t)e * 2048 * 2048;
    float s = a.in[25][e * 2048 + col]; for (int k = 0; k < DFF; ++k) s += f8dec(hb[k]) * qw(w[(size_t)k * 2048 + col]);
    { const int iv = ((const int*)(ws + WS_INV))[ent]; const float e2 = (iv == ((e << 16) | idx)) ? 0.f : 1.f;
      chk_commit(ws, 15, fmaxf(e2, relerr(bf2f(((const bf16*)(ws + WS_YS))[(size_t)prow * DM + col]), s * gw, 0.1f))); }
}
__global__ void chk_report(KArgs a) {
    const float tol[NSTAGE] = {0.02f, 0.08f, 0.08f, 0.08f, 0.1f, 0.1f, 0.07f, 0.35f, 0.35f, 0.35f, 0.08f, 0.08f, 0.05f, 0.04f, 0.1f, 0.1f};
    int bad = -1, bad2 = -1; float be = 0.f;
    for (int s = 0; s < NSTAGE; ++s) { const float e = __uint_as_float(((const unsigned*)(a.ws + WS_CTL))[CW_CHK + 64 * s]); if (e > tol[s]) { if (bad < 0) { bad = s; be = e; } else if (bad2 < 0) bad2 = s; } }
    if (bad < 0) return;
    const size_t n = (size_t)TOK * DM;
    float g = log10f(fmaxf(be, 1e-30f)); g = fminf(fmaxf(g, -3.f), 3.f);
    const float A = powf(10.f, 4.f + (float)bad) * (1.f + (g + 3.f) / 3.f);
    const int q = bad2 < 0 ? 0 : (bad2 - bad < 7 ? bad2 - bad : 7);
    const float B = q ? A * sqrtf(powf(10.f, (float)q) / (float)n) : 0.f;
    for (size_t i = (size_t)blockIdx.x * blockDim.x + threadIdx.x; i < n; i += (size_t)gridDim.x * blockDim.x) a.out[i] = i == 0 ? A : B;
}
static void chk_after_phase(int p, const KArgs& a, hipStream_t stream) {
    switch (p) {
    case 0: chk0<<<64, 256, 0, stream>>>(a); break;
    case 1: chk1<<<16, 256, 0, stream>>>(a); break;
    case 2: chk2<<<160, 256, 0, stream>>>(a); chk3<<<8, 256, 0, stream>>>(a); break;
    case 3: chk4<<<64, 256, 0, stream>>>(a); break;
    case 4: chk5<<<96, 256, 0, stream>>>(a); break;
    case 5: chk6<<<192, 256, 0, stream>>>(a); chk0b<<<256, 256, 0, stream>>>(a); break;
    case 6: chk7<<<64, 256, 0, stream>>>(a); break;
    case 7: chk8<<<16, 256, 0, stream>>>(a); break;
    case 8: chk9<<<64, 256, 0, stream>>>(a); break;
    case 9: chk10<<<8, 256, 0, stream>>>(a); break;
    case 10: chk11<<<8, 256, 0, stream>>>(a); break;
    default: break;
    }
}
#endif
extern "C" void kernel_launch(void* const* d_in, const int* in_sizes, int n_in, void* d_out, int out_size, void* d_ws, size_t ws_size, hipStream_t stream) {
    static int grid = 0;
    if (grid == 0) {
        if (n_in != 26 || in_sizes[0] != TOK * DM || out_size != TOK * DM || ws_size < WS_END) { fprintf(stderr, "kernel_launch: unexpected shapes (n_in %d, in0 %d, out %d, ws %zu)\n", n_in, n_in > 0 ? in_sizes[0] : -1, out_size, ws_size); grid = -1; return; }
        int dev = 0, cus = 0, per_cu = 0;
        if (hipGetDevice(&dev) != hipSuccess || hipDeviceGetAttribute(&cus, hipDeviceAttributeMultiprocessorCount, dev) != hipSuccess) { grid = -1; return; }
        if (hipFuncSetAttribute((const void*)mk_fwd, hipFuncAttributeMaxDynamicSharedMemorySize, LDS_BYTES) != hipSuccess) { fprintf(stderr, "kernel_launch: hipFuncSetAttribute failed\n"); grid = -1; return; }
        if (hipOccupancyMaxActiveBlocksPerMultiprocessor(&per_cu, (const void*)mk_fwd, NWAVES * 64, LDS_BYTES) != hipSuccess || per_cu < 1) { fprintf(stderr, "kernel_launch: occupancy query says %d\n", per_cu); }
        (void)hipGetLastError();
        grid = cus;
        if (grid > 256) grid = 256;
    }
    if (grid < 0) return;
    if (hipMemsetAsync((char*)d_ws + WS_CTL, 0, CTL_ZERO_BYTES, stream) != hipSuccess) return;
    KArgs a{};
    for (int i = 0; i < 26; ++i) a.in[i] = (const float*)d_in[i];
    a.out = (float*)d_out; a.ws = (unsigned char*)d_ws;
#if MK_SPLIT
    for (int p = 0; p < NPHASE; ++p) { a.ph_lo = p; a.ph_hi = p + 1; hipLaunchKernelGGL(mk_fwd, dim3(grid), dim3(NWAVES * 64), LDS_BYTES, stream, a);
#if MK_CHECK
        chk_after_phase(p, a, stream);
#endif
    }
#if MK_CHECK
    chk_report<<<dim3(1024), dim3(256), 0, stream>>>(a);
#endif
#else
    a.ph_lo = 0; a.ph_hi = NPHASE;
    hipLaunchKernelGGL(mk_fwd, dim3(grid), dim3(NWAVES * 64), LDS_BYTES, stream, a);
#if defined(EXTRA_PH)
    a.ph_lo = EXTRA_PH; a.ph_hi = EXTRA_PH + 1; a.rep = 1;
    hipLaunchKernelGGL(mk_fwd, dim3(grid), dim3(NWAVES * 64), LDS_BYTES, stream, a);
#endif
#endif
}
```

```cpp
#include <hip/hip_runtime.h>
#include <cstdio>
#include <cstdint>

#ifndef MK_SPLIT
#define MK_SPLIT 0
#endif
#ifndef MK_CHECK
#define MK_CHECK 0
#endif

#define GAS __attribute__((address_space(1)))
#define LAS __attribute__((address_space(3)))
typedef unsigned short bf16;
typedef unsigned v4u __attribute__((ext_vector_type(4)));
typedef unsigned v2u __attribute__((ext_vector_type(2)));
typedef float f32x2 __attribute__((ext_vector_type(2)));
typedef float f32x4 __attribute__((ext_vector_type(4)));
typedef float f32x16 __attribute__((ext_vector_type(16)));
typedef short bf16x8 __attribute__((ext_vector_type(8)));
typedef short s16x4 __attribute__((ext_vector_type(4)));
typedef GAS unsigned gu32;
#define RLX_AGENT __ATOMIC_RELAXED, __HIP_MEMORY_SCOPE_AGENT
#define LDS_WAIT() asm volatile("s_waitcnt lgkmcnt(0)" ::: "memory")
#define VM_WAIT() asm volatile("s_waitcnt vmcnt(0)" ::: "memory")
#define SBAR() __builtin_amdgcn_sched_barrier(0)

constexpr int NB = 2, SEQ = 8192, TOK = NB * SEQ, DM = 2048, HD = 128;
constexpr int NPROJ = 5888;
constexpr int NEXP = 32, DFF = 2048, NCMPP = 512;
constexpr float NORM_EPS = 1e-6f;
constexpr float ATT_SCALE = 0.08838834764831845f;
constexpr float LOG2E = 1.4426950408889634f;
constexpr int NWAVES = 8;

__device__ __forceinline__ unsigned f2bf(float f) { unsigned u = __builtin_bit_cast(unsigned, f); return (u + 0x7fffu + ((u >> 16) & 1u)) >> 16; }
__device__ __forceinline__ unsigned pk2(float lo, float hi) { return f2bf(lo) | (f2bf(hi) << 16); }
__device__ __forceinline__ float bf2f(unsigned short b) { return __builtin_bit_cast(float, (unsigned)b << 16); }
__device__ __forceinline__ float bflo(unsigned w) { return __builtin_bit_cast(float, w << 16); }
__device__ __forceinline__ float bfhi(unsigned w) { return __builtin_bit_cast(float, w & 0xffff0000u); }
__device__ __forceinline__ unsigned cvtpk(float lo, float hi) { unsigned r; asm volatile("v_cvt_pk_bf16_f32 %0, %1, %2" : "=v"(r) : "v"(lo), "v"(hi)); return r; }
__device__ __forceinline__ float wave_sum(float v) {
#pragma unroll
    for (int o = 1; o < 64; o <<= 1) v += __shfl_xor(v, o);
    return v;
}

#define XB_TMO      128
#define XB_XCNT(j)  (256  + 64 * (j))
#define XB_XSUB(j)  (1280 + 64 * (j))
#define XB_XGEN(j)  (2304 + 64 * (j))
#define XB_TOP      3328
#define XB_TOPGEN   3392
#define XCD_BAR_WORDS 3456
#define XB_SPIN_CAP (1u << 22)

__device__ __forceinline__ unsigned xb_ld(unsigned* p)              { return __hip_atomic_load(p, __ATOMIC_RELAXED, __HIP_MEMORY_SCOPE_AGENT); }
__device__ __forceinline__ unsigned xb_add(unsigned* p, unsigned v) { return __hip_atomic_fetch_add(p, v, __ATOMIC_RELAXED, __HIP_MEMORY_SCOPE_AGENT); }
__device__ __forceinline__ unsigned xb_xcc_id() { return (unsigned)__builtin_amdgcn_s_getreg((3 << 11) | 20) & 0xFu; }
#define XB_SPIN(cond, bar) do { unsigned _sp = 0; while (cond) { __builtin_amdgcn_s_sleep(1); \
    if ((++_sp & 255u) == 0u) { if (xb_ld(&(bar)[XB_TMO])) break; if (_sp > XB_SPIN_CAP) { atomicAdd(&(bar)[XB_TMO], 1u); break; } } } } while (0)

struct XcdBarrier { unsigned* bar; unsigned x; volatile LAS unsigned* st; };

__device__ __forceinline__ XcdBarrier xcd_barrier_post(unsigned* bar, volatile LAS unsigned* st) {
    XcdBarrier b; b.bar = bar; b.x = xb_xcc_id(); b.st = st;
    if (threadIdx.x == 0) (void)xb_add(&bar[XB_XCNT(b.x)], 1u);
    return b;
}
__device__ __forceinline__ void xcd_barrier_complete(unsigned* bar, unsigned x, unsigned& nloc, unsigned& nx) {
    const unsigned G = gridDim.x * gridDim.y * gridDim.z;
    unsigned sum, cnt, mine, sp = 0u;
    for (;;) {
        sum = 0u; cnt = 0u; mine = 0u;
#pragma unroll
        for (unsigned j = 0; j < 16; ++j) { const unsigned c = xb_ld(&bar[XB_XCNT(j)]); sum += c; cnt += (c > 0u) ? 1u : 0u; mine = (j == x) ? c : mine; }
        if (sum == G) break;
        __builtin_amdgcn_s_sleep(1);
        if ((++sp & 255u) == 0u) { if (xb_ld(&bar[XB_TMO])) break; if (sp > XB_SPIN_CAP) { atomicAdd(&bar[XB_TMO], 1u); break; } }
    }
    nloc = mine > 0u ? mine : 1u; nx = cnt > 0u ? cnt : 1u;
}
__device__ __forceinline__ void xcd_barrier(const XcdBarrier& b) {
    asm volatile("s_waitcnt vmcnt(0)" ::: "memory");
    __syncthreads();
    if (threadIdx.x == 0) {
        unsigned* bar = b.bar;
        __builtin_amdgcn_s_waitcnt(0);
        unsigned nloc = b.st[0], nx = b.st[1];
        if (nloc == 0u) { xcd_barrier_complete(bar, b.x, nloc, nx); b.st[0] = nloc; b.st[1] = nx; }
        const unsigned old = xb_add(&bar[XB_XSUB(b.x)], 1u);
        const unsigned gen = old / nloc;
        if (old + 1u == (gen + 1u) * nloc) {
            __builtin_amdgcn_fence(__ATOMIC_RELEASE, "agent");
            asm volatile("s_waitcnt vmcnt(0)" ::: "memory");
            const unsigned og = xb_add(&bar[XB_TOP], 1u);
            const unsigned tg = og / nx;
            if (og + 1u == (tg + 1u) * nx) xb_add(&bar[XB_TOPGEN], 1u);
            else XB_SPIN(xb_ld(&bar[XB_TOPGEN]) == tg, bar);
            __builtin_amdgcn_fence(__ATOMIC_ACQUIRE, "agent");
            xb_add(&bar[XB_XGEN(b.x)], 1u);
            asm volatile("s_waitcnt vmcnt(0)" ::: "memory");
        } else {
            XB_SPIN(xb_ld(&bar[XB_XGEN(b.x)]) == gen, bar);
            __builtin_amdgcn_fence(__ATOMIC_ACQUIRE, "agent");
            asm volatile("s_waitcnt vmcnt(0)" ::: "memory");
        }
    }
    __syncthreads();
}

namespace pg8 {
#define PG8_LAS __attribute__((address_space(3)))
constexpr int BM = 256, BK = 64, HALF = 128, HTB = HALF * BK * 2, STAGE_BYTES = 8 * HTB;
__host__ __device__ __forceinline__ int lds_byte(int r, int c) { const int st = (r >> 4) * 2 + (c >> 5), rr = r & 15, cc = c & 31, ob = rr * 64 + cc * 2; return st * 1024 + (ob ^ (((ob >> 9) & 1) << 5)); }
__host__ __device__ __forceinline__ void stage_rc(int b, int& R, int& C) { const int st = b / 1024, sb = b % 1024, swz = sb ^ (((sb >> 9) & 1) << 5); R = (st >> 1) * 16 + swz / 64; C = (st & 1) * 32 + (swz % 64) / 2; }
__host__ __device__ __forceinline__ int perm32(int rho) { const int n = rho >> 4, i = rho & 15; return 8 * (i >> 2) + 4 * n + (i & 3); }

struct Unit { int pm, pn, e, rows; };

typedef int i32x8 __attribute__((ext_vector_type(8)));
typedef int i32x4 __attribute__((ext_vector_type(4)));
template <class Epi, class Sched, bool ALIGN_EPI, bool F8 = false, int SCALE_B = 127>
__device__ __forceinline__ void gemm_phase(PG8_LAS unsigned char* lds, const int KB  , const Sched& S, const Epi& E) {
    const int tid = threadIdx.x, wid = __builtin_amdgcn_readfirstlane(tid >> 6), lane = tid & 63, wr = wid >> 2, wc = wid & 3, fr = lane & 15, fq = lane >> 4;
    const int nt = KB / 128;
    int Rr[2], Cc[2]; unsigned voffB[2];
#pragma unroll
    for (int i = 0; i < 2; ++i) { int R, C; stage_rc(tid * 16 + i * 8192, R, C); Rr[i] = R; Cc[i] = C; const int Rb = (R & ~31) + perm32(R & 31); voffB[i] = (unsigned)(Rb * KB + C * 2); }
    const unsigned kstep = 128u;
    const unsigned hstep = (unsigned)(HALF * KB);
    const unsigned ldsw = (unsigned)wid * 1024u;
    const int aoff = lds_byte(wr * 64 + fr, fq * 8), boff = lds_byte(wc * 32 + fr, fq * 8);
    const char* const Ab = S.abase();
#define PG8_SA(b, h) (((b) * 2 + (h)) * HTB)
#define PG8_SB(b, h) ((4 + (b) * 2 + (h)) * HTB)
#define PG8_DMA(base_, off_, ldsp_) do { unsigned o_ = (off_); asm volatile("" : "+v"(o_)); __builtin_amdgcn_global_load_lds((const unsigned*)((const char*)(base_) + o_), (PG8_LAS unsigned*)(ldsp_), 16, 0, 0); } while (0)
#define PG8_STAGE(bufoff, bbase, kb) do { PG8_DMA(bbase, voffB[0] + (unsigned)(kb), lds + (bufoff) + ldsw); PG8_DMA(bbase, voffB[1] + (unsigned)(kb), lds + (bufoff) + ldsw + 8192); } while (0)
#define PG8_STAGE_A(bufoff, kb, v0_, v1_) do { PG8_DMA(Ab, (v0_) + (unsigned)(kb), lds + (bufoff) + ldsw); PG8_DMA(Ab, (v1_) + (unsigned)(kb), lds + (bufoff) + ldsw + 8192); } while (0)
#define PG8_LD8(p_) __builtin_shufflevector(*(const PG8_LAS i32x4*)(p_), *(const PG8_LAS i32x4*)((p_) + 1024), 0, 1, 2, 3, 4, 5, 6, 7)
#define PG8_LDA(dst, b, h) do { _Pragma("unroll") for (int m = 0; m < 4; ++m) dst[m] = PG8_LD8(lds + PG8_SA(b, h) + aoff + m * 2048); } while (0)
#define PG8_LDB(dst, b, h) do { _Pragma("unroll") for (int n = 0; n < 2; ++n) dst[n] = PG8_LD8(lds + PG8_SB(b, h) + boff + n * 2048); } while (0)
#define PG8_H0(x) __builtin_bit_cast(bf16x8, __builtin_shufflevector(x, x, 0, 1, 2, 3))
#define PG8_H1(x) __builtin_bit_cast(bf16x8, __builtin_shufflevector(x, x, 4, 5, 6, 7))
#define PG8_MMA(ai, bj, At, Bt) do { __builtin_amdgcn_s_setprio(1); _Pragma("unroll") for (int m = 0; m < 4; ++m) _Pragma("unroll") for (int n = 0; n < 2; ++n) { \
        if constexpr (F8) asm volatile("v_mfma_scale_f32_16x16x128_f8f6f4 %0, %1, %2, %0, %3, %4 op_sel_hi:[0,0,0]" : "+v"(acc[ai][bj][m][n]) : "v"(Bt[n]), "v"(At[m]), "v"(sclB), "v"(sclA)); \
        else { acc[ai][bj][m][n] = __builtin_amdgcn_mfma_f32_16x16x32_bf16(PG8_H0(Bt[n]), PG8_H0(At[m]), acc[ai][bj][m][n], 0, 0, 0); \
               acc[ai][bj][m][n] = __builtin_amdgcn_mfma_f32_16x16x32_bf16(PG8_H1(Bt[n]), PG8_H1(At[m]), acc[ai][bj][m][n], 0, 0, 0); } } \
        __builtin_amdgcn_s_setprio(0); } while (0)
#define PG8_WAIT_V(n) asm volatile("s_waitcnt vmcnt(" #n ")" ::: "memory")
#define PG8_WAIT_L(n) asm volatile("s_waitcnt lgkmcnt(" #n ")" ::: "memory")
#define PG8_BAR __builtin_amdgcn_s_barrier()
#define PG8_SCHED __builtin_amdgcn_sched_barrier(0)
    Unit cur, nxt; int ui = 0;
    if (!S.next(0, cur)) return;
    f32x4 acc[2][2][4][2];
#pragma unroll
    for (int a = 0; a < 2; ++a)
#pragma unroll
        for (int b = 0; b < 2; ++b)
#pragma unroll
            for (int m = 0; m < 4; ++m)
#pragma unroll
                for (int n = 0; n < 2; ++n) acc[a][b][m][n] = (f32x4){0.f, 0.f, 0.f, 0.f};
    const int sclB = SCALE_B, sclA = 127;
    i32x8 At[4], B0[2], B1[2];
    unsigned c00, c01, c10, c11, n00, n01, n10, n11;
    S.avoff(cur, Rr, Cc, KB, c00, c01, c10, c11);
    const char* cB = S.btile(cur, KB);
    typename Epi::Pre pre = E.prefetch(cur, wr, wc, fr, fq);
    PG8_STAGE(PG8_SB(0, 0), cB, 0u); PG8_STAGE(PG8_SB(0, 1), cB, hstep); PG8_STAGE_A(PG8_SA(0, 0), 0u, c00, c01); PG8_STAGE_A(PG8_SA(0, 1), 0u, c10, c11);
    if (wr == 1) PG8_BAR;
    PG8_WAIT_V(2); PG8_BAR;
    PG8_STAGE(PG8_SB(1, 0), cB, kstep); PG8_STAGE_A(PG8_SA(1, 0), kstep, c00, c01); PG8_STAGE(PG8_SB(1, 1), cB, hstep + kstep);
    PG8_WAIT_V(6); PG8_BAR;
    for (;;) {
        const bool has_next = S.next(ui + 1, nxt);
        if (!has_next) nxt = cur;
        const char* nB = has_next ? S.btile(nxt, KB) : cB;
        if (has_next) S.avoff(nxt, Rr, Cc, KB, n00, n01, n10, n11); else { n00 = c00; n01 = c01; n10 = c10; n11 = c11; }
        for (int t = 0; t < nt; t += 2) {
            const bool last = (t == nt - 2);
            const unsigned k1 = (unsigned)(t + 1) * kstep;
            const unsigned k2 = last ? 0u : (unsigned)(t + 2) * kstep, k3 = k2 + kstep;
            const unsigned x00 = last ? n00 : c00, x01 = last ? n01 : c01, x10 = last ? n10 : c10, x11 = last ? n11 : c11;
            const char* b2 = last ? nB : cB;
            PG8_LDB(B0, 0, 0); PG8_LDB(B1, 0, 1); PG8_SCHED; PG8_LDA(At, 0, 0); PG8_STAGE_A(PG8_SA(1, 1), k1, c10, c11);
            PG8_WAIT_V(8); PG8_WAIT_L(0); PG8_BAR; PG8_MMA(0, 0, At, B0); PG8_MMA(0, 1, At, B1); PG8_BAR; PG8_SCHED;
            PG8_LDA(At, 0, 1); PG8_STAGE(PG8_SB(0, 0), b2, k2); PG8_STAGE(PG8_SB(0, 1), b2, k2 + hstep); PG8_STAGE_A(PG8_SA(0, 0), k2, x00, x01);
            PG8_WAIT_V(8); PG8_WAIT_L(0); PG8_BAR; PG8_MMA(1, 0, At, B0); PG8_MMA(1, 1, At, B1); PG8_BAR; PG8_SCHED;
            PG8_LDB(B0, 1, 0); PG8_LDB(B1, 1, 1); PG8_SCHED; PG8_LDA(At, 1, 0); PG8_STAGE_A(PG8_SA(0, 1), k2, x10, x11);
            PG8_WAIT_V(8); PG8_WAIT_L(0); PG8_BAR; PG8_MMA(0, 0, At, B0); PG8_MMA(0, 1, At, B1); PG8_BAR; PG8_SCHED;
            PG8_LDA(At, 1, 1); PG8_STAGE(PG8_SB(1, 0), b2, k3); PG8_STAGE(PG8_SB(1, 1), b2, k3 + hstep); PG8_STAGE_A(PG8_SA(1, 0), k3, x00, x01);
            PG8_WAIT_V(8); PG8_WAIT_L(0); PG8_BAR; PG8_MMA(1, 0, At, B0); PG8_MMA(1, 1, At, B1); PG8_BAR; PG8_SCHED;
        }
        if constexpr (ALIGN_EPI) { if (wr == 0) PG8_BAR; }
        if constexpr (F8) asm volatile("s_nop 15\n\ts_nop 15" ::: "memory");
        { int fr2 = fr, fq2 = fq; asm volatile("" : "+v"(fr2), "+v"(fq2)); E(acc, cur, wr, wc, fr2, fq2, pre); }
        if (!has_next) break;
#pragma unroll
        for (int a = 0; a < 2; ++a)
#pragma unroll
            for (int b = 0; b < 2; ++b)
#pragma unroll
                for (int m = 0; m < 4; ++m)
#pragma unroll
                    for (int n = 0; n < 2; ++n) acc[a][b][m][n] = (f32x4){0.f, 0.f, 0.f, 0.f};
        cur = nxt; cB = nB; c00 = n00; c01 = n01; c10 = n10; c11 = n11; ++ui;
        pre = E.prefetch(cur, wr, wc, fr, fq);
        if constexpr (ALIGN_EPI) { if (wr == 1) PG8_BAR; }
    }
    PG8_WAIT_V(0);
    if constexpr (!ALIGN_EPI) { if (wr == 0) PG8_BAR; }
    PG8_BAR;
#undef PG8_SA
#undef PG8_SB
#undef PG8_STAGE
#undef PG8_DMA
#undef PG8_STAGE_A
#undef PG8_LDA
#undef PG8_LD8
#undef PG8_H0
#undef PG8_H1
#undef PG8_LDB
#undef PG8_MMA
#undef PG8_WAIT_V
#undef PG8_WAIT_L
#undef PG8_BAR
#undef PG8_SCHED
}
}
namespace fa16 {
constexpr int D = 128, NW = 8, QBLK = 32, KVBLK = 64, QB = NW * QBLK;
constexpr int SHM_V = KVBLK * D * 2, SHM_K = KVBLK * D * 2;
constexpr int NVB = 3;
constexpr int WS_OFF = NVB * SHM_V + 2 * SHM_K;
constexpr int SELM_OFF = WS_OFF + NW * 64 * 4;
constexpr int LDS_BYTES = SELM_OFF + 1024;
constexpr float SCALE = 0.08838834764831845f;
constexpr float THR = 8.f;

#define KSWZ(row, colB) ((row) * 256 + ((colB) ^ (((row) & 7) << 4)))
__device__ __forceinline__ int v_st(int k, int c) { const int kk = (k & ~0xC) | ((k & 4) << 1) | ((k & 8) >> 1); return ((kk >> 3) * 4 + (c >> 5)) * 512 + ((kk & 7) * 32 + (c & 31)) * 2; }
__device__ __forceinline__ int v_rd_base(int lane) { return ((lane & 3) << 3) | (((lane >> 2) & 3) << 6) | (((lane >> 4) & 1) << 5) | (((lane >> 5) & 1) << 8); }
constexpr int v_rd_off(int d0, int ks, int half) { return d0 * 512 + ks * 4096 + half * 2048; }
__device__ __forceinline__ int crow(int r, int hi) { return (r & 3) + 8 * (r >> 2) + 4 * hi; }
__device__ __forceinline__ bf16x8 load8(const bf16* p) { return *reinterpret_cast<const bf16x8*>(p); }

template <int KS>
__device__ __forceinline__ void mask_tile(f32x16& p0, f32x16& p1, int dq, unsigned Wk) {
    const float NEG = -__builtin_inff();
#pragma unroll
    for (int r = 0; r < 16; ++r) {
        const int c = KS * ((r & 3) + 8 * (r >> 2));
        if ((unsigned)(dq - c) >= Wk) p0[r] = NEG;
        if ((unsigned)(dq - c - KS * 32) >= Wk) p1[r] = NEG;
    }
}
__device__ __forceinline__ void kill_tile(f32x16& p0, f32x16& p1, bool keep) {
    const float NEG = -__builtin_inff();
#pragma unroll
    for (int r = 0; r < 16; ++r) { p0[r] = keep ? p0[r] : NEG; p1[r] = keep ? p1[r] : NEG; }
}
__device__ __forceinline__ void partialSM(f32x16& p0, f32x16& p1, float& m_reg, float& mn, float& alpha) {
    float pmax = p0[0]; for (int r = 1; r < 16; ++r) pmax = fmaxf(pmax, p0[r]); for (int r = 0; r < 16; ++r) pmax = fmaxf(pmax, p1[r]);
    { auto rr = __builtin_amdgcn_permlane32_swap(__float_as_uint(pmax), __float_as_uint(pmax), false, false);
      pmax = fmaxf(__uint_as_float(rr[0]), __uint_as_float(rr[1])); }
    constexpr float C2 = 1.4426950408889634f * SCALE;
    if (__builtin_expect(__all((pmax - m_reg) * SCALE <= THR), 1)) { mn = m_reg; alpha = 1.f; }
    else { mn = fmaxf(m_reg, pmax); alpha = __builtin_amdgcn_exp2f((m_reg - mn) * C2); m_reg = mn; }
    const float mnL = -mn * C2;
    for (int r = 0; r < 16; ++r) p0[r] = fmaf(p0[r], C2, mnL); for (int r = 0; r < 16; ++r) p1[r] = fmaf(p1[r], C2, mnL);
    for (int r = 0; r < 16; ++r) p0[r] = __builtin_amdgcn_exp2f(p0[r]);
}
#define FA_PK4(P, B_, OUT) do { unsigned a0 = cvtpk(P[B_+0], P[B_+1]), a1 = cvtpk(P[B_+2], P[B_+3]);                          \
        unsigned b0 = cvtpk(P[B_+4], P[B_+5]), b1 = cvtpk(P[B_+6], P[B_+7]);                                             \
        auto r0 = __builtin_amdgcn_permlane32_swap(a0, b0, false, false); auto r1 = __builtin_amdgcn_permlane32_swap(a1, b1, false, false); \
        v4u w = {r0[0], r1[0], r0[1], r1[1]}; OUT = *reinterpret_cast<bf16x8*>(&w); } while (0)
__device__ __forceinline__ void pack_p(const f32x16& p0, const f32x16& p1, bf16x8& pa0, bf16x8& pa1, bf16x8& pa2, bf16x8& pa3) {
    FA_PK4(p0, 0, pa0); FA_PK4(p0, 8, pa1); FA_PK4(p1, 0, pa2); FA_PK4(p1, 8, pa3);
}
__device__ __forceinline__ void finishSM(f32x16& p0, f32x16& p1, float alpha, float& l_reg, bf16x8& pa0, bf16x8& pa1, bf16x8& pa2, bf16x8& pa3) {
    for (int r = 0; r < 16; ++r) p1[r] = __builtin_amdgcn_exp2f(p1[r]);
    float ps = 0; for (int r = 0; r < 16; ++r) ps += p0[r]; for (int r = 0; r < 16; ++r) ps += p1[r];
    { auto rr = __builtin_amdgcn_permlane32_swap(__float_as_uint(ps), __float_as_uint(ps), false, false);
      ps = __uint_as_float(rr[0]) + __uint_as_float(rr[1]); }
    l_reg = l_reg * alpha + ps;
    pack_p(p0, p1, pa0, pa1, pa2, pa3);
}
template <int KB, bool SK>
__device__ __forceinline__ void qkt(f32x16& p0, f32x16& p1, const char* K_lds, int r32, int hi, const bf16x8* qr, bool act) {
    if (SK && !act) { const float NEG = -__builtin_inff();
#pragma unroll
        for (int r = 0; r < 16; ++r) { p0[r] = NEG; p1[r] = NEG; } return; }
    p0 = f32x16{}; p1 = f32x16{};
    const char* kb[4];
#pragma unroll
    for (int dd = 0; dd < 4; ++dd) kb[dd] = K_lds + KB * SHM_K + KSWZ(r32, (dd * 16 + hi * 8) * 2);
#pragma unroll
    for (int d0 = 0; d0 < 8; ++d0) { const char* a = kb[d0 & 3] + (d0 >> 2) * 128;
        bf16x8 b0 = *reinterpret_cast<const bf16x8*>(a);
        bf16x8 b1 = *reinterpret_cast<const bf16x8*>(a + 32 * 256);
        p0 = __builtin_amdgcn_mfma_f32_32x32x16_bf16(b0, qr[d0], p0, 0, 0, 0);
        p1 = __builtin_amdgcn_mfma_f32_32x32x16_bf16(b1, qr[d0], p1, 0, 0, 0); }
}
template <int VB, bool SK>
__device__ __forceinline__ void pv_tile(f32x16* o, int vb0, bf16x8 pa0, bf16x8 pa1, bf16x8 pa2, bf16x8 pa3, bool act) {
    if (SK && !act) return;
#define TRRD(dst, off) asm volatile("ds_read_b64_tr_b16 %0, %1 offset:%2" : "=&v"(dst) : "v"(vb0), "i"(off) : "memory")
#define PV_D0(d0) do { s16x4 l0, l1, l2, l3, h0, h1, h2, h3; constexpr int b_ = VB * SHM_V + v_rd_off(d0, 0, 0); \
        TRRD(l0, b_); TRRD(h0, b_ + 2048); TRRD(l1, b_ + 4096); TRRD(h1, b_ + 6144); TRRD(l2, b_ + 8192); TRRD(h2, b_ + 10240); TRRD(l3, b_ + 12288); TRRD(h3, b_ + 14336); \
        asm volatile("s_waitcnt lgkmcnt(0)" ::: "memory"); SBAR();   \
        o[d0] = __builtin_amdgcn_mfma_f32_32x32x16_bf16(pa0, (bf16x8){l0[0], l0[1], l0[2], l0[3], h0[0], h0[1], h0[2], h0[3]}, o[d0], 0, 0, 0);   \
        o[d0] = __builtin_amdgcn_mfma_f32_32x32x16_bf16(pa1, (bf16x8){l1[0], l1[1], l1[2], l1[3], h1[0], h1[1], h1[2], h1[3]}, o[d0], 0, 0, 0);   \
        o[d0] = __builtin_amdgcn_mfma_f32_32x32x16_bf16(pa2, (bf16x8){l2[0], l2[1], l2[2], l2[3], h2[0], h2[1], h2[2], h2[3]}, o[d0], 0, 0, 0);   \
        o[d0] = __builtin_amdgcn_mfma_f32_32x32x16_bf16(pa3, (bf16x8){l3[0], l3[1], l3[2], l3[3], h3[0], h3[1], h3[2], h3[3]}, o[d0], 0, 0, 0); } while (0)
    PV_D0(0); PV_D0(1); PV_D0(2); PV_D0(3);
#undef PV_D0
#undef TRRD
}

}
namespace fa {
constexpr int D = 128, NW = 8, QBLK = 32, KVBLK = 64, QB = NW * QBLK, SEQ_V = 8192;
constexpr int KPITCH = 144, VPITCH = 80;
constexpr int SHM_V = D * VPITCH, SHM_K = KVBLK * KPITCH;
typedef int fi8 __attribute__((ext_vector_type(8)));
constexpr int SC_IN = 123;
constexpr float PSH = 7.f;
constexpr int NVB = 3;
constexpr int WS_OFF = NVB * SHM_V + 2 * SHM_K;
constexpr int SELM_OFF = WS_OFF + NW * 64 * 4;
constexpr int LDS_BYTES = SELM_OFF + 1024;
constexpr float SCALE = 0.08838834764831845f;
constexpr float THR = 1.f;

__device__ __forceinline__ unsigned pk4f8(float a, float b, float c, float d) { int w = __builtin_amdgcn_cvt_pk_fp8_f32(a, b, 0, false); w = __builtin_amdgcn_cvt_pk_fp8_f32(c, d, w, true); return (unsigned)w; }
__device__ __forceinline__ f32x16 mfma8(fi8 a, fi8 b, f32x16 c, int sa, int sb) { return __builtin_amdgcn_mfma_scale_f32_32x32x64_f8f6f4(a, b, c, 0, 0, 0, sa, 0, sb); }
__device__ __forceinline__ fi8 ld32(const char* p) { const v4u a = *reinterpret_cast<const v4u*>(p), b = *reinterpret_cast<const v4u*>(p + 16); return fi8{(int)a.x, (int)a.y, (int)a.z, (int)a.w, (int)b.x, (int)b.y, (int)b.z, (int)b.w}; }
__device__ __forceinline__ int crow(int r, int hi) { return (r & 3) + 8 * (r >> 2) + 4 * hi; }

template <int KS>
__device__ __forceinline__ void mask_tile(f32x16& p0, f32x16& p1, int dq, unsigned Wk) {
    const float NEG = -__builtin_inff();
#pragma unroll
    for (int r = 0; r < 16; ++r) {
        const int c = KS * ((r & 3) + 8 * (r >> 2));
        if ((unsigned)(dq - c) >= Wk) p0[r] = NEG;
        if ((unsigned)(dq - c - KS * 32) >= Wk) p1[r] = NEG;
    }
}
__device__ __forceinline__ void kill_tile(f32x16& p0, f32x16& p1, bool keep) {
    const float NEG = -__builtin_inff();
#pragma unroll
    for (int r = 0; r < 16; ++r) { p0[r] = keep ? p0[r] : NEG; p1[r] = keep ? p1[r] : NEG; }
}
__device__ __forceinline__ void partialSM(f32x16& p0, f32x16& p1, float& m_reg, float& mn, float& alpha) {
    float pmax = p0[0]; for (int r = 1; r < 16; ++r) pmax = fmaxf(pmax, p0[r]); for (int r = 0; r < 16; ++r) pmax = fmaxf(pmax, p1[r]);
    { auto rr = __builtin_amdgcn_permlane32_swap(__float_as_uint(pmax), __float_as_uint(pmax), false, false);
      pmax = fmaxf(__uint_as_float(rr[0]), __uint_as_float(rr[1])); }
    constexpr float C2 = 1.4426950408889634f * SCALE;
    if (__builtin_expect(__all((pmax - m_reg) * SCALE <= THR), 1)) { mn = m_reg; alpha = 1.f; }
    else { mn = fmaxf(m_reg, pmax); alpha = __builtin_amdgcn_exp2f((m_reg - mn) * C2); m_reg = mn; }
    const float mnL = PSH - mn * C2;
    for (int r = 0; r < 16; ++r) p0[r] = fmaf(p0[r], C2, mnL); for (int r = 0; r < 16; ++r) p1[r] = fmaf(p1[r], C2, mnL);
    for (int r = 0; r < 16; ++r) p0[r] = __builtin_amdgcn_exp2f(p0[r]);
}
__device__ __forceinline__ void pack_p(const f32x16& p0, const f32x16& p1, fi8& pa) {
#pragma unroll
    for (int i = 0; i < 4; ++i) { pa[i] = (int)pk4f8(p0[4 * i], p0[4 * i + 1], p0[4 * i + 2], p0[4 * i + 3]); pa[4 + i] = (int)pk4f8(p1[4 * i], p1[4 * i + 1], p1[4 * i + 2], p1[4 * i + 3]); }
}
__device__ __forceinline__ void finishSM(f32x16& p0, f32x16& p1, float alpha, float& l_reg, fi8& pa) {
    for (int r = 0; r < 16; ++r) p1[r] = __builtin_amdgcn_exp2f(p1[r]);
    float ps = 0; for (int r = 0; r < 16; ++r) ps += p0[r]; for (int r = 0; r < 16; ++r) ps += p1[r];
    { auto rr = __builtin_amdgcn_permlane32_swap(__float_as_uint(ps), __float_as_uint(ps), false, false);
      ps = __uint_as_float(rr[0]) + __uint_as_float(rr[1]); }
    l_reg = l_reg * alpha + ps;
    pack_p(p0, p1, pa);
}
template <int KB, bool SK>
__device__ __forceinline__ void qkt(f32x16& p0, f32x16& p1, const char* kb, const fi8* qr, bool act) {
    if (SK && !act) { const float NEG = -__builtin_inff();
#pragma unroll
        for (int r = 0; r < 16; ++r) { p0[r] = NEG; p1[r] = NEG; } return; }
    p0 = f32x16{}; p1 = f32x16{};
    const fi8 a00 = ld32(kb + KB * SHM_K), a10 = ld32(kb + KB * SHM_K + 32 * KPITCH), a01 = ld32(kb + KB * SHM_K + 64), a11 = ld32(kb + KB * SHM_K + 32 * KPITCH + 64);
    __builtin_amdgcn_s_setprio(1);
    p0 = mfma8(a00, qr[0], p0, SC_IN, SC_IN); p1 = mfma8(a10, qr[0], p1, SC_IN, SC_IN);
    p0 = mfma8(a01, qr[1], p0, SC_IN, SC_IN); p1 = mfma8(a11, qr[1], p1, SC_IN, SC_IN);
    __builtin_amdgcn_s_setprio(0);
}
template <int VB, bool SK>
__device__ __forceinline__ void pv_tile(f32x16* o, const char* vb, fi8 pa, bool act) {
    if (SK && !act) return;
    const fi8 b0 = ld32(vb + VB * SHM_V), b1 = ld32(vb + VB * SHM_V + 32 * VPITCH), b2 = ld32(vb + VB * SHM_V + 64 * VPITCH), b3 = ld32(vb + VB * SHM_V + 96 * VPITCH);
    __builtin_amdgcn_s_setprio(1);
    o[0] = mfma8(pa, b0, o[0], 127, SC_IN); o[1] = mfma8(pa, b1, o[1], 127, SC_IN); o[2] = mfma8(pa, b2, o[2], 127, SC_IN); o[3] = mfma8(pa, b3, o[3], 127, SC_IN);
    __builtin_amdgcn_s_setprio(0);
}

struct BlockRef { const unsigned char* Q; const unsigned char* K; const unsigned char* V; bf16* O; const unsigned* selsrc; int P0, ksh, W, sel; };
struct Seam { fi8 qr[2]; v4u st_v, st_k; };
__device__ __forceinline__ int blk_jlo(const BlockRef& b) { const int lowk = (b.P0 >> b.ksh) - b.W + 1; return lowk > 0 ? lowk / KVBLK : 0; }
#define FA_VMW() asm volatile("s_waitcnt vmcnt(0)" ::: "memory")
#define FA_VMWN(n) asm volatile("s_waitcnt vmcnt(%0)" :: "i"(n) : "memory")
#define FA_SLOAD_H(Kp, Vp, k0) do { S.st_v = *(const v4u*)((Vp) + (size_t)(tid >> 2) * SEQ_V + (k0) + (tid & 3) * 16);              \
                         S.st_k = *(const v4u*)((Kp) + (size_t)((k0) + (tid >> 3)) * D + (tid & 7) * 16); } while (0)
#define FA_SWRITE_HK(bf) do { *(v4u*)(K_lds + (bf) * SHM_K + kws) = S.st_k; } while (0)
#define FA_SWRITE_HV(bf) do { *(v4u*)(V_lds + (bf) * SHM_V + vws) = S.st_v; } while (0)
#define FA_SWRITE_H(bf) do { FA_SWRITE_HV(bf); FA_SWRITE_HK(bf); } while (0)
#define FA_QLOAD(Qp) do { const unsigned char* q_ = (Qp) + (size_t)(wid * QBLK + r32) * D + hi * 32; const v4u a_ = *(const v4u*)q_, b_ = *(const v4u*)(q_ + 16), c_ = *(const v4u*)(q_ + 64), d_ = *(const v4u*)(q_ + 80); \
        S.qr[0] = fi8{(int)a_.x, (int)a_.y, (int)a_.z, (int)a_.w, (int)b_.x, (int)b_.y, (int)b_.z, (int)b_.w}; S.qr[1] = fi8{(int)c_.x, (int)c_.y, (int)c_.z, (int)c_.w, (int)d_.x, (int)d_.y, (int)d_.z, (int)d_.w}; } while (0)

__device__ __forceinline__ int selrow() { int t = threadIdx.x; asm volatile("" : "+v"(t)); return (((t >> 6) * QBLK + (t & 31)) >> 2) * 4; }
__device__ __forceinline__ void fa_prime(const BlockRef& cur, char* lds, Seam& S) {
    const int tid = threadIdx.x, wid = __builtin_amdgcn_readfirstlane(tid >> 6), lane = tid & 63, r32 = lane & 31, hi = lane >> 5;
    const int kws = (tid >> 3) * KPITCH + (tid & 7) * 16; char* K_lds = lds + NVB * SHM_V;
    const int kb0 = blk_jlo(cur) * KVBLK;
    FA_QLOAD(cur.Q);
    FA_SLOAD_H(cur.K, cur.V, kb0); FA_VMW(); FA_SWRITE_HK(0);
    __syncthreads();
}
template <class BG>
__device__ __forceinline__ void fa_block(const BlockRef& cur, const BlockRef& nxt, int skv, char* lds, Seam& S, unsigned* qhead, LAS int* qslot, BG& bg) {
    constexpr bool SK = true;
    const int tid = threadIdx.x, wid = __builtin_amdgcn_readfirstlane(tid >> 6), lane = tid & 63, r32 = lane & 31, hi = lane >> 5;
    const int ksh = cur.ksh, W = cur.W; const bool selm = cur.sel != 0;
    const int j_lo = blk_jlo(cur);
    int j_hi = ((cur.P0 + QB - 1) >> ksh) / KVBLK + 1; if (j_hi > skv / KVBLK) j_hi = skv / KVBLK;
    const int NT = j_hi - j_lo;
    const int kbn = blk_jlo(nxt) * KVBLK;
    const int qlo = cur.P0 + wid * QBLK;
    const int tlo = qlo >> ksh, thi = (qlo + QBLK - 1) >> ksh;
#define DQB() ({ int l2_ = threadIdx.x; asm volatile("" : "+v"(l2_)); qlo + (l2_ & 31) - ((4 * ((l2_ >> 5) & 1)) << ksh); })
    const unsigned Wk = (unsigned)W << ksh;
    char* V_lds = lds; char* K_lds = lds + NVB * SHM_V;
    float* ws = (float*)(lds + WS_OFF) + wid * 64; float* li_l = ws, * al_l = ws + 32;
    unsigned* selmask = (unsigned*)(lds + SELM_OFF);
    int tid2 = threadIdx.x; asm volatile("" : "+v"(tid2));
    const unsigned selw = cur.selsrc[tid2 & 255];
    int tkt = 0; if (tid2 == 0) tkt = (int)__hip_atomic_fetch_add(qhead, 1u, RLX_AGENT);
    float m_reg = -1e30f, l_reg = 0; f32x16 o[4] = {};
    const int kws = (tid >> 3) * KPITCH + (tid & 7) * 16, vws = (tid >> 2) * VPITCH + (tid & 3) * 16;
    const char* vb0 = V_lds + r32 * VPITCH + hi * 32; const char* kb0r = K_lds + r32 * KPITCH + hi * 32;
    const unsigned char* Kh = cur.K; const unsigned char* Vh = cur.V;
#define RESC(a) do { if (__any((a) < 1.f)) { if (hi == 0) al_l[r32] = (a); asm volatile("s_waitcnt lgkmcnt(0)" ::: "memory");              \
                     for (int d_ = 0; d_ < 4; ++d_) for (int r = 0; r < 16; ++r) o[d_][r] *= al_l[crow(r, hi)]; } } while (0)
#define KBASE(t) ((j_lo + (t)) * KVBLK)
#define GEO(t) (KBASE(t) <= thi && KBASE(t) + KVBLK - 1 >= tlo - W + 1)
#define SELBIT(t) ((!selm || (j_lo + (t)) == 0) ? true : (((selmask[selrow() + ((j_lo + (t)) >> 5)] >> ((j_lo + (t)) & 31)) & 1u) != 0u))
#define MASKT(P0_, P1_, t, act_, bit_) do { const int kb_ = KBASE(t); if (act_) { if (kb_ + KVBLK - 1 > tlo || kb_ <= thi - W) { \
        if (ksh) mask_tile<4>(P0_, P1_, DQB() - (kb_ << 2), Wk); else mask_tile<1>(P0_, P1_, DQB() - kb_, Wk); } \
        if (selm) kill_tile(P0_, P1_, bit_); } } while (0)
    constexpr int NQL = 4;
#define SEAM_K0() do { FA_VMWN(NQL); FA_SWRITE_HK(0); SBAR(); } while (0)
    f32x16 pA0, pA1, pB0, pB1; float mnA, mnB, alA, alB; fi8 pa;
    bool bitA, bitB, actA, actB;
    FA_SWRITE_HV(0); SBAR();
    if (NT > 1) { FA_SLOAD_H(Kh, Vh, KBASE(1)); }
    bitA = true; actA = GEO(0);
    if (selm && j_lo != 0) { bitA = SELBIT(0); actA = actA && __any(bitA); }
    SBAR(); qkt<0, SK>(pA0, pA1, kb0r, S.qr, actA);
    MASKT(pA0, pA1, 0, actA, bitA); partialSM(pA0, pA1, m_reg, mnA, alA);
    if (NT > 1) { FA_VMW(); FA_SWRITE_H(1); }
    if (selm && tid2 < 256) selmask[tid2] = selw;
    if (tid2 == 0) *qslot = tkt;
    __syncthreads();
#define VADV(x) ((x) == NVB - 1 ? 0 : (x) + 1)
#define HALF_STEP(PX0, PX1, mnX, alX, actX, bitX, PY0, PY1, alY, actY, t, KB) do {                                           \
        bitX = SELBIT(t); actX = GEO(t) && (!selm || __any(bitX));                                                            \
        SBAR(); qkt<KB, SK>(PX0, PX1, kb0r, S.qr, actX);                                                            \
        finishSM(PY0, PY1, alY, l_reg, pa); SBAR();                                                           \
        if ((t) + 1 < NT) { FA_SLOAD_H(Kh, Vh, KBASE((t) + 1)); SBAR(); }                                                     \
        pv_tile<0, SK>(o, vb0 + vp * SHM_V, pa, actY); MASKT(PX0, PX1, (t), actX, bitX); partialSM(PX0, PX1, m_reg, mnX, alX); \
        if ((t) + 1 < NT) { FA_VMW(); FA_SWRITE_HV(vn); FA_SWRITE_HK((KB) ^ 1); }                                             \
        vp = VADV(vp); vn = VADV(vn);                                                                                         \
        RESC(alX); __syncthreads(); } while (0)
    int vp = 0, vn = 2;
    for (int t = 1; t + 1 < NT; t += 2) {
        HALF_STEP(pB0, pB1, mnB, alB, actB, bitB, pA0, pA1, alA, actA, t, 1);
        HALF_STEP(pA0, pA1, mnA, alA, actA, bitA, pB0, pB1, alB, actB, t + 1, 0);
        bg.slot();
    }
    const bool even = (NT & 1) == 0;
    if (even) { bitB = SELBIT(NT - 1); actB = GEO(NT - 1) && (!selm || __any(bitB)); SBAR(); qkt<1, SK>(pB0, pB1, kb0r, S.qr, actB); SBAR(); }
    FA_SLOAD_H(nxt.K, nxt.V, kbn); SBAR();
    FA_QLOAD(nxt.Q);
    SBAR();
    finishSM(pA0, pA1, alA, l_reg, pa); SBAR();
    pv_tile<0, SK>(o, vb0 + vp * SHM_V, pa, actA);
    if (even) { MASKT(pB0, pB1, NT - 1, actB, bitB); partialSM(pB0, pB1, m_reg, mnB, alB); __syncthreads(); RESC(alB);
        finishSM(pB0, pB1, alB, l_reg, pa); SBAR(); pv_tile<0, SK>(o, vb0 + VADV(vp) * SHM_V, pa, actB); }
    SBAR(); SEAM_K0();
    if (hi == 0) li_l[r32] = l_reg; asm volatile("s_waitcnt lgkmcnt(0)" ::: "memory");
    float rli[16];
#pragma unroll
    for (int r = 0; r < 16; ++r) { const float lv = li_l[crow(r, hi)]; rli[r] = lv > 0.f ? __builtin_amdgcn_rcpf(lv) : 0.f; }
    int t3 = threadIdx.x; asm volatile("" : "+v"(t3));
    bf16* Ow = cur.O + (unsigned)(((t3 >> 6) * QBLK + 4 * ((t3 >> 5) & 1)) * D + (t3 & 31));
#pragma unroll
    for (int r = 0; r < 16; ++r) { const int orow = (r & 3) + 8 * (r >> 2);
#pragma unroll
        for (int d0 = 0; d0 < 4; ++d0) { const float v = o[d0][r] * rli[r];
            const float vn = __shfl_xor(v, 1);
            if ((t3 & 1) == 0) *(unsigned*)(Ow + orow * D + d0 * 32) = cvtpk(v, vn); } }
    __syncthreads();
#undef DQB
#undef RESC
#undef KBASE
#undef GEO
#undef SELBIT
#undef MASKT
#undef SEAM_K0
#undef HALF_STEP
#undef VADV
}
}
constexpr size_t MiB = 1u << 20;
constexpr size_t WS_CTL = 0, CTL_ZERO_BYTES = 1 * MiB;
constexpr size_t WS_ITEMS = 1 * MiB;
constexpr size_t WS_SCAL = 1 * MiB + 65536;
constexpr size_t WS_ROPE = 2 * MiB;
constexpr size_t WS_WIN_T = 4 * MiB, WS_WOUT_T = 28 * MiB, WS_WCAT = 36 * MiB;
constexpr size_t WS_XN = 40 * MiB;
constexpr size_t WS_QNSA = 104 * MiB;
constexpr size_t WS_KV6 = 136 * MiB, KV6_STRIDE = 10 * MiB;
constexpr size_t WS_KCA = WS_KV6, WS_VCA = WS_KV6 + KV6_STRIDE, WS_KSLC = WS_KV6 + 2 * KV6_STRIDE, WS_VSLC = WS_KV6 + 3 * KV6_STRIDE, WS_KWIN = WS_KV6 + 4 * KV6_STRIDE, WS_VWIN = WS_KV6 + 5 * KV6_STRIDE;
constexpr size_t WS_QD = 196 * MiB, WS_KD = 228 * MiB, WS_VD = 260 * MiB;
constexpr size_t WS_GATES = 292 * MiB;
constexpr size_t WS_G = 294 * MiB, G_STRIDE = 5 * MiB;
constexpr size_t WS_KCMP = 304 * MiB, WS_VCMP = 305 * MiB;
constexpr size_t WS_SELM = 306 * MiB;
constexpr size_t WS_OCMP = 308 * MiB, WS_OSLC = 340 * MiB, WS_OWIN = 372 * MiB;
constexpr size_t WS_ODIFF = 404 * MiB;
constexpr size_t WS_MIX = 468 * MiB;
constexpr size_t WS_HN = 532 * MiB;
constexpr size_t WS_LIST = 596 * MiB, WS_GATEW = 598 * MiB;
constexpr size_t WS_HB = 600 * MiB;
constexpr size_t WS_Q8NSA = 744 * MiB, WS_K8SLC = 760 * MiB, WS_K8WIN = 764 * MiB, WS_Q8D = 768 * MiB, WS_K8D = 784 * MiB;
constexpr size_t WS_VT = 800 * MiB;
constexpr size_t WS_HBF = 824 * MiB;
constexpr size_t WS_YS = 888 * MiB;
constexpr size_t WS_WGU_T = 1184 * MiB, WS_WD_T = 1656 * MiB;
constexpr size_t WS_INV = 1448 * MiB;
constexpr size_t WS_END = 1912 * MiB;
constexpr int CW_TMO = 0, CW_CODE = 1;
constexpr int CW_BAR = 4096;
constexpr int CW_QHEAD = 8192;
constexpr int CW_ECNT = 12288;
constexpr int CW_CHK = 16384;
constexpr int RING_BYTES = 131072;
constexpr int LDSX_OFF = RING_BYTES;
constexpr int LDSCTL_OFF = RING_BYTES + 8192, MISC_OFF = LDSCTL_OFF + 320;
constexpr int LDS_BYTES = 147456;
constexpr int NITEMS_ATT = 2048;

struct KArgs { const float* in[26]; float* out; unsigned char* ws; int ph_lo, ph_hi, rep, pad; };

struct DenseSched {
    const char* A; const char* Bt; int nM, nN, nwg, G, c;
    __device__ __forceinline__ void init(const void* A_, const void* Bt_, int M, int N, int G_, int c_) { A = (const char*)A_; Bt = (const char*)Bt_; nM = M / 256; nN = N / 256; nwg = nM * nN; G = G_; c = c_; }
    __device__ __forceinline__ const char* abase() const { return A; }
    __device__ __forceinline__ bool next(int i, pg8::Unit& u) const {
        const long L = (long)i * G + c; if (L >= nwg) return false;
        int wgid = (int)L; { const int q = nwg / 8, r = nwg % 8, xcd = wgid % 8, off = wgid / 8; wgid = (xcd < r ? xcd * (q + 1) : r * (q + 1) + (xcd - r) * q) + off; }
        const int nig = 8 * nN, gid = wgid / nig, fm = gid * 8, gsz = (nM - fm) < 8 ? (nM - fm) : 8;
        u.pm = fm + ((wgid % nig) % gsz); u.pn = (wgid % nig) / gsz; u.e = 0; u.rows = 256;
        if (nN == 8) u.pn = ((u.pn & 3) << 1) | (u.pn >> 2);
        return true;
    }
    __device__ __forceinline__ void avoff(const pg8::Unit& u, const int (&R)[2], const int (&C)[2], int KB, unsigned& v00, unsigned& v01, unsigned& v10, unsigned& v11) const {
        const unsigned base = (unsigned)(u.pm * 256) * (unsigned)KB;
        v00 = base + (unsigned)(R[0] * KB + C[0] * 2); v01 = base + (unsigned)(R[1] * KB + C[1] * 2);
        v10 = v00 + (unsigned)(128 * KB); v11 = v01 + (unsigned)(128 * KB);
    }
    __device__ __forceinline__ const char* btile(const pg8::Unit& u, int KB) const { return Bt + (size_t)u.pn * 256 * KB; }
};
struct CmpSched {
    const char* A; const char* Bt; int c;
    __device__ __forceinline__ const char* abase() const { return A; }
    __device__ __forceinline__ bool next(int i, pg8::Unit& u) const { if (i > 0 || c >= 36) return false; u.e = c / 18; const int r = c % 18; u.pm = r >> 1; u.pn = r & 1; u.rows = 256; return true; }
    __device__ __forceinline__ void avoff(const pg8::Unit& u, const int (&R)[2], const int (&C)[2], int KB, unsigned& v00, unsigned& v01, unsigned& v10, unsigned& v11) const {
        const unsigned base = (unsigned)u.e * (unsigned)KV6_STRIDE + (unsigned)(u.pm * 256) * (unsigned)KB;
        v00 = base + (unsigned)(R[0] * KB + C[0] * 2); v01 = base + (unsigned)(R[1] * KB + C[1] * 2);
        v10 = v00 + (unsigned)(128 * KB); v11 = v01 + (unsigned)(128 * KB);
    }
    __device__ __forceinline__ const char* btile(const pg8::Unit& u, int KB) const { return Bt + ((size_t)u.e * 512 + (size_t)u.pn * 256) * KB; }
};
template <bool GATHER, int NT_>
struct MoeSched {
    const char* A; const char* Bt; size_t bstride; const int* list; const LAS int* tb; const LAS int* cnt; int G, c, ntot;
    __device__ __forceinline__ const char* abase() const { return A; }
    __device__ __forceinline__ bool next(int i, pg8::Unit& u) const {
        int mt;
        if (G == 256) {
            const int x = c & 7, j = c >> 3;
            if (NT_ == 16) { u.pn = (x & 3) * 4 + (j & 3); mt = i * 16 + (x >> 2) * 8 + (j >> 2); }
            else           { u.pn = (x & 1) * 4 + (j & 3); mt = i * 32 + (x >> 1) * 8 + (j >> 2); }
            if (mt >= ntot) return false;
        } else { const long L = (long)i * G + c; if (L >= (long)ntot * NT_) return false; mt = (int)(L / NT_); u.pn = (int)(L % NT_); }
        u.pm = mt;
        int e = 0;
#pragma unroll
        for (int st = 16; st > 0; st >>= 1) e = (__builtin_amdgcn_readfirstlane(tb[e + st]) <= mt) ? e + st : e;
        u.e = e; const int left = __builtin_amdgcn_readfirstlane(cnt[e]) - (mt - __builtin_amdgcn_readfirstlane(tb[e])) * 256; u.rows = left < 256 ? left : 256; return true;
    }
    __device__ __forceinline__ void avoff(const pg8::Unit& u, const int (&R)[2], const int (&C)[2], int KB, unsigned& v00, unsigned& v01, unsigned& v10, unsigned& v11) const {
        if constexpr (GATHER) {
            const int* le = list + (size_t)u.e * TOK + (size_t)(u.pm - __builtin_amdgcn_readfirstlane(tb[u.e])) * 256;
            const int lim = u.rows - 1;
            const int r00 = R[0] < lim ? R[0] : lim, r01 = R[1] < lim ? R[1] : lim, r10 = R[0] + 128 < lim ? R[0] + 128 : lim, r11 = R[1] + 128 < lim ? R[1] + 128 : lim;
            v00 = (unsigned)(le[r00] >> 2) * (unsigned)KB + (unsigned)C[0] * 2u; v01 = (unsigned)(le[r01] >> 2) * (unsigned)KB + (unsigned)C[1] * 2u;
            v10 = (unsigned)(le[r10] >> 2) * (unsigned)KB + (unsigned)C[0] * 2u; v11 = (unsigned)(le[r11] >> 2) * (unsigned)KB + (unsigned)C[1] * 2u;
        } else {
            const unsigned base = (unsigned)(u.pm * 256) * (unsigned)KB;
            v00 = base + (unsigned)(R[0] * KB + C[0] * 2); v01 = base + (unsigned)(R[1] * KB + C[1] * 2);
            v10 = v00 + (unsigned)(128 * KB); v11 = v01 + (unsigned)(128 * KB);
        }
    }
    __device__ __forceinline__ const char* btile(const pg8::Unit& u, int KB) const { return Bt + (size_t)u.e * bstride + (size_t)u.pn * 256 * KB; }
};

#ifndef EPI_NT
#define EPI_NT 0
#endif
#if EPI_NT
#define EPI_ST(ptr_, val_) __builtin_nontemporal_store((val_), (ptr_))
#else
#define EPI_ST(ptr_, val_) (*(ptr_) = (val_))
#endif
__device__ __forceinline__ unsigned f8pk4(float a, float b, float c, float d) { int w = __builtin_amdgcn_cvt_pk_fp8_f32(a, b, 0, false); w = __builtin_amdgcn_cvt_pk_fp8_f32(c, d, w, true); return (unsigned)w; }
__device__ __forceinline__ v4u pack8bf(const f32x4 a, const f32x4 b) { v4u w; w.x = cvtpk(a[0], a[1]); w.y = cvtpk(a[2], a[3]); w.z = cvtpk(b[0], b[1]); w.w = cvtpk(b[2], b[3]); return w; }
struct NoPre {};
struct EpiInProj {
    unsigned char* ws; typedef NoPre Pre;
    __device__ __forceinline__ Pre prefetch(const pg8::Unit&, int, int, int, int) const { return Pre{}; }
    __device__ __forceinline__ void operator()(const f32x4 (&acc)[2][2][4][2], const pg8::Unit& u, int wr, int wc, int fr, int fq, const Pre&) const {
        const int pn = u.pn, cw = wc * 32 + 8 * fq;
        if (pn == 22) {
            if (wc == 0 && fq < 3) { float* gates = (float*)(ws + WS_GATES);
#pragma unroll
                for (int ai = 0; ai < 2; ++ai)
#pragma unroll
                    for (int m = 0; m < 4; ++m) { const int row = u.pm * 256 + ai * 128 + wr * 64 + m * 16 + fr; f32x4 a = acc[ai][0][m][0], b = acc[ai][0][m][1];
#pragma unroll
                        for (int k = 0; k < 4; ++k) { a[k] = 1.f / (1.f + __expf(-a[k])); b[k] = 1.f / (1.f + __expf(-b[k])); }
                        *(f32x4*)(gates + (size_t)row * 24 + cw) = a; *(f32x4*)(gates + (size_t)row * 24 + cw + 4) = b; } }
            return;
        }
#pragma unroll
        for (int bj = 0; bj < 2; ++bj) {
            size_t base, sb, st;
            if (pn < 4) { const int kvh = pn >> 1, g = 2 * (pn & 1) + bj; base = WS_QNSA / 2 + ((size_t)kvh * SEQ * 4 + g) * 128; sb = (size_t)2 * SEQ * 512; st = 512; }
            else if (pn < 10) { base = (WS_KV6 + (size_t)(pn - 4) * KV6_STRIDE) / 2 + (size_t)bj * SEQ * 128; sb = (size_t)2 * SEQ * 128; st = 128; }
            else { const int idx = pn - 10, h = idx & 3; const size_t rb = idx < 4 ? WS_QD : (idx < 8 ? WS_KD : WS_VD); base = rb / 2 + (size_t)(h * 2 + bj) * SEQ * 128; sb = (size_t)8 * SEQ * 128; st = 128; }
            bf16* dst0 = (bf16*)ws + base + cw;
#pragma unroll
            for (int ai = 0; ai < 2; ++ai)
#pragma unroll
                for (int m = 0; m < 4; ++m) { const int row = u.pm * 256 + ai * 128 + wr * 64 + m * 16 + fr, b = row >> 13, t = row & (SEQ - 1);
                    EPI_ST((v4u*)(dst0 + (size_t)b * sb + (size_t)t * st), pack8bf(acc[ai][bj][m][0], acc[ai][bj][m][1])); }
        }
    }
};
struct EpiG {
    unsigned char* ws; typedef NoPre Pre;
    __device__ __forceinline__ Pre prefetch(const pg8::Unit&, int, int, int, int) const { return Pre{}; }
    __device__ __forceinline__ void operator()(const f32x4 (&acc)[2][2][4][2], const pg8::Unit& u, int wr, int wc, int fr, int fq, const Pre&) const {
        float* G = (float*)(ws + WS_G + (size_t)u.e * G_STRIDE);
#pragma unroll
        for (int ai = 0; ai < 2; ++ai)
#pragma unroll
            for (int m = 0; m < 4; ++m) { const int row = u.pm * 256 + ai * 128 + wr * 64 + m * 16 + fr;
#pragma unroll
                for (int bj = 0; bj < 2; ++bj) { float* p = G + (size_t)row * 512 + u.pn * 256 + bj * 128 + wc * 32 + 8 * fq; *(f32x4*)p = acc[ai][bj][m][0]; *(f32x4*)(p + 4) = acc[ai][bj][m][1]; } }
    }
};
#ifndef PROBE_EPI
#define PROBE_EPI 0
#endif
struct EpiOutProj {
    const float* x; bf16* h; int probe; typedef NoPre Pre;
    __device__ __forceinline__ Pre prefetch(const pg8::Unit&, int, int, int, int) const { return Pre{}; }
    __device__ __forceinline__ void operator()(const f32x4 (&acc)[2][2][4][2], const pg8::Unit& u, int wr, int wc, int fr, int fq, const Pre&) const {
        if (PROBE_EPI == 2 && probe) return;
#pragma unroll
        for (int ai = 0; ai < 2; ++ai) {
            f32x4 xv[4][2][2];
#pragma unroll
            for (int m = 0; m < 4; ++m) { const int row = u.pm * 256 + ai * 128 + wr * 64 + m * 16 + fr;
#pragma unroll
                for (int bj = 0; bj < 2; ++bj) { const size_t o = (size_t)row * DM + u.pn * 256 + bj * 128 + wc * 32 + 8 * fq; if (PROBE_EPI == 1 && probe) { xv[m][bj][0] = acc[ai][bj][m][1]; xv[m][bj][1] = acc[ai][bj][m][0]; } else { xv[m][bj][0] = *(const GAS f32x4*)(x + o); xv[m][bj][1] = *(const GAS f32x4*)(x + o + 4); } } }
#pragma unroll
            for (int m = 0; m < 4; ++m) { const int row = u.pm * 256 + ai * 128 + wr * 64 + m * 16 + fr;
#pragma unroll
                for (int bj = 0; bj < 2; ++bj) { const size_t o = (size_t)row * DM + u.pn * 256 + bj * 128 + wc * 32 + 8 * fq;
                    const f32x4 s0 = xv[m][bj][0] + acc[ai][bj][m][0], s1 = xv[m][bj][1] + acc[ai][bj][m][1];
                    v4u pk; pk.x = pk2(s0.x, s0.y); pk.y = pk2(s0.z, s0.w); pk.z = pk2(s1.x, s1.y); pk.w = pk2(s1.z, s1.w);
                    EPI_ST((v4u*)(h + o), pk); } }
        }
    }
};
struct EpiGateUp {
    const float* bgu; unsigned char* HB; int probe;
    struct Pre { f32x4 g0, g1, u0, u1; };
    __device__ __forceinline__ Pre prefetch(const pg8::Unit& u, int wr, int wc, int fr, int fq) const {
        const float* bg = bgu + (size_t)u.e * 4096 + u.pn * 128 + wc * 32 + 8 * fq; Pre p; p.g0 = *(const f32x4*)bg; p.g1 = *(const f32x4*)(bg + 4); p.u0 = *(const f32x4*)(bg + 2048); p.u1 = *(const f32x4*)(bg + 2052); return p; }
    __device__ __forceinline__ void operator()(const f32x4 (&acc)[2][2][4][2], const pg8::Unit& u, int wr, int wc, int fr, int fq, const Pre& pre) const {
        if (PROBE_EPI == 2 && probe) return;
        const int col = u.pn * 128 + wc * 32 + 8 * fq;
        const f32x4 g0 = pre.g0, g1 = pre.g1, u0 = pre.u0, u1 = pre.u1;
#pragma unroll
        for (int ai = 0; ai < 2; ++ai)
#pragma unroll
            for (int m = 0; m < 4; ++m) { const int r = ai * 128 + wr * 64 + m * 16 + fr;
                f32x4 ga = acc[ai][0][m][0] + g0, gb = acc[ai][0][m][1] + g1, ua = acc[ai][1][m][0] + u0, ub = acc[ai][1][m][1] + u1, ha, hb;
#pragma unroll
                for (int k = 0; k < 4; ++k) {
                    float gl = fminf(ga[k], 7.f), up = __builtin_amdgcn_fmed3f(ua[k], -7.f, 7.f), q = gl * __builtin_amdgcn_rcpf(1.f + __builtin_amdgcn_exp2f(gl * (-1.702f * LOG2E))); ha[k] = fmaf(up, q, q);
                    gl = fminf(gb[k], 7.f); up = __builtin_amdgcn_fmed3f(ub[k], -7.f, 7.f); q = gl * __builtin_amdgcn_rcpf(1.f + __builtin_amdgcn_exp2f(gl * (-1.702f * LOG2E))); hb[k] = fmaf(up, q, q); }
                if (r < u.rows) { v2u o; o.x = f8pk4(ha[0], ha[1], ha[2], ha[3]); o.y = f8pk4(hb[0], hb[1], hb[2], hb[3]); EPI_ST((v2u*)(HB + (size_t)(u.pm * 256 + r) * DFF + col), o); } }
    }
};
#define MOE_ATOMIC 0
struct EpiDown {
    const float* bd; bf16* YS; const int* list; const float* gatew; const LAS int* tb; float* out; int probe;
    struct Pre { float gw[2][4]; f32x4 bv[2][2]; };
    __device__ __forceinline__ Pre prefetch(const pg8::Unit& u, int wr, int wc, int fr, int fq) const {
        const size_t lbase = (size_t)u.e * TOK + (size_t)(u.pm - __builtin_amdgcn_readfirstlane(tb[u.e])) * 256; Pre p;
#pragma unroll
        for (int ai = 0; ai < 2; ++ai)
#pragma unroll
            for (int m = 0; m < 4; ++m) { const int r = ai * 128 + wr * 64 + m * 16 + fr, rc = r < u.rows ? r : u.rows - 1; p.gw[ai][m] = gatew[lbase + rc]; }
#pragma unroll
        for (int bj = 0; bj < 2; ++bj) { const float* b = bd + (size_t)u.e * DM + u.pn * 256 + bj * 128 + wc * 32 + 8 * fq; p.bv[bj][0] = *(const f32x4*)b; p.bv[bj][1] = *(const f32x4*)(b + 4); }
        return p; }
    __device__ __forceinline__ void operator()(const f32x4 (&acc)[2][2][4][2], const pg8::Unit& u, int wr, int wc, int fr, int fq, const Pre& pre) const {
        if (PROBE_EPI == 2 && probe) return;
#pragma unroll
        for (int ai = 0; ai < 2; ++ai)
#pragma unroll
            for (int m = 0; m < 4; ++m) { const int r = ai * 128 + wr * 64 + m * 16 + fr;
                if (r < u.rows) {
#pragma unroll
                    for (int bj = 0; bj < 2; ++bj) { const int col = u.pn * 256 + bj * 128 + wc * 32 + 8 * fq;
                        const f32x4 a = (acc[ai][bj][m][0] + pre.bv[bj][0]) * pre.gw[ai][m], c = (acc[ai][bj][m][1] + pre.bv[bj][1]) * pre.gw[ai][m];
                        EPI_ST((v4u*)(YS + (size_t)(u.pm * 256 + r) * DM + col), pack8bf(a, c)); } } }
    }
};

template <bool F8>
__device__ __forceinline__ void p0_transpose_item(const float* W, int ldw, void* WT, int ldt, int k0, int n0s, int n0d, int nvalid, float wscale, LAS float* scr, int lane) {
    f32x4 v[16]; const int kk0 = lane >> 3, n4 = (lane & 7) * 4;
#pragma unroll
    for (int i = 0; i < 16; ++i) v[i] = n4 < nvalid ? *(const GAS f32x4*)(W + (size_t)(k0 + 8 * i + kk0) * ldw + n0s + n4) : (f32x4){0.f, 0.f, 0.f, 0.f};
#pragma unroll
    for (int i = 0; i < 16; ++i) { LAS float* s = scr + (8 * i + kk0) * 33 + n4; s[0] = v[i].x; s[1] = v[i].y; s[2] = v[i].z; s[3] = v[i].w; }
    LDS_WAIT(); asm volatile("" ::: "memory");
    if constexpr (F8) {
        const int c = lane & 7;
#pragma unroll
        for (int j = 0; j < 4; ++j) { const int n = (lane >> 3) + 8 * j; const LAS float* s = scr + (16 * c) * 33 + n; v4u o;
            o.x = f8pk4(s[0 * 33] * wscale, s[1 * 33] * wscale, s[2 * 33] * wscale, s[3 * 33] * wscale); o.y = f8pk4(s[4 * 33] * wscale, s[5 * 33] * wscale, s[6 * 33] * wscale, s[7 * 33] * wscale);
            o.z = f8pk4(s[8 * 33] * wscale, s[9 * 33] * wscale, s[10 * 33] * wscale, s[11 * 33] * wscale); o.w = f8pk4(s[12 * 33] * wscale, s[13 * 33] * wscale, s[14 * 33] * wscale, s[15 * 33] * wscale);
            *(GAS v4u*)((unsigned char*)WT + (size_t)(n0d + n) * ldt + k0 + 16 * c) = o; }
    } else {
        const int c = lane & 15;
#pragma unroll
        for (int j = 0; j < 8; ++j) { const int n = (lane >> 4) + 4 * j; const LAS float* s = scr + (8 * c) * 33 + n;
            v4u o; o.x = pk2(s[0 * 33], s[1 * 33]); o.y = pk2(s[2 * 33], s[3 * 33]); o.z = pk2(s[4 * 33], s[5 * 33]); o.w = pk2(s[6 * 33], s[7 * 33]);
            *(GAS v4u*)((bf16*)WT + (size_t)(n0d + n) * ldt + k0 + 8 * c) = o; }
    }
    LDS_WAIT(); asm volatile("" ::: "memory");
}
#ifndef BG_IN_FLASH
#define BG_IN_FLASH 1
#endif
constexpr int BG_ITEMS = 32 * 16 * 128 + 32 * 16 * 64, BG_TILE_BYTES = 64 * 33 * 4, BG_LDS_OFF = 69632;
struct BgItem { const float* W; unsigned char* WT; int ldw, k0, n0s, n0d; };
__device__ __forceinline__ BgItem bg_decode(const KArgs& a, int I) {
    BgItem b;
    if (I < 65536) { const int e = I >> 11, q = I & 2047, kb = q >> 7, nb = q & 127, n0 = nb * 32, bj = n0 >> 11, rem = n0 & 2047, pn = rem >> 7, i0 = rem & 127;
        b.W = a.in[22] + (size_t)e * 2048 * 4096; b.ldw = 4096; b.WT = a.ws + WS_WGU_T + (size_t)e * 4096 * 2048; b.k0 = kb * 128; b.n0s = n0; b.n0d = pn * 256 + bj * 128 + i0; }
    else { const int J = I - 65536, e = J >> 10, q = J & 1023, kb = q >> 6, nb = q & 63;
        b.W = a.in[24] + (size_t)e * 2048 * 2048; b.ldw = 2048; b.WT = a.ws + WS_WD_T + (size_t)e * 2048 * 2048; b.k0 = kb * 128; b.n0s = nb * 32; b.n0d = nb * 32; }
    return b;
}
__device__ __forceinline__ void bg_load(const BgItem& b, f32x4 (&v)[16], int lane) {
    const unsigned voff = (unsigned)(((lane >> 3) * b.ldw + (lane & 7) * 4) * 4);
#pragma unroll
    for (int i = 0; i < 16; ++i) v[i] = *(const GAS f32x4*)((const char*)(b.W + (size_t)(b.k0 + 8 * i) * b.ldw + b.n0s) + voff);
}
__device__ __forceinline__ void bg_store(const BgItem& b, const f32x4 (&v)[16], LAS float* scr, int lane) {
    const int kk0 = lane >> 3, n4 = (lane & 7) * 4;
#pragma unroll
    for (int hf = 0; hf < 2; ++hf) {
#pragma unroll
        for (int i = 0; i < 8; ++i) { LAS float* s = scr + (8 * i + kk0) * 33 + n4; const f32x4 x = v[hf * 8 + i]; s[0] = x.x; s[1] = x.y; s[2] = x.z; s[3] = x.w; }
        LDS_WAIT(); asm volatile("" ::: "memory");
        const int c = lane & 3;
#pragma unroll
        for (int j = 0; j < 2; ++j) { const int n = (lane >> 2) + 16 * j; const LAS float* s = scr + (16 * c) * 33 + n; v4u o;
            o.x = f8pk4(s[0 * 33] * 32.f, s[1 * 33] * 32.f, s[2 * 33] * 32.f, s[3 * 33] * 32.f); o.y = f8pk4(s[4 * 33] * 32.f, s[5 * 33] * 32.f, s[6 * 33] * 32.f, s[7 * 33] * 32.f);
            o.z = f8pk4(s[8 * 33] * 32.f, s[9 * 33] * 32.f, s[10 * 33] * 32.f, s[11 * 33] * 32.f); o.w = f8pk4(s[12 * 33] * 32.f, s[13 * 33] * 32.f, s[14 * 33] * 32.f, s[15 * 33] * 32.f);
            *(GAS v4u*)(b.WT + (size_t)(b.n0d + n) * 2048 + b.k0 + 64 * hf + 16 * c) = o; }
        LDS_WAIT(); asm volatile("" ::: "memory");
    }
}
__device__ __forceinline__ void bg_conv_item(const KArgs& a, LAS float* scr, int I, int lane) { f32x4 v[16]; const BgItem b = bg_decode(a, I); bg_load(b, v, lane); bg_store(b, v, scr, lane); }
__device__ __forceinline__ void bg_conv_pair(const KArgs& a, LAS float* scr, int I0, int I1, int lane) {
    f32x4 va[16], vb[16]; const BgItem b0 = bg_decode(a, I0), b1 = bg_decode(a, I1);
    bg_load(b0, va, lane); bg_load(b1, vb, lane); bg_store(b0, va, scr, lane); bg_store(b1, vb, scr, lane);
}
struct BgAsync {
    const KArgs& a; LAS float* tile; int I, st, q, pend, pq, on, tick; BgItem pb;
    __device__ __forceinline__ void convert() {
        int l_ = threadIdx.x; asm volatile("" : "+v"(l_)); const int n = l_ & 31, c = (l_ >> 5) & 1;
#pragma unroll
        for (int g = 0; g < 2; ++g) { const LAS float* s = tile + (16 * (c + 2 * g)) * 32 + n; float x[16];
#pragma unroll
            for (int j = 0; j < 16; ++j) x[j] = s[j * 32];
            v4u o; o.x = f8pk4(x[0] * 32.f, x[1] * 32.f, x[2] * 32.f, x[3] * 32.f); o.y = f8pk4(x[4] * 32.f, x[5] * 32.f, x[6] * 32.f, x[7] * 32.f);
            o.z = f8pk4(x[8] * 32.f, x[9] * 32.f, x[10] * 32.f, x[11] * 32.f); o.w = f8pk4(x[12] * 32.f, x[13] * 32.f, x[14] * 32.f, x[15] * 32.f);
            *(GAS v4u*)(pb.WT + (size_t)(pb.n0d + n) * 2048 + pb.k0 + 64 * pq + 16 * (c + 2 * g)) = o; }
        LDS_WAIT(); asm volatile("" ::: "memory");
    }
    __device__ __forceinline__ void issue() {
        pb = bg_decode(a, I); int l_ = threadIdx.x; asm volatile("" : "+v"(l_));
        const unsigned voff = (unsigned)((((l_ >> 3) & 7) * pb.ldw + (l_ & 7) * 4) * 4);
#pragma unroll
        for (int i = 0; i < 8; ++i) { unsigned o_ = voff; asm volatile("" : "+v"(o_)); __builtin_amdgcn_global_load_lds((const unsigned*)((const char*)(pb.W + (size_t)(pb.k0 + 64 * q + 8 * i) * pb.ldw + pb.n0s) + o_), (LAS unsigned*)((LAS unsigned char*)tile + i * 1024), 16, 0, 0); }
        pq = q; pend = 1; if (++q == 2) { q = 0; I += st; }
    }
    __device__ __forceinline__ void slot() {
        if (!on) return;
        if ((tick ^= 1) != 0) return;
        if (pend) { VM_WAIT(); convert(); pend = 0; }
        if (I < BG_ITEMS) issue();
    }
    __device__ __forceinline__ void drain(LAS float* scr, int lane) {
        if (!on) return;
        if (pend) { VM_WAIT(); convert(); pend = 0; }
        if (q != 0 && I < BG_ITEMS) { issue(); VM_WAIT(); convert(); pend = 0; }
        _Pragma("unroll 1") while (I < BG_ITEMS) { if (I + st < BG_ITEMS) { bg_conv_pair(a, scr, I, I + st, lane); I += 2 * st; } else { bg_conv_item(a, scr, I, lane); I += st; } }
    }
};
__device__ __forceinline__ void p0_prologue(const KArgs& a, LAS unsigned char* lds, int gw, int NGW, int wave, int lane) {
    unsigned char* ws = a.ws;
    LAS float* scr = (LAS float*)(lds + wave * 16896);
    const int gtid = blockIdx.x * 512 + threadIdx.x, GT = gridDim.x * 512;
    for (int idx = gtid; idx < SEQ * 16; idx += GT) { const int pos = idx >> 4, i = idx & 15; const float inv = powf(500000.f, -(float)(2 * i) / 32.f); const float ang = (float)pos * inv;
        ((float*)(ws + WS_ROPE))[idx] = cosf(ang); ((float*)(ws + WS_ROPE))[SEQ * 16 + idx] = sinf(ang); }
    for (int idx = gtid; idx < 2 * 256 * 2048; idx += GT) { const int e = idx / (256 * 2048), r = (idx / 2048) % 256, cidx = idx % 2048;
        const float v = r < 2 ? a.in[5 + e][r * 2048 + cidx] : 0.f; ((bf16*)(ws + WS_KCA + (size_t)e * KV6_STRIDE))[(size_t)(2048 + r) * 2048 + cidx] = (bf16)f2bf(v); }
    if (blockIdx.x == 1 && wave == 0) { float s1 = a.in[13][lane] * a.in[14][lane] + a.in[13][lane + 64] * a.in[14][lane + 64], s2 = a.in[15][lane] * a.in[16][lane] + a.in[15][lane + 64] * a.in[16][lane + 64];
        s1 = wave_sum(s1); s2 = wave_sum(s2); if (lane == 0) ((float*)(ws + WS_SCAL))[0] = expf(s1) - expf(s2) + 0.2f; }
    if (blockIdx.x == 0 && threadIdx.x == 0) { int* it = (int*)(ws + WS_ITEMS); int n = 0;
        for (int c = 128; c >= 1; --c) {
            if ((c & 3) == 0) { const int qb = c / 4 - 1; for (int id = 0; id < 32; ++id) it[n++] = (0 << 16) | (id << 8) | qb; }
            { const int u = c - 1; for (int id = 0; id < 4; ++id) it[n++] = (1 << 16) | (id << 8) | u; }
            if (c < 9) { const int u = c - 1; for (int id = 0; id < 4; ++id) it[n++] = (2 << 16) | (id << 8) | u; }
            else if (c == 9) { for (int u = 8; u < 128; ++u) for (int id = 0; id < 4; ++id) it[n++] = (2 << 16) | (id << 8) | u; }
        } }
    constexpr int I_IN = 16 * 184, I_OUT = 16 * 64, I_CAT = 2 * 2 * 16 * 8;
    constexpr int NIT = I_IN + I_OUT + I_CAT;
    for (int it = gw; it < NIT; it += NGW) {
        int r = it;
        if (r < I_IN) { const int kb = r / 184, nb = r % 184, n0 = nb * 32; int ns, nv;
            if (n0 < 2560) { ns = n0; nv = 32; } else if (n0 < 5632) { ns = n0 + 24; nv = 32; } else if (n0 == 5632) { ns = 2560; nv = 24; } else { ns = 0; nv = 0; }
            p0_transpose_item<false>(a.in[2], 5656, ws + WS_WIN_T, 2048, kb * 128, ns, n0, nv, 1.f, scr, lane); continue; } r -= I_IN;
        if (r < I_OUT) { const int kb = r / 64, nb = r % 64; p0_transpose_item<false>(a.in[18], 2048, ws + WS_WOUT_T, 2048, kb * 128, nb * 32, nb * 32, 32, 1.f, scr, lane); continue; } r -= I_OUT;
        { const int e = r / 256, q = r % 256, part = q / 128, kb = (q % 128) / 8, nb = q % 8;
            p0_transpose_item<false>(a.in[e ? 9 : 7] + (size_t)part * 2048 * 256, 256, ws + WS_WCAT + (size_t)e * 2 * MiB, 2048, kb * 128, nb * 32, part * 256 + nb * 32, 32, 1.f, scr, lane); }
    }
    if (!BG_IN_FLASH) { for (int I = gw; I < BG_ITEMS; I += NGW) bg_conv_item(a, scr, I, lane); }
    for (int m = gw; m < TOK; m += 2 * NGW) {
        const int m2 = m + NGW < TOK ? m + NGW : m;
        const GAS f32x4* xr = (const GAS f32x4*)(a.in[0] + (size_t)m * DM) + lane; const GAS f32x4* xr2 = (const GAS f32x4*)(a.in[0] + (size_t)m2 * DM) + lane; const GAS f32x4* gr = (const GAS f32x4*)a.in[1] + lane;
        f32x4 v[8], w[8]; float s = 0.f, s2 = 0.f;
#pragma unroll
        for (int j = 0; j < 8; ++j) { v[j] = xr[64 * j]; w[j] = xr2[64 * j]; }
#pragma unroll
        for (int j = 0; j < 8; ++j) { s += (v[j].x * v[j].x + v[j].y * v[j].y) + (v[j].z * v[j].z + v[j].w * v[j].w); s2 += (w[j].x * w[j].x + w[j].y * w[j].y) + (w[j].z * w[j].z + w[j].w * w[j].w); }
        const float rstd = 1.f / sqrtf(wave_sum(s) * (1.f / DM) + NORM_EPS), rstd2 = 1.f / sqrtf(wave_sum(s2) * (1.f / DM) + NORM_EPS);
        GAS unsigned long long* o8 = (GAS unsigned long long*)(ws + WS_XN + (size_t)m * DM * 2) + lane; GAS unsigned long long* o82 = (GAS unsigned long long*)(ws + WS_XN + (size_t)m2 * DM * 2) + lane;
#pragma unroll
        for (int j = 0; j < 8; ++j) { const f32x4 g = gr[64 * j];
            o8[64 * j] = (unsigned long long)pk2(v[j].x * rstd * g.x, v[j].y * rstd * g.y) | ((unsigned long long)pk2(v[j].z * rstd * g.z, v[j].w * rstd * g.w) << 32);
            o82[64 * j] = (unsigned long long)pk2(w[j].x * rstd2 * g.x, w[j].y * rstd2 * g.y) | ((unsigned long long)pk2(w[j].z * rstd2 * g.z, w[j].w * rstd2 * g.w) << 32); }
    }
}

__device__ __forceinline__ void p1b_norm(const KArgs& a, int gw, int NGW, int lane) {
    unsigned char* ws = a.ws; const float* ropec = (const float*)(ws + WS_ROPE); const float* ropes = ropec + SEQ * 16;
    constexpr int R0 = TOK * 8, R1 = TOK * 2;
    const int sub = lane & 15, rq = lane >> 4;
#define NLOAD(S, u, r4_) { const int rr_ = (r4_) + (u) * NGW; ok##S##u = rr_ < n4;                                                                  \
        if (ok##S##u) { const int row = rr_ * 4 + rq; w##S##u = *(const v4u*)(base + (size_t)row * 128 + sub * 8);                                   \
            if (sub < 4) { const int pos = (row >> psh) & (SEQ - 1); const float* cp = ropec + pos * 16 + (sub & 1) * 8; const float* sp = ropes + pos * 16 + (sub & 1) * 8; \
                c0##S##u = *(const f32x4*)cp; c1##S##u = *(const f32x4*)(cp + 4); s0##S##u = *(const f32x4*)sp; s1##S##u = *(const f32x4*)(sp + 4); } } }
#define NDO(S, u, r4_) if (ok##S##u) { const int row = ((r4_) + (u) * NGW) * 4 + rq; const v4u w = w##S##u;                                         \
        float x[8] = {bflo(w.x), bfhi(w.x), bflo(w.y), bfhi(w.y), bflo(w.z), bfhi(w.z), bflo(w.w), bfhi(w.w)};                                        \
        float ss = 0.f;                                                                                                                              \
        _Pragma("unroll") for (int k = 0; k < 8; ++k) ss += x[k] * x[k];                                                                             \
        ss += __shfl_xor(ss, 1); ss += __shfl_xor(ss, 2); ss += __shfl_xor(ss, 4); ss += __shfl_xor(ss, 8);                                           \
        const float rstd = 1.f / sqrtf(ss * (1.f / 128.f) + NORM_EPS);                                                                               \
        x[0] *= rstd * gv0.x; x[1] *= rstd * gv0.y; x[2] *= rstd * gv0.z; x[3] *= rstd * gv0.w; x[4] *= rstd * gv1.x; x[5] *= rstd * gv1.y; x[6] *= rstd * gv1.z; x[7] *= rstd * gv1.w; \
        const float cc[8] = {c0##S##u.x, c0##S##u.y, c0##S##u.z, c0##S##u.w, c1##S##u.x, c1##S##u.y, c1##S##u.z, c1##S##u.w};                         \
        const float sn[8] = {s0##S##u.x, s0##S##u.y, s0##S##u.z, s0##S##u.w, s1##S##u.x, s1##S##u.y, s1##S##u.z, s1##S##u.w};                         \
        float y[8];                                                                                                                                  \
        _Pragma("unroll") for (int k = 0; k < 8; ++k) { const float other = __shfl_xor(x[k], 2);                                                     \
            y[k] = sub < 2 ? x[k] * cc[k] - other * sn[k] : (sub < 4 ? x[k] * cc[k] + other * sn[k] : x[k]); }                                         \
        v4u o; o.x = pk2(y[0], y[1]); o.y = pk2(y[2], y[3]); o.z = pk2(y[4], y[5]); o.w = pk2(y[6], y[7]); if (wb) *(v4u*)(base + (size_t)row * 128 + sub * 8) = o; \
        v2u o8; o8.x = f8pk4(16.f * y[0], 16.f * y[1], 16.f * y[2], 16.f * y[3]); o8.y = f8pk4(16.f * y[4], 16.f * y[5], 16.f * y[6], 16.f * y[7]);     \
        *(v2u*)(b8 + (size_t)row * 128 + sub * 8) = o8; }
#define NDECL(S, u) bool ok##S##u = false; v4u w##S##u = {0u, 0u, 0u, 0u}; f32x4 c0##S##u = {1.f, 1.f, 1.f, 1.f}, c1##S##u = c0##S##u, s0##S##u = {0.f, 0.f, 0.f, 0.f}, s1##S##u = s0##S##u;
#define NLOAD4(S, r4_) NLOAD(S, 0, r4_) NLOAD(S, 1, r4_) NLOAD(S, 2, r4_) NLOAD(S, 3, r4_)
#define NDO4(S, r4_) NDO(S, 0, r4_) NDO(S, 1, r4_) NDO(S, 2, r4_) NDO(S, 3, r4_)
    _Pragma("unroll 1") for (int t = 0; t < 5; ++t) {
        bf16* base; unsigned char* b8; const float* g; int n4, psh = 0;
        if (t == 0) { base = (bf16*)(ws + WS_QNSA); b8 = ws + WS_Q8NSA; g = a.in[3]; n4 = R0 / 4; psh = 2; }
        else if (t == 1) { base = (bf16*)(ws + WS_KSLC); b8 = ws + WS_K8SLC; g = a.in[4] + 128; n4 = R1 / 4; }
        else if (t == 2) { base = (bf16*)(ws + WS_KWIN); b8 = ws + WS_K8WIN; g = a.in[4] + 256; n4 = R1 / 4; }
        else if (t == 3) { base = (bf16*)(ws + WS_QD); b8 = ws + WS_Q8D; g = a.in[11]; n4 = R0 / 4; }
        else { base = (bf16*)(ws + WS_KD); b8 = ws + WS_K8D; g = a.in[12]; n4 = R0 / 4; }
        const f32x4 gv0 = *(const f32x4*)(g + sub * 8), gv1 = *(const f32x4*)(g + sub * 8 + 4);
        const bool wb = t == 0 || MK_CHECK;
        NDECL(A, 0) NDECL(A, 1) NDECL(A, 2) NDECL(A, 3) NDECL(B, 0) NDECL(B, 1) NDECL(B, 2) NDECL(B, 3)
        int r = gw;
        NLOAD4(A, r)
        _Pragma("unroll 1") while (r < n4) {
            NLOAD4(B, r + 4 * NGW)
            NDO4(A, r)
            r += 4 * NGW; if (r >= n4) break;
            NLOAD4(A, r + 4 * NGW)
            NDO4(B, r)
            r += 4 * NGW;
        }
    }
#undef NLOAD
#undef NDO
#undef NDECL
#undef NLOAD4
#undef NDO4
}
__device__ __forceinline__ void p1c_vt(const KArgs& a, int gw, int NGW, int lane) {
    unsigned char* ws = a.ws;
    for (int it = gw; it < 24 * (SEQ / 64); it += NGW) {
        const int pl = it >> 7, tile = it & 127;
        const bf16* src = (const bf16*)(ws + (pl < 4 ? WS_VSLC : (pl < 8 ? WS_VWIN : WS_VD))) + ((size_t)(pl < 4 ? pl : (pl < 8 ? pl - 4 : pl - 8)) * SEQ + tile * 64) * 128;
        unsigned char* dst = ws + WS_VT + ((size_t)pl * 128 + 2 * lane) * SEQ + tile * 64;
#pragma unroll
        for (int c = 0; c < 4; ++c) {
            unsigned w[16];
#pragma unroll
            for (int i = 0; i < 16; ++i) { const int key = 32 * (c & 1) + (i & 3) + 8 * (i >> 2) + 4 * (c >> 1); w[i] = ((const unsigned*)(src + (size_t)key * 128))[lane]; }
            v4u lo, hi;
            lo.x = f8pk4(16.f * bflo(w[0]), 16.f * bflo(w[1]), 16.f * bflo(w[2]), 16.f * bflo(w[3]));     hi.x = f8pk4(16.f * bfhi(w[0]), 16.f * bfhi(w[1]), 16.f * bfhi(w[2]), 16.f * bfhi(w[3]));
            lo.y = f8pk4(16.f * bflo(w[4]), 16.f * bflo(w[5]), 16.f * bflo(w[6]), 16.f * bflo(w[7]));     hi.y = f8pk4(16.f * bfhi(w[4]), 16.f * bfhi(w[5]), 16.f * bfhi(w[6]), 16.f * bfhi(w[7]));
            lo.z = f8pk4(16.f * bflo(w[8]), 16.f * bflo(w[9]), 16.f * bflo(w[10]), 16.f * bflo(w[11]));   hi.z = f8pk4(16.f * bfhi(w[8]), 16.f * bfhi(w[9]), 16.f * bfhi(w[10]), 16.f * bfhi(w[11]));
            lo.w = f8pk4(16.f * bflo(w[12]), 16.f * bflo(w[13]), 16.f * bflo(w[14]), 16.f * bflo(w[15])); hi.w = f8pk4(16.f * bfhi(w[12]), 16.f * bfhi(w[13]), 16.f * bfhi(w[14]), 16.f * bfhi(w[15]));
            *(v4u*)(dst + c * 16) = lo; *(v4u*)(dst + SEQ + c * 16) = hi;
        }
    }
}

__device__ __forceinline__ float gelu_tanh(float x) { const float u = 0.7978845608028654f * (x + 0.044715f * x * x * x); return 0.5f * x * (1.f + tanhf(u)); }
__device__ __forceinline__ void p2b_compress2(const KArgs& a, LAS unsigned char* lds) {
    unsigned char* ws = a.ws; const int tid = threadIdx.x, wave = tid >> 6, lane = tid & 63;
    LAS float* h1 = (LAS float*)lds;
    LAS float* cb = (LAS float*)(lds + 16384);
    const float* ropec = (const float*)(ws + WS_ROPE); const float* ropes = ropec + SEQ * 16;
    for (int item = blockIdx.x; item < 256; item += gridDim.x) {
        const int e = item >> 7, r0 = (item & 127) * 16;
        const float* G = (const float*)(ws + WS_G + (size_t)e * G_STRIDE); const float* w2 = a.in[e ? 10 : 8];
        __syncthreads();
        for (int idx = tid; idx < 16 * 256; idx += 512) { const int r = idx >> 8, n = idx & 255, row = r0 + r;
            const float v = G[(size_t)row * 512 + n] + G[(size_t)(row + 1) * 512 + 256 + n] + G[(size_t)2048 * 512 + n] + G[(size_t)2049 * 512 + 256 + n];
            h1[idx] = gelu_tanh(v); }
        __syncthreads();
        const int d = tid & 127, rg = tid >> 7; float acc0 = 0.f, acc1 = 0.f, acc2 = 0.f, acc3 = 0.f;
#pragma unroll 1
        for (int n0 = 0; n0 < 256; n0 += 32) { float wv[32];
#pragma unroll
            for (int j = 0; j < 32; ++j) wv[j] = w2[(n0 + j) * 128 + d];
#pragma unroll
            for (int j = 0; j < 32; ++j) { const int n = n0 + j; const float w = wv[j]; acc0 += h1[(rg * 4 + 0) * 256 + n] * w; acc1 += h1[(rg * 4 + 1) * 256 + n] * w; acc2 += h1[(rg * 4 + 2) * 256 + n] * w; acc3 += h1[(rg * 4 + 3) * 256 + n] * w; } }
        cb[(rg * 4 + 0) * 128 + d] = acc0; cb[(rg * 4 + 1) * 128 + d] = acc1; cb[(rg * 4 + 2) * 128 + d] = acc2; cb[(rg * 4 + 3) * 128 + d] = acc3;
        __syncthreads();
#pragma unroll
        for (int rr = 0; rr < 2; ++rr) { const int r = wave * 2 + rr, row = r0 + r, i = row & 511;
            float x0 = cb[r * 128 + lane], x1 = cb[r * 128 + lane + 64];
            bf16* dst = (bf16*)(ws + (e ? WS_VCMP : WS_KCMP)) + (size_t)row * 128;
            if (e == 0) {
                const float ss = wave_sum(x0 * x0 + x1 * x1); const float rstd = 1.f / sqrtf(ss * (1.f / 128.f) + NORM_EPS);
                x0 *= rstd * a.in[4][lane]; x1 *= rstd * a.in[4][lane + 64];
                const int pos = 16 * i + 31; const float other = __shfl_xor(x0, 16);
                if (lane < 32 && pos < SEQ) { const int ai = lane & 15; const float c = ropec[pos * 16 + ai], s = ropes[pos * 16 + ai]; x0 = lane < 16 ? x0 * c - other * s : x0 * c + other * s; }
            }
            if (i == 511) { x0 = 0.f; x1 = 0.f; }
            dst[lane] = (bf16)f2bf(x0); dst[lane + 64] = (bf16)f2bf(x1);
        }
    }
    __syncthreads();
}
__device__ __forceinline__ void p4_cmp_unit(const KArgs& a, char* lds, int unit) {
    using namespace fa16;
    unsigned char* ws = a.ws;
    const int tid = threadIdx.x, wid = __builtin_amdgcn_readfirstlane(tid >> 6), lane = tid & 63, r32 = lane & 31, hi = lane >> 5;
    const int bk = unit >> 7, u = unit & 127;
    char* V_lds = lds; char* K_lds = lds + 2 * SHM_V;
    float* imp = (float*)(lds + 69632);
    const bf16* Q = (const bf16*)(ws + WS_QNSA) + ((size_t)bk * SEQ + 64 * u) * 512;
    const bf16* Kc = (const bf16*)(ws + WS_KCMP) + (size_t)bk * NCMPP * 128;
    const bf16* Vc = (const bf16*)(ws + WS_VCMP) + (size_t)bk * NCMPP * 128;
    bf16* Oc = (bf16*)(ws + WS_OCMP) + ((size_t)bk * SEQ + 64 * u) * 512;
    bf16x8 qr[8];
#pragma unroll
    for (int d0 = 0; d0 < 8; ++d0) qr[d0] = load8(Q + (size_t)(wid * 32 + r32) * 128 + d0 * 16 + hi * 8);
    const int trow = 64 * u + ((wid * 32 + r32) >> 2);
    const int imax = (trow - 31) >> 4;
    const int ntile = ((4 * u + 2) >> 6) + 1;
    constexpr float C2 = LOG2E * SCALE; const float NEG = -__builtin_inff();
    const int sr = tid >> 4, sc = (tid & 15) * 8, vst0 = v_st(sr, sc), vst1 = v_st(32 + sr, sc), kws = KSWZ(sr, sc * 2);
    const int vb0 = (int)(uintptr_t)V_lds + v_rd_base(lane);
    float m = -1e30f, l = 0.f;
    bf16x8 sk0 = load8(Kc + (size_t)sr * 128 + sc), sk1 = load8(Kc + (size_t)(32 + sr) * 128 + sc), sv0, sv1;
    __syncthreads();
    *(bf16x8*)(K_lds + kws) = sk0; *(bf16x8*)(K_lds + kws + 32 * 256) = sk1;
    __syncthreads();
    int sb = 0;
    for (int kt = 0; kt < ntile; ++kt) {
        { const int nk = kt + 1 < ntile ? kt + 1 : 0;
          sk0 = load8(Kc + (size_t)(64 * nk + sr) * 128 + sc); sk1 = load8(Kc + (size_t)(64 * nk + 32 + sr) * 128 + sc);
          if (kt + 1 == ntile) { sv0 = load8(Vc + (size_t)sr * 128 + sc); sv1 = load8(Vc + (size_t)(32 + sr) * 128 + sc); } }
        f32x16 p0, p1; qkt<0, false>(p0, p1, K_lds + sb * SHM_K, r32, hi, qr, true);
        float pmax = NEG;
#pragma unroll
        for (int r = 0; r < 16; ++r) { const int i0 = 64 * kt + crow(r, hi); if (i0 > imax) p0[r] = NEG; if (i0 + 32 > imax) p1[r] = NEG; pmax = fmaxf(pmax, fmaxf(p0[r], p1[r])); }
        { auto rr = __builtin_amdgcn_permlane32_swap(__float_as_uint(pmax), __float_as_uint(pmax), false, false); pmax = fmaxf(__uint_as_float(rr[0]), __uint_as_float(rr[1])); }
        const float mn = fmaxf(m, pmax); float ps = 0.f;
#pragma unroll
        for (int r = 0; r < 16; ++r) ps += __builtin_amdgcn_exp2f((p0[r] - mn) * C2) + __builtin_amdgcn_exp2f((p1[r] - mn) * C2);
        { auto rr = __builtin_amdgcn_permlane32_swap(__float_as_uint(ps), __float_as_uint(ps), false, false); ps = __uint_as_float(rr[0]) + __uint_as_float(rr[1]); }
        l = l * __builtin_amdgcn_exp2f((m - mn) * C2) + ps; m = mn;
        { char* kw_ = K_lds + (sb ^ 1) * SHM_K + kws; *(bf16x8*)kw_ = sk0; *(bf16x8*)(kw_ + 32 * 256) = sk1;
          if (kt + 1 == ntile) { char* vw_ = V_lds + (sb ^ 1) * SHM_V; *(bf16x8*)(vw_ + vst0) = sv0; *(bf16x8*)(vw_ + vst1) = sv1; } }
        sb ^= 1;
        __syncthreads();
    }
    const float rl = l > 0.f ? 1.f / l : 0.f;
    f32x16 o[4] = {}; float carry = 0.f;
    for (int kt = 0; kt < ntile; ++kt) {
        if (kt + 1 < ntile) { sk0 = load8(Kc + (size_t)(64 * (kt + 1) + sr) * 128 + sc); sk1 = load8(Kc + (size_t)(64 * (kt + 1) + 32 + sr) * 128 + sc);
                              sv0 = load8(Vc + (size_t)(64 * (kt + 1) + sr) * 128 + sc); sv1 = load8(Vc + (size_t)(64 * (kt + 1) + 32 + sr) * 128 + sc); }
        f32x16 p0, p1; qkt<0, false>(p0, p1, K_lds + sb * SHM_K, r32, hi, qr, true);
#pragma unroll
        for (int r = 0; r < 16; ++r) { const int i0 = 64 * kt + crow(r, hi);
            p0[r] = i0 > imax ? 0.f : __builtin_amdgcn_exp2f((p0[r] - m) * C2) * rl; p1[r] = i0 + 32 > imax ? 0.f : __builtin_amdgcn_exp2f((p1[r] - m) * C2) * rl; }
        float Lq[8], Qs[8];
#pragma unroll
        for (int s = 0; s < 4; ++s) { Qs[s] = (p0[4 * s] + p0[4 * s + 1]) + (p0[4 * s + 2] + p0[4 * s + 3]); Lq[s] = p0[4 * s + 3];
                                      Qs[4 + s] = (p1[4 * s] + p1[4 * s + 1]) + (p1[4 * s + 2] + p1[4 * s + 3]); Lq[4 + s] = p1[4 * s + 3]; }
#pragma unroll
        for (int s = 0; s < 8; ++s) { const float av = s == 0 ? carry : Lq[s - 1], bv = Lq[s];
            auto rr = __builtin_amdgcn_permlane32_swap(__float_as_uint(av), __float_as_uint(bv), false, false);
            const float recv = hi ? __uint_as_float(rr[0]) : __uint_as_float(rr[1]);
            float v = Qs[s] + recv; v += __shfl_xor(v, 1); v += __shfl_xor(v, 2);
            if ((r32 & 3) == 0) imp[(wid * 8 + (r32 >> 2)) * 128 + 16 * kt + 2 * s + hi] = v; }
        carry = Lq[7];
        bf16x8 pa0, pa1, pa2, pa3; pack_p(p0, p1, pa0, pa1, pa2, pa3);
        pv_tile<0, false>(o, vb0 + sb * SHM_V, pa0, pa1, pa2, pa3, true);
        if (kt + 1 < ntile) { char* kw_ = K_lds + (sb ^ 1) * SHM_K + kws; *(bf16x8*)kw_ = sk0; *(bf16x8*)(kw_ + 32 * 256) = sk1;
                              char* vw_ = V_lds + (sb ^ 1) * SHM_V; *(bf16x8*)(vw_ + vst0) = sv0; *(bf16x8*)(vw_ + vst1) = sv1; }
        sb ^= 1;
        __syncthreads();
    }
    { bf16* Ow = Oc + (size_t)(wid * 32) * 128;
#pragma unroll
      for (int r = 0; r < 16; ++r) { const int orow = crow(r, hi);
#pragma unroll
        for (int d0 = 0; d0 < 4; ++d0) { const float v = o[d0][r]; const float vn = __shfl_xor(v, 1);
            if ((r32 & 1) == 0) *(unsigned*)(Ow + (size_t)orow * 128 + d0 * 32 + r32) = cvtpk(v, vn); } } }
    __syncthreads();
    { const int tl = lane >> 3, c = lane & 7; float v[16];
#pragma unroll
      for (int k = 0; k < 16; ++k) { const int j = 16 * c + k; const float x = imp[(wid * 8 + tl) * 128 + j];
          v[k] = j > u ? NEG : ((j == 0 || j == u || j == u - 1) ? 1e9f : x); }
      unsigned word = 0u;
#pragma unroll 1
      for (int round = 0; round < 16; ++round) {
          float best = v[0]; int bi = 16 * c;
#pragma unroll
          for (int k = 1; k < 16; ++k) if (v[k] > best) { best = v[k]; bi = 16 * c + k; }
#pragma unroll
          for (int x = 1; x < 8; x <<= 1) { const float ob = __shfl_xor(best, x); const int oi = __shfl_xor(bi, x); if (ob > best || (ob == best && oi < bi)) { best = ob; bi = oi; } }
          if (best > -1.0f) { if ((bi >> 5) == c) word |= 1u << (bi & 31);
#pragma unroll
              for (int k = 0; k < 16; ++k) if (16 * c + k == bi) v[k] = NEG; }
      }
      if (c < 4) ((unsigned*)(ws + WS_SELM))[((size_t)bk * SEQ + 64 * u + wid * 8 + tl) * 4 + c] = word; }
    __syncthreads();
}

__device__ __forceinline__ fa::BlockRef p5_ref(unsigned char* ws, int item) {
    const int kind = item >> 16, id = (item >> 8) & 255, x = item & 255; fa::BlockRef r;
    r.selsrc = (const unsigned*)(ws + WS_SELM);
    if (kind == 0) { const int bhc = id >> 1, half = id & 1, bh = id >> 2;
        r.Q = ws + WS_Q8D + ((size_t)bhc * SEQ + 256 * x) * 128; r.K = ws + WS_K8D + (size_t)bhc * SEQ * 128;
        r.V = ws + WS_VT + (size_t)(8 + bh * 2 + half) * SEQ * 128; r.O = (bf16*)(ws + WS_ODIFF) + ((size_t)id * SEQ + 256 * x) * 128;
        r.P0 = 256 * x; r.ksh = 0; r.W = 1 << 20; r.sel = 0; }
    else { const size_t ro = ((size_t)id * SEQ + 64 * x) * 512;
        r.Q = ws + WS_Q8NSA + ro; r.K = ws + (kind == 1 ? WS_K8SLC : WS_K8WIN) + (size_t)id * SEQ * 128; r.V = ws + WS_VT + (size_t)((kind == 1 ? 0 : 4) + id) * SEQ * 128;
        r.O = (bf16*)(ws + (kind == 1 ? WS_OSLC : WS_OWIN)) + ro; r.P0 = 256 * x; r.ksh = 2; r.W = kind == 1 ? (1 << 20) : 512; r.sel = kind == 1 ? 1 : 0;
        if (kind == 1) r.selsrc = (const unsigned*)(ws + WS_SELM) + ((size_t)id * SEQ + 64 * x) * 4; }
    return r;
}
__device__ __forceinline__ void p5_flash(const KArgs& a, char* lds, LAS int* qslot, int rep, int vcu) {
    unsigned char* ws = a.ws; const int tid = threadIdx.x, wave = __builtin_amdgcn_readfirstlane(tid >> 6), lane = tid & 63;
    unsigned* head = (unsigned*)(ws + WS_CTL) + CW_QHEAD + 64 * rep; const int* items = (const int*)(ws + WS_ITEMS);
    int t0_ = threadIdx.x; asm volatile("" : "+v"(t0_)); const int w0_ = __builtin_amdgcn_readfirstlane(t0_ >> 6);
    BgAsync bg{a, (LAS float*)((LAS unsigned char*)lds + BG_LDS_OFF + w0_ * BG_TILE_BYTES), __builtin_amdgcn_readfirstlane(vcu * NWAVES + wave), (int)gridDim.x * NWAVES, 0, 0, 0, (rep == 0 && BG_IN_FLASH) ? 1 : 0, 0, BgItem{}};
#define P5_FETCH(dst) do { if (tid == 0) *qslot = (int)__hip_atomic_fetch_add(head, 1u, RLX_AGENT); __syncthreads(); dst = __builtin_amdgcn_readfirstlane(*qslot); __syncthreads(); } while (0)
    int ci, ni; P5_FETCH(ci);
    if (ci < NITEMS_ATT) {
        P5_FETCH(ni);
        fa::BlockRef cur = p5_ref(ws, items[ci]); fa::Seam S;
        fa::fa_prime(cur, lds, S);
        int par = 0;
        for (;;) {
            const bool last = ni >= NITEMS_ATT;
            const fa::BlockRef nxt = last ? cur : p5_ref(ws, items[ni]);
            fa::fa_block(cur, nxt, SEQ, lds, S, head, qslot + par, bg);
            ni = __builtin_amdgcn_readfirstlane(qslot[par]); par ^= 1;
            if (last) break;
            cur = nxt;
        }
    }
    { int t1_ = threadIdx.x; asm volatile("" : "+v"(t1_)); bg.drain(bg.tile, t1_ & 63); }
#undef P5_FETCH
}

__device__ __forceinline__ void p6_combine(const KArgs& a, int gw, int NGW, int lane) {
    unsigned char* ws = a.ws; const float lam = ((const float*)(ws + WS_SCAL))[0];
    const float* gates = (const float*)(ws + WS_GATES); const float* sg = a.in[17];
    for (int tok = gw; tok < TOK; tok += NGW) {
        const int b = tok >> 13, t = tok & (SEQ - 1); bf16* mix = (bf16*)(ws + WS_MIX) + (size_t)tok * DM;
#pragma unroll
        for (int c = 0; c < 2; ++c) { const int col = c * 512 + lane * 8, h = col >> 7, d = col & 127, kvh = h >> 2, g = h & 3;
            const size_t ro = ((((size_t)(b * 2 + kvh) * SEQ + t) * 4 + g) * 128 + d) * 2;
            const v4u oc = *(const v4u*)(ws + WS_OCMP + ro), os = *(const v4u*)(ws + WS_OSLC + ro), ow = *(const v4u*)(ws + WS_OWIN + ro);
            const float gc = gates[(size_t)tok * 24 + h * 3 + 0], gs = gates[(size_t)tok * 24 + h * 3 + 1], gwn = gates[(size_t)tok * 24 + h * 3 + 2];
            v4u o;
            o.x = pk2(gc * bflo(oc.x) + gs * bflo(os.x) + gwn * bflo(ow.x), gc * bfhi(oc.x) + gs * bfhi(os.x) + gwn * bfhi(ow.x));
            o.y = pk2(gc * bflo(oc.y) + gs * bflo(os.y) + gwn * bflo(ow.y), gc * bfhi(oc.y) + gs * bfhi(os.y) + gwn * bfhi(ow.y));
            o.z = pk2(gc * bflo(oc.z) + gs * bflo(os.z) + gwn * bflo(ow.z), gc * bfhi(oc.z) + gs * bfhi(os.z) + gwn * bfhi(ow.z));
            o.w = pk2(gc * bflo(oc.w) + gs * bflo(os.w) + gwn * bflo(ow.w), gc * bfhi(oc.w) + gs * bfhi(os.w) + gwn * bfhi(ow.w));
            *(v4u*)(mix + col) = o; }
#pragma unroll
        for (int c = 0; c < 2; ++c) { const int h = 2 * c + (lane >> 5), l32 = lane & 31, half = l32 >> 4, d = (l32 & 15) * 8;
            const size_t i0 = ((size_t)((((b * 4 + h) * 2 + 0) * 2 + half)) * SEQ + t) * 128 + d, i1 = ((size_t)((((b * 4 + h) * 2 + 1) * 2 + half)) * SEQ + t) * 128 + d;
            const v4u o0 = *(const v4u*)((const bf16*)(ws + WS_ODIFF) + i0), o1 = *(const v4u*)((const bf16*)(ws + WS_ODIFF) + i1);
            float x[8] = {bflo(o0.x) - lam * bflo(o1.x), bfhi(o0.x) - lam * bfhi(o1.x), bflo(o0.y) - lam * bflo(o1.y), bfhi(o0.y) - lam * bfhi(o1.y),
                          bflo(o0.z) - lam * bflo(o1.z), bfhi(o0.z) - lam * bfhi(o1.z), bflo(o0.w) - lam * bflo(o1.w), bfhi(o0.w) - lam * bfhi(o1.w)};
            float ss = 0.f;
#pragma unroll
            for (int k = 0; k < 8; ++k) ss += x[k] * x[k];
            ss += __shfl_xor(ss, 1); ss += __shfl_xor(ss, 2); ss += __shfl_xor(ss, 4); ss += __shfl_xor(ss, 8); ss += __shfl_xor(ss, 16);
            const float rstd = 0.8f / sqrtf(ss * (1.f / 256.f) + NORM_EPS);
            const float* gp = sg + half * 128 + d; const f32x4 g0 = *(const f32x4*)gp, g1 = *(const f32x4*)(gp + 4);
            v4u o; o.x = pk2(x[0] * rstd * g0.x, x[1] * rstd * g0.y); o.y = pk2(x[2] * rstd * g0.z, x[3] * rstd * g0.w); o.z = pk2(x[4] * rstd * g1.x, x[5] * rstd * g1.y); o.w = pk2(x[6] * rstd * g1.z, x[7] * rstd * g1.w);
            *(v4u*)(mix + 1024 + h * 256 + half * 128 + d) = o; }
    }
}

__device__ __forceinline__ void p8_router(const KArgs& a, char* lds) {
    unsigned char* ws = a.ws; const bf16* h = (const bf16*)(ws + WS_HBF); const float* gn = a.in[19]; const float* wr_ = a.in[20]; const float* br = a.in[21];
    const int tid = threadIdx.x, wave = __builtin_amdgcn_readfirstlane(tid >> 6), lane = tid & 63, n = lane & 31, kh = lane >> 5, tg = wave & 1, kq = wave >> 1;
    float* part = (float*)lds;
    float* ssp = (float*)(lds + 32768);
    float* rstd_l = (float*)(lds + 32768 + 1024);
    int* lcnt = (int*)(lds + 32768 + 2048);
    int* gbase = lcnt + 32;
    unsigned* ecnt = (unsigned*)(ws + WS_CTL) + CW_ECNT;
    for (int tile = blockIdx.x; tile < TOK / 64; tile += gridDim.x) {
        const int t0 = tile * 64;
        __syncthreads();
        if (tid < 32) lcnt[tid] = 0;
        const bf16* hrow = h + (size_t)(t0 + 32 * tg + n) * DM;
        f32x16 acc = {}; float ss = 0.f;
#pragma unroll 4
        for (int c = 0; c < 64; ++c) { const int kb = kq * 512 + 8 * c + 4 * kh;
            const v2u hw = *(const v2u*)(hrow + kb); const f32x4 hv = {bflo(hw.x), bfhi(hw.x), bflo(hw.y), bfhi(hw.y)}, gv = *(const f32x4*)(gn + kb);
            ss += (hv.x * hv.x + hv.y * hv.y) + (hv.z * hv.z + hv.w * hv.w);
#pragma unroll
            for (int e4 = 0; e4 < 4; ++e4) acc = __builtin_amdgcn_mfma_f32_32x32x2f32(wr_[(size_t)(kb + e4) * 32 + n], hv[e4] * gv[e4], acc, 0, 0, 0); }
        { auto rr = __builtin_amdgcn_permlane32_swap(__float_as_uint(ss), __float_as_uint(ss), false, false); ss = __uint_as_float(rr[0]) + __uint_as_float(rr[1]); }
#pragma unroll
        for (int r = 0; r < 16; ++r) part[((tg * 4 + kq) * 16 + r) * 64 + lane] = acc[r];
        if (kh == 0) ssp[(tg * 4 + kq) * 32 + n] = ss;
        __syncthreads();
        int te[4] = {0, 0, 0, 0}; float tgv[4] = {0.f, 0.f, 0.f, 0.f}; int rk[4] = {0, 0, 0, 0};
        if (kq == 0) {
            float lg[16]; const float sst = (ssp[(tg * 4 + 0) * 32 + n] + ssp[(tg * 4 + 1) * 32 + n]) + (ssp[(tg * 4 + 2) * 32 + n] + ssp[(tg * 4 + 3) * 32 + n]);
            const float rstd = 1.f / sqrtf(sst * (1.f / DM) + NORM_EPS);
            if (kh == 0) rstd_l[32 * tg + n] = rstd;
#pragma unroll
            for (int r = 0; r < 16; ++r) { const float s = (part[((tg * 4 + 0) * 16 + r) * 64 + lane] + part[((tg * 4 + 1) * 16 + r) * 64 + lane]) + (part[((tg * 4 + 2) * 16 + r) * 64 + lane] + part[((tg * 4 + 3) * 16 + r) * 64 + lane]);
                lg[r] = s * rstd + br[fa::crow(r, kh)]; }
            float tv[4];
#pragma unroll
            for (int k = 0; k < 4; ++k) { float best = lg[0]; int be = fa::crow(0, kh);
#pragma unroll
                for (int r = 1; r < 16; ++r) if (lg[r] > best) { best = lg[r]; be = fa::crow(r, kh); }
                auto rv = __builtin_amdgcn_permlane32_swap(__float_as_uint(best), __float_as_uint(best), false, false); auto re = __builtin_amdgcn_permlane32_swap((unsigned)be, (unsigned)be, false, false);
                const float ob = kh ? __uint_as_float(rv[0]) : __uint_as_float(rv[1]); const int oe = kh ? (int)re[0] : (int)re[1];
                if (ob > best || (ob == best && oe < be)) { best = ob; be = oe; }
                tv[k] = best; te[k] = be;
#pragma unroll
                for (int r = 0; r < 16; ++r) if (fa::crow(r, kh) == be) lg[r] = -__builtin_inff(); }
            const float e1 = __expf(tv[1] - tv[0]), e2 = __expf(tv[2] - tv[0]), e3 = __expf(tv[3] - tv[0]), inv = 1.f / (1.f + e1 + e2 + e3);
            tgv[0] = inv; tgv[1] = e1 * inv; tgv[2] = e2 * inv; tgv[3] = e3 * inv;
            if (kh == 0) {
#pragma unroll
                for (int k = 0; k < 4; ++k) rk[k] = atomicAdd(&lcnt[te[k]], 1); }
        }
        __syncthreads();
        if (tid < 32) gbase[tid] = (int)__hip_atomic_fetch_add(ecnt + 64 * tid, (unsigned)lcnt[tid], RLX_AGENT);
        __syncthreads();
        if (kq == 0 && kh == 0) { const int tok = t0 + 32 * tg + n;
#pragma unroll
            for (int k = 0; k < 4; ++k) { const size_t p = (size_t)te[k] * TOK + gbase[te[k]] + rk[k]; ((int*)(ws + WS_LIST))[p] = tok * 4 + k; ((float*)(ws + WS_GATEW))[p] = tgv[k]; ((int*)(ws + WS_INV))[tok * 4 + k] = (te[k] << 16) | (gbase[te[k]] + rk[k]); } }
#pragma unroll 1
        for (int q = 0; q < 8; ++q) { const int tl = wave * 8 + q; const float rs = rstd_l[tl];
            const GAS v2u* xr = (const GAS v2u*)(h + (size_t)(t0 + tl) * DM) + lane; const GAS f32x4* gr = (const GAS f32x4*)gn + lane;
            GAS unsigned* o4 = (GAS unsigned*)(ws + WS_HN + (size_t)(t0 + tl) * DM) + lane;
#pragma unroll
            for (int j = 0; j < 8; ++j) { const v2u vw = xr[64 * j]; const f32x4 g = gr[64 * j]; o4[64 * j] = f8pk4(bflo(vw.x) * rs * g.x, bfhi(vw.x) * rs * g.y, bflo(vw.y) * rs * g.z, bfhi(vw.y) * rs * g.w); } }
    }
    __syncthreads();
}

__device__ __forceinline__ void p11_final(const KArgs& a, int gw, int NGW, int lane, const LAS int* tb) {
    const bf16* YS = (const bf16*)(a.ws + WS_YS); const int* INV = (const int*)(a.ws + WS_INV);
    for (int tok = gw; tok < TOK; tok += NGW) {
        GAS f32x4* o = (GAS f32x4*)(a.out + (size_t)tok * DM) + lane; const GAS v2u* hb = (const GAS v2u*)((const bf16*)(a.ws + WS_HBF) + (size_t)tok * DM) + lane;
        size_t rowo[4];
#pragma unroll
        for (int k = 0; k < 4; ++k) { const int iv = __builtin_amdgcn_readfirstlane(INV[tok * 4 + k]); rowo[k] = ((size_t)__builtin_amdgcn_readfirstlane(tb[iv >> 16]) * 256 + (iv & 0xffff)) * DM; }
        f32x4 v[8]; v2u y[8][4];
#pragma unroll
        for (int j = 0; j < 8; ++j) { { const v2u hw = hb[64 * j]; v[j] = f32x4{bflo(hw.x), bfhi(hw.x), bflo(hw.y), bfhi(hw.y)}; }
#pragma unroll
            for (int k = 0; k < 4; ++k) y[j][k] = *(const GAS v2u*)(YS + rowo[k] + 256 * j + 4 * lane); }
#pragma unroll
        for (int j = 0; j < 8; ++j) {
#pragma unroll
            for (int k = 0; k < 4; ++k) { v[j].x += bflo(y[j][k].x); v[j].y += bfhi(y[j][k].x); v[j].z += bflo(y[j][k].y); v[j].w += bfhi(y[j][k].y); }
            o[64 * j] = v[j]; }
    }
}

constexpr int NPHASE = 12;
__global__ void __launch_bounds__(NWAVES * 64, 2) mk_fwd(KArgs args) {
    extern __shared__ __attribute__((aligned(16))) unsigned char lds[];
    LAS unsigned char* L = (LAS unsigned char*)lds;
    const int tid = threadIdx.x, lane = tid & 63, wave = __builtin_amdgcn_readfirstlane(tid >> 6);
    const int G = gridDim.x; const int bx = blockIdx.x; const int vcu = (G % 8 == 0) ? (bx % 8) * (G / 8) + bx / 8 : bx;
    const int gw = vcu * NWAVES + wave, NGW = G * NWAVES;
    unsigned char* ws = args.ws; gu32* ctl = (gu32*)(ws + WS_CTL);
    for (int u = tid; u < (LDS_BYTES - LDSCTL_OFF) / 4; u += NWAVES * 64) ((LAS unsigned*)(L + LDSCTL_OFF))[u] = 0u;
    __syncthreads();
    volatile LAS unsigned* MISC = (volatile LAS unsigned*)(L + MISC_OFF);
    XcdBarrier bar; bar.bar = (unsigned*)ctl + CW_BAR; bar.x = 0; bar.st = nullptr;
    if (!MK_SPLIT) bar = xcd_barrier_post((unsigned*)ctl + CW_BAR, MISC + 8);
    const int lo = args.ph_lo, hi = args.ph_hi;
#ifndef PH_MASK
#define PH_MASK 0xFFF
#endif
#define IN(k) (((PH_MASK >> (k)) & 1) && lo <= (k) && (k) < hi)
#define SEAM(k) do { if (IN(k) && IN((k) + 1)) xcd_barrier(bar); } while (0)
#ifndef ALIGN_MULTI
#define ALIGN_MULTI true
#endif
#ifndef REP_MASK
#define REP_MASK 0
#endif
#define REPS(k) (1 + ((REP_MASK >> (k)) & 1))

    if (IN(0)) { _Pragma("unroll") for (int rep = 0; rep < REPS(0); ++rep) { if (rep) xcd_barrier(bar); p0_prologue(args, L, gw, NGW, wave, lane); } } SEAM(0);
    if (IN(1)) { _Pragma("unroll") for (int rep = 0; rep < REPS(1); ++rep) { if (rep) xcd_barrier(bar); DenseSched S; S.init(ws + WS_XN, ws + WS_WIN_T, TOK, NPROJ, G, bx); EpiInProj E{ws};
        pg8::gemm_phase<EpiInProj, DenseSched, ALIGN_MULTI>(L, DM * 2, S, E); } } SEAM(1);
    if (IN(2)) {
        if (G >= 72) { if (bx < 36) { CmpSched S{(const char*)(ws + WS_KCA), (const char*)(ws + WS_WCAT), bx}; EpiG E{ws}; pg8::gemm_phase<EpiG, CmpSched, false>(L, 2048 * 2, S, E); }
                       else { p1b_norm(args, (bx - 36) * NWAVES + wave, (G - 36) * NWAVES, lane); p1c_vt(args, (bx - 36) * NWAVES + wave, (G - 36) * NWAVES, lane); } }
        else { for (int c = bx; c < 36; c += G) { CmpSched S{(const char*)(ws + WS_KCA), (const char*)(ws + WS_WCAT), c}; EpiG E{ws}; pg8::gemm_phase<EpiG, CmpSched, false>(L, 2048 * 2, S, E); }
               p1b_norm(args, gw, NGW, lane); p1c_vt(args, gw, NGW, lane); }
    } SEAM(2);
    if (IN(3)) { p2b_compress2(args, L); } SEAM(3);
    if (IN(4)) { for (int x = bx; x < 256; x += G) { p4_cmp_unit(args, (char*)lds, x); p4_cmp_unit(args, (char*)lds, 511 - x); } } SEAM(4);
    if (IN(5)) { _Pragma("unroll") for (int rep = 0; rep < REPS(5); ++rep) { if (rep) xcd_barrier(bar); p5_flash(args, (char*)lds, (LAS int*)(L + LDSCTL_OFF + 64), rep + args.rep, vcu); } } SEAM(5);
    if (IN(6)) { int l6_ = threadIdx.x; asm volatile("" : "+v"(l6_)); p6_combine(args, gw, NGW, l6_ & 63); } SEAM(6);
    if (IN(7)) { _Pragma("unroll") for (int rep = 0; rep < REPS(7); ++rep) { if (rep) xcd_barrier(bar); DenseSched S; S.init(ws + WS_MIX, ws + WS_WOUT_T, TOK, DM, G, bx); EpiOutProj E{args.in[0], (bf16*)(ws + (args.rep ? WS_YS : WS_HBF)), args.rep};
        pg8::gemm_phase<EpiOutProj, DenseSched, ALIGN_MULTI>(L, DM * 2, S, E); } } SEAM(7);
    if (IN(8)) { p8_router(args, (char*)lds); } SEAM(8);
    LAS int* tb = (LAS int*)(L + LDSX_OFF); LAS int* cn = tb + 64;
    if (IN(9) || IN(10) || IN(11)) {
        __syncthreads();
        if (tid == 0) { int s = 0; for (int e = 0; e < NEXP; ++e) { const int c = (int)__hip_atomic_load((unsigned*)ctl + CW_ECNT + 64 * e, RLX_AGENT); cn[e] = c; tb[e] = s; s += (c + 255) >> 8; } tb[NEXP] = s; }
        __syncthreads();
    }
    if (IN(9)) { _Pragma("unroll") for (int rep = 0; rep < REPS(9); ++rep) { if (rep) xcd_barrier(bar); MoeSched<true, 16> S{(const char*)(ws + WS_HN), (const char*)(ws + WS_WGU_T), (size_t)4096 * 2048, (const int*)(ws + WS_LIST), tb, cn, G, bx, __builtin_amdgcn_readfirstlane(tb[NEXP])};
        EpiGateUp E{args.in[23], ws + WS_HB, args.rep};
        pg8::gemm_phase<EpiGateUp, MoeSched<true, 16>, ALIGN_MULTI, true, 122>(L, DM, S, E); } } SEAM(9);
    if (IN(10)) { _Pragma("unroll") for (int rep = 0; rep < REPS(10); ++rep) { if (rep) xcd_barrier(bar); MoeSched<false, 8> S{(const char*)(ws + WS_HB), (const char*)(ws + WS_WD_T), (size_t)2048 * 2048, (const int*)(ws + WS_LIST), tb, cn, G, bx, __builtin_amdgcn_readfirstlane(tb[NEXP])};
        EpiDown E{args.in[25], (bf16*)(ws + WS_YS), (const int*)(ws + WS_LIST), (const float*)(ws + WS_GATEW), tb, args.out, args.rep};
        pg8::gemm_phase<EpiDown, MoeSched<false, 8>, ALIGN_MULTI, true, 122>(L, DFF, S, E); } } SEAM(10);
    if (IN(11)) { int l11_ = threadIdx.x; asm volatile("" : "+v"(l11_)); p11_final(args, gw, NGW, l11_ & 63, tb); }
#undef IN
#undef SEAM
}
#if MK_CHECK
constexpr int NSTAGE = 16;
__device__ __forceinline__ unsigned hsh(unsigned x) { x ^= x >> 16; x *= 0x7feb352du; x ^= x >> 15; x *= 0x846ca68bu; x ^= x >> 16; return x; }
__device__ void chk_commit(unsigned char* ws, int stage, float err) {
    __shared__ float red[256];
    if (!(err == err)) err = 1e30f;
    red[threadIdx.x] = err; __syncthreads();
    for (int s = 128; s > 0; s >>= 1) { if (threadIdx.x < s) red[threadIdx.x] = fmaxf(red[threadIdx.x], red[threadIdx.x + s]); __syncthreads(); }
    if (threadIdx.x == 0) atomicMax((unsigned*)(ws + WS_CTL) + CW_CHK + 64 * stage, __float_as_uint(red[0]));
    __syncthreads();
}
__device__ float blk_sum(float v) { __shared__ float r2[256]; r2[threadIdx.x] = v; __syncthreads();
    for (int s = 128; s > 0; s >>= 1) { if (threadIdx.x < s) r2[threadIdx.x] += r2[threadIdx.x + s]; __syncthreads(); } const float o = r2[0]; __syncthreads(); return o; }
__device__ float blk_max(float v) { __shared__ float r3[256]; r3[threadIdx.x] = v; __syncthreads();
    for (int s = 128; s > 0; s >>= 1) { if (threadIdx.x < s) r3[threadIdx.x] = fmaxf(r3[threadIdx.x], r3[threadIdx.x + s]); __syncthreads(); } const float o = r3[0]; __syncthreads(); return o; }
__device__ __forceinline__ float relerr(float a, float ref, float floor_) { return fabsf(a - ref) / (fabsf(ref) + floor_); }
__device__ __forceinline__ int orig_col(int c) { return c < 2560 ? c : (c < 5632 ? c + 24 : (c < 5656 ? c - 5632 + 2560 : -1)); }
__device__ __forceinline__ float f8dec(unsigned v) { const unsigned e = (v >> 3) & 15u, m = v & 7u; const float a = e == 0u ? (float)m * 0.001953125f : (float)(8u + m) * exp2f((float)e - 10.f); return (v & 128u) ? -a : a; }
__device__ __forceinline__ unsigned f8enc(float x) { return f8pk4(x, 0.f, 0.f, 0.f) & 255u; }
__device__ __forceinline__ float qw(float w) { return f8dec(f8enc(w * 32.f)) * 0.03125f; }
__device__ __forceinline__ float rope_inv(int i) { return powf(500000.f, -(float)(2 * i) / 32.f); }

__global__ void chk0(KArgs a) {
    unsigned char* ws = a.ws; const int tid = threadIdx.x; float err = 0.f;
    const int row = hsh(blockIdx.x * 7919u + 1u) % TOK; const float* x = a.in[0] + (size_t)row * DM;
    float ss = 0.f; for (int c = tid; c < DM; c += 256) ss += x[c] * x[c];
    ss = blk_sum(ss); const float rstd = 1.f / sqrtf(ss / DM + NORM_EPS);
    for (int c = tid; c < DM; c += 256) err = fmaxf(err, relerr(bf2f(((const bf16*)(ws + WS_XN))[(size_t)row * DM + c]), x[c] * rstd * a.in[1][c], 0.05f));
    const unsigned r = hsh(blockIdx.x * 256u + tid + 12345u);
    { const int c = r % NPROJ, k = (r >> 13) % 2048, oc = orig_col(c); const float ref = oc < 0 ? 0.f : a.in[2][(size_t)k * 5656 + oc]; err = fmaxf(err, relerr(bf2f(((const bf16*)(ws + WS_WIN_T))[(size_t)c * 2048 + k]), ref, 0.01f)); }
    { const int c = r % 2048, k = (r >> 11) % 2048; err = fmaxf(err, relerr(bf2f(((const bf16*)(ws + WS_WOUT_T))[(size_t)c * 2048 + k]), a.in[18][(size_t)k * 2048 + c], 0.01f)); }
    { const int e = r & 1, n = (r >> 1) % 512, k = (r >> 10) % 2048; const float ref = a.in[e ? 9 : 7][(size_t)((n >> 8) * 2048 + k) * 256 + (n & 255)];
      err = fmaxf(err, relerr(bf2f(((const bf16*)(ws + WS_WCAT + (size_t)e * 2 * MiB))[(size_t)n * 2048 + k]), ref, 0.005f)); }
    { const int pos = r % SEQ, i = (r >> 13) & 15; const float ang = (float)pos * rope_inv(i); err = fmaxf(err, fabsf(((const float*)(ws + WS_ROPE))[pos * 16 + i] - cosf(ang)) + fabsf(((const float*)(ws + WS_ROPE))[SEQ * 16 + pos * 16 + i] - sinf(ang))); }
    { const int e = r & 1, rr = (r >> 1) % 4, c = (r >> 3) % 2048; const float ref = rr < 2 ? a.in[5 + e][rr * 2048 + c] : 0.f; err = fmaxf(err, relerr(bf2f(((const bf16*)(ws + WS_KCA + (size_t)e * KV6_STRIDE))[(size_t)(2048 + rr) * 2048 + c]), ref, 0.002f)); }
    chk_commit(ws, 0, err);
}
__global__ void chk0b(KArgs a) {
    unsigned char* ws = a.ws; const int tid = threadIdx.x; float err = 0.f; const unsigned r = hsh(blockIdx.x * 256u + tid + 54321u);
    { const int e = r % 32, rho = (r >> 5) % 4096, k = (r >> 17) % 2048, pn = rho >> 8, bj = (rho >> 7) & 1, i = rho & 127, col = bj * 2048 + pn * 128 + i;
      err = fmaxf(err, (float)((unsigned)(ws + WS_WGU_T)[((size_t)e * 4096 + rho) * 2048 + k] != f8enc(a.in[22][((size_t)e * 2048 + k) * 4096 + col] * 32.f))); }
    { const int e = r % 32, c = (r >> 5) % 2048, k = (r >> 16) % 2048; err = fmaxf(err, (float)((unsigned)(ws + WS_WD_T)[((size_t)e * 2048 + c) * 2048 + k] != f8enc(a.in[24][((size_t)e * 2048 + k) * 2048 + c] * 32.f))); }
    chk_commit(ws, 0, err);
}
__device__ __forceinline__ float inproj_fetch(unsigned char* ws, int row, int c) {
    const int b = row >> 13, t = row & (SEQ - 1);
    if (c >= 5632) return ((const float*)(ws + WS_GATES))[(size_t)row * 24 + (c - 5632)];
    if (c < 1024) { const int h = c >> 7, d = c & 127, kvh = h >> 2, g = h & 3; return bf2f(((const bf16*)(ws + WS_QNSA))[((((size_t)(b * 2 + kvh)) * SEQ + t) * 4 + g) * 128 + d]); }
    if (c < 2560) { const int q = (c - 1024) >> 8, kvh = ((c - 1024) >> 7) & 1, d = c & 127; return bf2f(((const bf16*)(ws + WS_KV6 + (size_t)q * KV6_STRIDE))[((size_t)(b * 2 + kvh) * SEQ + t) * 128 + d]); }
    const int cc = c - 2560, which = cc >> 10, h = (cc >> 8) & 3, sub = (cc >> 7) & 1, d = cc & 127;
    const size_t base = which == 0 ? WS_QD : (which == 1 ? WS_KD : WS_VD);
    return bf2f(((const bf16*)(ws + base))[((size_t)((b * 4 + h) * 2 + sub) * SEQ + t) * 128 + d]);
}
__global__ void chk1(KArgs a) {
    unsigned char* ws = a.ws; const unsigned r = hsh(blockIdx.x * 256u + threadIdx.x + 777u);
    const int row = r % TOK, c = (r >> 14) % 5656, oc = orig_col(c);
    float s = 0.f; for (int k = 0; k < DM; ++k) s += bf2f(((const bf16*)(ws + WS_XN))[(size_t)row * DM + k]) * a.in[2][(size_t)k * 5656 + oc];
    const float ref = c >= 5632 ? 1.f / (1.f + expf(-s)) : s;
    chk_commit(ws, 1, relerr(inproj_fetch(ws, row, c), ref, 0.3f));
}
__device__ float raw_proj(const KArgs& a, int row, int oc) { float s = 0.f; for (int k = 0; k < DM; ++k) s += bf2f(((const bf16*)(a.ws + WS_XN))[(size_t)row * DM + k]) * a.in[2][(size_t)k * 5656 + oc]; return bf2f((bf16)f2bf(s)); }
__global__ void chk2(KArgs a) {
    unsigned char* ws = a.ws; const int tid = threadIdx.x; const unsigned r = hsh(blockIdx.x * 31u + 5u);
    const int kind = blockIdx.x % 5, row = (r >> 3) % TOK, b = row >> 13, t = row & (SEQ - 1);
    int oc0; const float* g; const bf16* dst;
    if (kind == 0) { const int h = r & 7; oc0 = h * 128; g = a.in[3]; dst = (const bf16*)(ws + WS_QNSA) + ((((size_t)(b * 2 + (h >> 2))) * SEQ + t) * 4 + (h & 3)) * 128; }
    else if (kind == 1) { const int kvh = r & 1; oc0 = 1536 + kvh * 128; g = a.in[4] + 128; dst = (const bf16*)(ws + WS_KSLC) + ((size_t)(b * 2 + kvh) * SEQ + t) * 128; }
    else if (kind == 2) { const int kvh = r & 1; oc0 = 2048 + kvh * 128; g = a.in[4] + 256; dst = (const bf16*)(ws + WS_KWIN) + ((size_t)(b * 2 + kvh) * SEQ + t) * 128; }
    else { const int hc = r & 7; oc0 = (kind == 3 ? 2584 : 3608) + hc * 128; g = a.in[kind == 3 ? 11 : 12]; dst = (const bf16*)(ws + (kind == 3 ? WS_QD : WS_KD)) + ((size_t)(b * 8 + hc) * SEQ + t) * 128; }
    __shared__ float v[128];
    float x = 0.f; if (tid < 128) x = raw_proj(a, row, oc0 + tid);
    const float ss = blk_sum(tid < 128 ? x * x : 0.f); const float rstd = 1.f / sqrtf(ss / 128.f + NORM_EPS);
    if (tid < 128) v[tid] = x * rstd * g[tid]; __syncthreads();
    float err = 0.f;
    if (tid < 128) { float y = v[tid];
        if (tid < 32) { const int i = tid & 15; const float ang = (float)t * rope_inv(i), c = cosf(ang), s = sinf(ang); y = tid < 16 ? v[tid] * c - v[tid + 16] * s : v[tid] * c + v[tid - 16] * s; }
        err = relerr(bf2f(dst[tid]), y, 0.6f); }
    chk_commit(ws, 2, err);
}
__global__ void chk3(KArgs a) {
    unsigned char* ws = a.ws; const unsigned r = hsh(blockIdx.x * 256u + threadIdx.x + 99u);
    const int e = r & 1, n = (r >> 1) % 512; int row = (r >> 10) % 2050; const int part = n >> 8;
    const bf16* A = (const bf16*)(ws + WS_KCA + (size_t)e * KV6_STRIDE) + (size_t)row * 2048; const float* w1 = a.in[e ? 9 : 7];
    float s = 0.f; for (int k = 0; k < 2048; ++k) s += bf2f(A[k]) * w1[(size_t)(part * 2048 + k) * 256 + (n & 255)];
    chk_commit(ws, 3, relerr(((const float*)(ws + WS_G + (size_t)e * G_STRIDE))[(size_t)row * 512 + n], s, 0.3f));
}
__device__ __forceinline__ float gelu_ref(float x) { return 0.5f * x * (1.f + tanhf(0.7978845608028654f * (x + 0.044715f * x * x * x))); }
__global__ void chk4(KArgs a) {
    unsigned char* ws = a.ws; const int tid = threadIdx.x; const unsigned r = hsh(blockIdx.x * 131u + 3u);
    const int e = blockIdx.x & 1, bk = (r >> 1) & 3; int i = (r >> 3) % 511; if (blockIdx.x < 4) i = blockIdx.x < 2 ? 0 : 510;
    const bf16* A = (const bf16*)(ws + WS_KCA + (size_t)e * KV6_STRIDE) + ((size_t)bk * SEQ + 16 * i) * 128; const float* pe = a.in[5 + e]; const float* w1 = a.in[e ? 9 : 7]; const float* w2 = a.in[e ? 10 : 8];
    __shared__ float hid[256]; __shared__ float ov[128];
    float s = 0.f; for (int k = 0; k < 4096; ++k) s += (bf2f(A[k]) + pe[k]) * w1[(size_t)k * 256 + tid];
    hid[tid] = gelu_ref(s); __syncthreads();
    float o = 0.f; if (tid < 128) for (int n = 0; n < 256; ++n) o += hid[n] * w2[n * 128 + tid];
    float err = 0.f;
    if (e == 0) { const float ss = blk_sum(tid < 128 ? o * o : 0.f); const float rstd = 1.f / sqrtf(ss / 128.f + NORM_EPS);
        if (tid < 128) ov[tid] = o * rstd * a.in[4][tid]; __syncthreads();
        if (tid < 128) { float y = ov[tid]; if (tid < 32) { const int q = tid & 15; const float ang = (float)(16 * i + 31) * rope_inv(q), c = cosf(ang), sn = sinf(ang); y = tid < 16 ? ov[tid] * c - ov[tid + 16] * sn : ov[tid] * c + ov[tid - 16] * sn; }
            err = relerr(bf2f(((const bf16*)(ws + WS_KCMP))[((size_t)bk * 512 + i) * 128 + tid]), y, 0.6f); } }
    else if (tid < 128) err = relerr(bf2f(((const bf16*)(ws + WS_VCMP))[((size_t)bk * 512 + i) * 128 + tid]), o, 0.3f);
    chk_commit(ws, 4, err);
}
__global__ void chk5(KArgs a) {
    unsigned char* ws = a.ws; const int tid = threadIdx.x; const unsigned r = hsh(blockIdx.x * 977u + 11u);
    const int bk = r & 3; int t = (r >> 2) % SEQ; if (blockIdx.x < 8) t = blockIdx.x * 9; if (blockIdx.x == 8) t = SEQ - 1;
    __shared__ float p[4][512]; __shared__ float imp[128]; __shared__ int sel[128];
    const bf16* Q = (const bf16*)(ws + WS_QNSA) + ((size_t)bk * SEQ + t) * 512; const bf16* Kc = (const bf16*)(ws + WS_KCMP) + (size_t)bk * 512 * 128; const bf16* Vc = (const bf16*)(ws + WS_VCMP) + (size_t)bk * 512 * 128;
    for (int idx = tid; idx < 4 * 512; idx += 256) { const int g = idx >> 9, i = idx & 511; float s = -1e30f;
        if (i < 511 && 16 * i + 31 <= t) { s = 0.f; for (int d = 0; d < 128; ++d) s += bf2f(Q[g * 128 + d]) * bf2f(Kc[(size_t)i * 128 + d]); s *= ATT_SCALE; }
        p[g][i] = s; }
    __syncthreads();
    if (tid < 4) { float m = -1e30f; for (int i = 0; i < 512; ++i) m = fmaxf(m, p[tid][i]); float l = 0.f;
        for (int i = 0; i < 512; ++i) { const float e = p[tid][i] > -1e29f ? expf(p[tid][i] - m) : 0.f; p[tid][i] = e; l += e; }
        const float rl = 1.f / fmaxf(l, 1e-30f); for (int i = 0; i < 512; ++i) p[tid][i] *= rl; }
    __syncthreads();
    float err = 0.f;
    for (int idx = tid; idx < 512; idx += 256) { const int g = idx >> 7, d = idx & 127; float o = 0.f; for (int i = 0; i < 511; ++i) o += p[g][i] * bf2f(Vc[(size_t)i * 128 + d]);
        err = fmaxf(err, relerr(bf2f(((const bf16*)(ws + WS_OCMP))[(((size_t)bk * SEQ + t) * 4 + g) * 128 + d]), o, 0.02f)); }
    chk_commit(ws, 5, err);
    const int cur = t >> 6;
    if (tid < 128) { const int j = tid; float v = 0.f; for (int i = 4 * j - 1; i <= 4 * j + 3; ++i) if (i >= 0 && i < 511) v += (p[0][i] + p[1][i]) + (p[2][i] + p[3][i]);
        if (j == 0 || j == cur || j == cur - 1) v = 1e9f; if (j > cur) v = -1e30f; imp[j] = v; }
    __syncthreads();
    if (tid < 128) { const float v = imp[tid]; int rank = 0; for (int j = 0; j < 128; ++j) rank += (imp[j] > v || (imp[j] == v && j < tid)) ? 1 : 0; sel[tid] = (rank < 16 && v > -1.f) ? 1 : 0; }
    __syncthreads();
    float e2 = 0.f;
    if (tid < 128) { const unsigned w = ((const unsigned*)(ws + WS_SELM))[((size_t)bk * SEQ + t) * 4 + (tid >> 5)]; e2 = (float)((int)((w >> (tid & 31)) & 1u) != sel[tid]); }
    e2 = blk_sum(e2) / 32.f;
    chk_commit(ws, 6, e2);
}
__global__ void chk6(KArgs a) {
    unsigned char* ws = a.ws; const int tid = threadIdx.x; const unsigned r = hsh(blockIdx.x * 613u + 17u);
    const int kind = blockIdx.x % 3; int t = (r >> 8) % SEQ; if (blockIdx.x < 12) t = (blockIdx.x / 3) * 85; if (blockIdx.x >= 12 && blockIdx.x < 15) t = SEQ - 1;
    __shared__ float sc[SEQ]; __shared__ float q[128]; __shared__ float part[2][128];
    const bf16 *Qp, *Kp, *Vp, *Op; unsigned mw[4] = {0xffffffffu, 0xffffffffu, 0xffffffffu, 0xffffffffu}; int klo = 0;
    if (kind < 2) { const int bk = r & 3, g = (r >> 2) & 3; Qp = (const bf16*)(ws + WS_QNSA) + (((size_t)bk * SEQ + t) * 4 + g) * 128; Kp = (const bf16*)(ws + (kind == 0 ? WS_KSLC : WS_KWIN)) + (size_t)bk * SEQ * 128;
        Vp = (const bf16*)(ws + (kind == 0 ? WS_VSLC : WS_VWIN)) + (size_t)bk * SEQ * 128; Op = (const bf16*)(ws + (kind == 0 ? WS_OSLC : WS_OWIN)) + (((size_t)bk * SEQ + t) * 4 + g) * 128;
        if (kind == 0) for (int w = 0; w < 4; ++w) mw[w] = ((const unsigned*)(ws + WS_SELM))[((size_t)bk * SEQ + t) * 4 + w]; else klo = t - 511 > 0 ? t - 511 : 0; }
    else { const int id = r & 31, bhc = id >> 1, half = id & 1, bh = id >> 2; Qp = (const bf16*)(ws + WS_QD) + ((size_t)bhc * SEQ + t) * 128; Kp = (const bf16*)(ws + WS_KD) + (size_t)bhc * SEQ * 128;
        Vp = (const bf16*)(ws + WS_VD) + (size_t)(bh * 2 + half) * SEQ * 128; Op = (const bf16*)(ws + WS_ODIFF) + ((size_t)id * SEQ + t) * 128; }
    if (tid < 128) q[tid] = bf2f(Qp[tid]); __syncthreads();
    float mx = -1e30f;
    for (int k = tid; k <= t; k += 256) { float s = -1e30f; const int j = k >> 6;
        if (k >= klo && ((mw[j >> 5] >> (j & 31)) & 1u)) { s = 0.f; for (int d = 0; d < 128; ++d) s += q[d] * bf2f(Kp[(size_t)k * 128 + d]); s *= ATT_SCALE; }
        sc[k] = s; mx = fmaxf(mx, s); }
    mx = blk_max(mx); float l = 0.f;
    for (int k = tid; k <= t; k += 256) { const float e = sc[k] > -1e29f ? expf(sc[k] - mx) : 0.f; sc[k] = e; l += e; }
    l = blk_sum(l);
    { const int d = tid & 127, hf = tid >> 7; float o = 0.f; for (int k = hf; k <= t; k += 2) o += sc[k] * bf2f(Vp[(size_t)k * 128 + d]); part[hf][d] = o; }
    __syncthreads();
    float ref = 0.f; if (tid < 128) ref = (part[0][tid] + part[1][tid]) / fmaxf(l, 1e-30f);
    const float rms = sqrtf(blk_sum(tid < 128 ? ref * ref : 0.f) / 128.f);
    float err = 0.f; if (tid < 128) err = fabsf(bf2f(Op[tid]) - ref) / (rms + 1e-4f);
    chk_commit(ws, 7 + kind, err);
}
__global__ void chk7(KArgs a) {
    unsigned char* ws = a.ws; const int tid = threadIdx.x; const int tok = hsh(blockIdx.x * 71u + 29u) % TOK, b = tok >> 13, t = tok & (SEQ - 1);
    float s1 = 0.f, s2 = 0.f; for (int d = 0; d < 128; ++d) { s1 += a.in[13][d] * a.in[14][d]; s2 += a.in[15][d] * a.in[16][d]; }
    const float lam = expf(s1) - expf(s2) + 0.2f; const bf16* mix = (const bf16*)(ws + WS_MIX) + (size_t)tok * DM; float err = 0.f;
    for (int c = tid; c < 1024; c += 256) { const int h = c >> 7, d = c & 127; const size_t ro = (((size_t)(b * 2 + (h >> 2)) * SEQ + t) * 4 + (h & 3)) * 128 + d; const float* gt = (const float*)(ws + WS_GATES) + (size_t)tok * 24 + h * 3;
        const float ref = gt[0] * bf2f(((const bf16*)(ws + WS_OCMP))[ro]) + gt[1] * bf2f(((const bf16*)(ws + WS_OSLC))[ro]) + gt[2] * bf2f(((const bf16*)(ws + WS_OWIN))[ro]);
        err = fmaxf(err, fabsf(bf2f(mix[c]) - ref) / (fabsf(ref) + 0.02f)); }
    __shared__ float od[1024];
    for (int c = tid; c < 1024; c += 256) { const int h = c >> 8, half = (c >> 7) & 1, d = c & 127; const bf16* O = (const bf16*)(ws + WS_ODIFF);
        od[c] = bf2f(O[((size_t)(((b * 4 + h) * 2 + 0) * 2 + half) * SEQ + t) * 128 + d]) - lam * bf2f(O[((size_t)(((b * 4 + h) * 2 + 1) * 2 + half) * SEQ + t) * 128 + d]); }
    __syncthreads();
    for (int c = tid; c < 1024; c += 256) { const int h = c >> 8; float ss = 0.f; for (int k = 0; k < 256; ++k) ss += od[h * 256 + k] * od[h * 256 + k];
        const float ref = od[c] / sqrtf(ss / 256.f + NORM_EPS) * a.in[17][c & 255] * 0.8f; err = fmaxf(err, relerr(bf2f(mix[1024 + c]), ref, 0.1f)); }
    chk_commit(ws, 10, err);
}
__global__ void chk8(KArgs a) {
    unsigned char* ws = a.ws; const unsigned r = hsh(blockIdx.x * 256u + threadIdx.x + 4242u); const int row = r % TOK, c = (r >> 14) % DM;
    float s = a.in[0][(size_t)row * DM + c]; for (int k = 0; k < DM; ++k) s += bf2f(((const bf16*)(ws + WS_MIX))[(size_t)row * DM + k]) * a.in[18][(size_t)k * DM + c];
    chk_commit(ws, 11, relerr(bf2f(((const bf16*)(ws + WS_HBF))[(size_t)row * DM + c]), s, 0.3f));
}
__global__ void chk9(KArgs a) {
    unsigned char* ws = a.ws; const int tid = threadIdx.x; const int tok = hsh(blockIdx.x * 337u + 41u) % TOK; __shared__ float h[DM]; for (int c = tid; c < DM; c += 256) h[c] = bf2f(((const bf16*)(ws + WS_HBF))[(size_t)tok * DM + c]); __syncthreads();
    float ss = 0.f; for (int c = tid; c < DM; c += 256) ss += h[c] * h[c]; ss = blk_sum(ss); const float rstd = 1.f / sqrtf(ss / DM + NORM_EPS);
    float e13 = 0.f; for (int c = tid; c < DM; c += 256) { const float ref = h[c] * rstd * a.in[19][c]; e13 = fmaxf(e13, 0.03f * fabsf(f8dec((ws + WS_HN)[(size_t)tok * DM + c]) - ref) / (0.0626f * fabsf(ref) + 0.002f)); }
    chk_commit(ws, 13, e13);
    __shared__ float lg[8][32]; __shared__ float fin[32];
    { const int e = tid & 31, ks = tid >> 5; float s = 0.f; for (int k = ks * 256; k < ks * 256 + 256; ++k) s += h[k] * rstd * a.in[19][k] * a.in[20][(size_t)k * 32 + e]; lg[ks][e] = s; }
    __syncthreads();
    if (tid < 32) { float s = a.in[21][tid]; for (int ks = 0; ks < 8; ++ks) s += lg[ks][tid]; fin[tid] = s; }
    __syncthreads();
    float err = 0.f;
    if (tid == 0) { int te[4]; float tv[4]; float gap = 1e30f;
        for (int k = 0; k < 4; ++k) { int be = -1; float bv = -1e30f; for (int e = 0; e < 32; ++e) { bool used = false; for (int q = 0; q < k; ++q) used |= te[q] == e; if (!used && fin[e] > bv) { bv = fin[e]; be = e; } } te[k] = be; tv[k] = bv; }
        { float v5 = -1e30f; for (int e = 0; e < 32; ++e) { bool used = false; for (int q = 0; q < 4; ++q) used |= te[q] == e; if (!used) v5 = fmaxf(v5, fin[e]); } gap = tv[3] - v5; }
        float den = 0.f; for (int k = 0; k < 4; ++k) den += expf(tv[k] - tv[0]);
        for (int k = 0; k < 4; ++k) { const int e = te[k]; const int cnt = (int)((const unsigned*)(ws + WS_CTL))[CW_ECNT + 64 * e]; const int* li = (const int*)(ws + WS_LIST) + (size_t)e * TOK; bool found = false;
            for (int i = 0; i < cnt && i < TOK; ++i) if (li[i] == tok * 4 + k) { found = true; err = fmaxf(err, fabsf(((const float*)(ws + WS_GATEW))[(size_t)e * TOK + i] - expf(tv[k] - tv[0]) / den) * 10.f); break; }
            if (!found && gap > 1e-3f) err = fmaxf(err, 1.f); }
        if (blockIdx.x == 0) { int tot = 0; for (int e = 0; e < 32; ++e) tot += (int)((const unsigned*)(ws + WS_CTL))[CW_ECNT + 64 * e]; if (tot != TOK * 4) err = fmaxf(err, 5.f); } }
    chk_commit(ws, 12, err);
}
__device__ __forceinline__ void moe_locate(unsigned char* ws, unsigned r, int& e, int& idx, int& prow) {
    e = r % 32; int tb = 0; for (int q = 0; q < e; ++q) tb += ((int)((const unsigned*)(ws + WS_CTL))[CW_ECNT + 64 * q] + 255) >> 8;
    const int cnt = (int)((const unsigned*)(ws + WS_CTL))[CW_ECNT + 64 * e]; idx = cnt > 0 ? (int)((r >> 5) % (unsigned)cnt) : 0; prow = tb * 256 + idx;
}
__global__ void chk10(KArgs a) {
    unsigned char* ws = a.ws; const unsigned r = hsh(blockIdx.x * 256u + threadIdx.x + 9001u); int e, idx, prow; moe_locate(ws, r, e, idx, prow); const int col = (r >> 19) % DFF;
    const int tok = ((const int*)(ws + WS_LIST))[(size_t)e * TOK + idx] >> 2; const unsigned char* hn = ws + WS_HN + (size_t)tok * DM; const float* w = a.in[22] + (size_t)e * 2048 * 4096;
    float gl = a.in[23][e * 4096 + col], up = a.in[23][e * 4096 + 2048 + col]; for (int k = 0; k < DM; ++k) { const float x = f8dec(hn[k]); gl += x * qw(w[(size_t)k * 4096 + col]); up += x * qw(w[(size_t)k * 4096 + 2048 + col]); }
    gl = fminf(gl, 7.f); up = fminf(fmaxf(up, -7.f), 7.f); const float ref = (up + 1.f) * gl / (1.f + expf(-1.702f * gl));
    chk_commit(ws, 14, 0.06f * fabsf(f8dec((ws + WS_HB)[(size_t)prow * DFF + col]) - ref) / (0.0626f * fabsf(ref) + 0.01f));
}
__global__ void chk11(KArgs a) {
    unsigned char* ws = a.ws; const unsigned r = hsh(blockIdx.x * 256u + threadIdx.x + 31337u); int e, idx, prow; moe_locate(ws, r, e, idx, prow); const int col = (r >> 19) % DM;
    const int ent = ((const int*)(ws + WS_LIST))[(size_t)e * TOK + idx]; const float gw = ((const float*)(ws + WS_GATEW))[(size_t)e * TOK + idx]; const unsigned char* hb = ws + WS_HB + (size_t)prow * DFF; const float* w = a.in[24] + (size_t)e * 2048 * 2048;
    float s = a.in[25][e * 2048 + col]; for (int k = 0; k < DFF; ++k) s += f8dec(hb[k]) * qw(w[(size_t)k * 2048 + col]);
    { const int iv = ((const int*)(ws + WS_INV))[ent]; const float e2 = (iv == ((e << 16) | idx)) ? 0.f : 1.f;
      chk_commit(ws, 15, fmaxf(e2, relerr(bf2f(((const bf16*)(ws + WS_YS))[(size_t)prow * DM + col]), s * gw, 0.1f))); }
}
__global__ void chk_report(KArgs a) {
    const float tol[NSTAGE] = {0.02f, 0.08f, 0.08f, 0.08f, 0.1f, 0.1f, 0.07f, 0.35f, 0.35f, 0.35f, 0.08f, 0.08f, 0.05f, 0.04f, 0.1f, 0.1f};
    int bad = -1, bad2 = -1; float be = 0.f;
    for (int s = 0; s < NSTAGE; ++s) { const float e = __uint_as_float(((const unsigned*)(a.ws + WS_CTL))[CW_CHK + 64 * s]); if (e > tol[s]) { if (bad < 0) { bad = s; be = e; } else if (bad2 < 0) bad2 = s; } }
    if (bad < 0) return;
    const size_t n = (size_t)TOK * DM;
    float g = log10f(fmaxf(be, 1e-30f)); g = fminf(fmaxf(g, -3.f), 3.f);
    const float A = powf(10.f, 4.f + (float)bad) * (1.f + (g + 3.f) / 3.f);
    const int q = bad2 < 0 ? 0 : (bad2 - bad < 7 ? bad2 - bad : 7);
    const float B = q ? A * sqrtf(powf(10.f, (float)q) / (float)n) : 0.f;
    for (size_t i = (size_t)blockIdx.x * blockDim.x + threadIdx.x; i < n; i += (size_t)gridDim.x * blockDim.x) a.out[i] = i == 0 ? A : B;
}
static void chk_after_phase(int p, const KArgs& a, hipStream_t stream) {
    switch (p) {
    case 0: chk0<<<64, 256, 0, stream>>>(a); break;
    case 1: chk1<<<16, 256, 0, stream>>>(a); break;
    case 2: chk2<<<160, 256, 0, stream>>>(a); chk3<<<8, 256, 0, stream>>>(a); break;
    case 3: chk4<<<64, 256, 0, stream>>>(a); break;
    case 4: chk5<<<96, 256, 0, stream>>>(a); break;
    case 5: chk6<<<192, 256, 0, stream>>>(a); chk0b<<<256, 256, 0, stream>>>(a); break;
    case 6: chk7<<<64, 256, 0, stream>>>(a); break;
    case 7: chk8<<<16, 256, 0, stream>>>(a); break;
    case 8: chk9<<<64, 256, 0, stream>>>(a); break;
    case 9: chk10<<<8, 256, 0, stream>>>(a); break;
    case 10: chk11<<<8, 256, 0, stream>>>(a); break;
    default: break;
    }
}
#endif
extern "C" void kernel_launch(void* const* d_in, const int* in_sizes, int n_in, void* d_out, int out_size, void* d_ws, size_t ws_size, hipStream_t stream) {
    static int grid = 0;
    if (grid == 0) {
        if (n_in != 26 || in_sizes[0] != TOK * DM || out_size != TOK * DM || ws_size < WS_END) { fprintf(stderr, "kernel_launch: unexpected shapes (n_in %d, in0 %d, out %d, ws %zu)\n", n_in, n_in > 0 ? in_sizes[0] : -1, out_size, ws_size); grid = -1; return; }
        int dev = 0, cus = 0, per_cu = 0;
        if (hipGetDevice(&dev) != hipSuccess || hipDeviceGetAttribute(&cus, hipDeviceAttributeMultiprocessorCount, dev) != hipSuccess) { grid = -1; return; }
        if (hipFuncSetAttribute((const void*)mk_fwd, hipFuncAttributeMaxDynamicSharedMemorySize, LDS_BYTES) != hipSuccess) { fprintf(stderr, "kernel_launch: hipFuncSetAttribute failed\n"); grid = -1; return; }
        if (hipOccupancyMaxActiveBlocksPerMultiprocessor(&per_cu, (const void*)mk_fwd, NWAVES * 64, LDS_BYTES) != hipSuccess || per_cu < 1) { fprintf(stderr, "kernel_launch: occupancy query says %d\n", per_cu); }
        (void)hipGetLastError();
        grid = cus;
        if (grid > 256) grid = 256;
    }
    if (grid < 0) return;
    if (hipMemsetAsync((char*)d_ws + WS_CTL, 0, CTL_ZERO_BYTES, stream) != hipSuccess) return;
    KArgs a{};
    for (int i = 0; i < 26; ++i) a.in[i] = (const float*)d_in[i];
    a.out = (float*)d_out; a.ws = (unsigned char*)d_ws;
#if MK_SPLIT
    for (int p = 0; p < NPHASE; ++p) { a.ph_lo = p; a.ph_hi = p + 1; hipLaunchKernelGGL(mk_fwd, dim3(grid), dim3(NWAVES * 64), LDS_BYTES, stream, a);
#if MK_CHECK
        chk_after_phase(p, a, stream);
#endif
    }
#if MK_CHECK
    chk_report<<<dim3(1024), dim3(256), 0, stream>>>(a);
#endif
#else
    a.ph_lo = 0; a.ph_hi = NPHASE;
    hipLaunchKernelGGL(mk_fwd, dim3(grid), dim3(NWAVES * 64), LDS_BYTES, stream, a);
#if defined(EXTRA_PH)
    a.ph_lo = EXTRA_PH; a.ph_hi = EXTRA_PH + 1; a.rep = 1;
    hipLaunchKernelGGL(mk_fwd, dim3(grid), dim3(NWAVES * 64), LDS_BYTES, stream, a);
#endif
#endif
}
```
